# Optimizing an MI355X kernel written in HIP

```python
import math
import jax, jax.numpy as jnp
from jax import lax
import numpy as np

D_MODEL = 2048
BATCH = 4
SEQ = 4096
DEPTH = 4

N_META = 16
D_FF = 5632
SSM_WIDTH = D_MODEL // 2
SSM_GROUP = 16
SSM_GROUPS = SSM_WIDTH // SSM_GROUP
SSM_STATE = 64
DT_MIN = 1e-3
DT_MAX = 1e-1
RWKV_WIDTH = D_MODEL // 2
RWKV_HEAD = 64
RWKV_HEADS = RWKV_WIDTH // RWKV_HEAD
LORA_DECAY = 64
LORA_ICLR = 64
LORA_VRES = 32
LORA_GATE = 160
NORM_EPS = 1e-6
LNX_EPS = RWKV_HEAD * 1e-5

COL_U = 0
COL_R = COL_U + SSM_WIDTH
COL_K = COL_R + RWKV_WIDTH
COL_V = COL_K + RWKV_WIDTH
COL_W = COL_V + RWKV_WIDTH
COL_A = COL_W + LORA_DECAY
COL_G = COL_A + LORA_ICLR
COL_GATE_A = COL_G + LORA_GATE
COL_GATE_B = COL_GATE_A + D_MODEL
P_COMMON = COL_GATE_B + D_MODEL
P_REST = P_COMMON + LORA_VRES
SHIFT_LO = COL_R
SHIFT_HI = COL_GATE_A

kernel_name = "hybrid_s5_rwkv7_macaron_meta"


def rms_norm(x, g):
    xf = x.astype(jnp.float32)
    inv = lax.rsqrt(jnp.mean(xf * xf, axis=-1, keepdims=True) + NORM_EPS)
    return (xf * inv).astype(x.dtype) * g


def swiglu(h, w_gate, w_up, w_down):
    return (jax.nn.silu(h @ w_gate) * (h @ w_up)) @ w_down


def token_shift(p):
    return jnp.pad(p, ((0, 0), (1, 0), (0, 0)))[:, :-1]


def cmul(ar, ai, br, bi):
    return ar * br - ai * bi, ar * bi + ai * br


def s5_branch(u, lam_re, lam_im, log_dt, b_re, b_im, c_re, c_im, d_skip, w_glu):
    f32 = jnp.float32
    bsz, t_len, _ = u.shape
    uf = u.astype(f32).reshape(bsz, t_len, SSM_GROUPS, SSM_GROUP)
    lr = lam_re.astype(f32)
    li = lam_im.astype(f32)
    dt = jnp.exp(log_dt.astype(f32))[:, None]
    mag = jnp.exp(lr * dt)
    abar_re = mag * jnp.cos(li * dt)
    abar_im = mag * jnp.sin(li * dt)
    den = lr * lr + li * li
    nr = abar_re - 1.0
    ni = abar_im
    q_re = (nr * lr + ni * li) / den
    q_im = (ni * lr - nr * li) / den
    bb_re, bb_im = cmul(q_re[..., None], q_im[..., None], b_re.astype(f32), b_im.astype(f32))
    drive_re = jnp.einsum("btgc,gnc->btgn", uf, bb_re)
    drive_im = jnp.einsum("btgc,gnc->btgn", uf, bb_im)
    a_re = jnp.broadcast_to(abar_re, (1, t_len, SSM_GROUPS, SSM_STATE))
    a_im = jnp.broadcast_to(abar_im, (1, t_len, SSM_GROUPS, SSM_STATE))

    def combine(e1, e2):
        a1r, a1i, b1r, b1i = e1
        a2r, a2i, b2r, b2i = e2
        ar, ai = cmul(a2r, a2i, a1r, a1i)
        br, bi = cmul(a2r, a2i, b1r, b1i)
        return ar, ai, br + b2r, bi + b2i

    _, _, s_re, s_im = lax.associative_scan(combine, (a_re, a_im, drive_re, drive_im), axis=1)
    y = (jnp.einsum("btgn,gcn->btgc", s_re, c_re.astype(f32))
         - jnp.einsum("btgn,gcn->btgc", s_im, c_im.astype(f32)))
    y = y.reshape(bsz, t_len, SSM_WIDTH) + d_skip.astype(f32) * uf.reshape(bsz, t_len, SSM_WIDTH)
    y = jax.nn.gelu(y).astype(u.dtype)
    return y * jax.nn.sigmoid(y @ w_glu)


def _heads(t):
    return t.reshape(t.shape[0], t.shape[1], RWKV_HEADS, RWKV_HEAD)


def rwkv7_recurrence(r, w, k, v, a, b):
    bsz = r.shape[0]

    def step(s, inp):
        r_t, w_t, k_t, v_t, a_t, b_t = inp
        sa = jnp.einsum("bhvk,bhk->bhv", s, a_t)
        s = s * w_t[:, :, None, :] + sa[..., None] * b_t[:, :, None, :] + v_t[..., None] * k_t[:, :, None, :]
        return s, jnp.einsum("bhvk,bhk->bhv", s, r_t)

    s0 = jnp.zeros((bsz, RWKV_HEADS, RWKV_HEAD, RWKV_HEAD), jnp.float32)
    xs = tuple(jnp.moveaxis(t, 1, 0) for t in (r, w, k, v, a, b))
    _, out = lax.scan(step, s0, xs)
    return jnp.moveaxis(out, 0, 1)


def rwkv7_branch(r, k, v, xw, xa, xg, w0, w2, a0, a2, g2, k_k, k_a, r_k, lnx_w, lnx_b):
    f32 = jnp.float32
    bsz, t_len, _ = r.shape
    w_log = -jax.nn.softplus(-(w0 + jnp.tanh(xw) @ w2)) - 0.5
    decay = jnp.exp(-jnp.exp(w_log.astype(f32)))
    iclr = jax.nn.sigmoid(a0 + xa @ a2)
    gate = jax.nn.sigmoid(xg) @ g2
    kk = _heads(k * k_k).astype(f32)
    kk = kk * lax.rsqrt(jnp.sum(kk * kk, axis=-1, keepdims=True) + 1e-12)
    k = k * (1.0 + (iclr - 1.0) * k_a)
    r_h = _heads(r).astype(f32)
    k_h = _heads(k).astype(f32)
    v_h = _heads(v).astype(f32)
    iclr_h = _heads(iclr).astype(f32)
    o = rwkv7_recurrence(r_h, _heads(decay), k_h, v_h, -kk, kk * iclr_h)
    mean = jnp.mean(o, axis=-1, keepdims=True)
    var = jnp.mean(jnp.square(o - mean), axis=-1, keepdims=True)
    o = (o - mean) * lax.rsqrt(var + LNX_EPS)
    bonus = jnp.sum(r_h * k_h * r_k.astype(f32), axis=-1, keepdims=True) * v_h
    o = (o.reshape(bsz, t_len, RWKV_WIDTH).astype(r.dtype) * lnx_w + lnx_b
         + bonus.reshape(bsz, t_len, RWKV_WIDTH).astype(r.dtype))
    return o * gate


def setup_inputs(seed: int = 0) -> dict:
    key = jax.random.key(seed)
    ks = iter(jax.random.split(key, 64))
    f32 = jnp.float32
    L = DEPTH
    Lr = DEPTH - 1
    G, N, C = SSM_GROUPS, SSM_STATE, SSM_GROUP

    def nrm(shape, scale):
        return scale * jax.random.normal(next(ks), shape, f32)

    def gain(shape):
        return 1.0 + nrm(shape, 0.02)

    def unif(shape, lo, hi):
        return jax.random.uniform(next(ks), shape, f32, lo, hi)

    n_idx = jnp.arange(SSM_STATE, dtype=f32)
    d_in = D_MODEL ** -0.5
    return {
        "x": nrm((BATCH, SEQ, D_MODEL), 1.0),
        "meta_tokens": nrm((N_META, D_MODEL), 1.0),
        "ffn1_norm": gain((L, D_MODEL)),
        "ffn1_w_gate": nrm((L, D_MODEL, D_FF), d_in),
        "ffn1_w_up": nrm((L, D_MODEL, D_FF), d_in),
        "ffn1_w_down": nrm((L, D_FF, D_MODEL), D_FF ** -0.5),
        "mix_norm": gain((L, D_MODEL)),
        "w_in_first": nrm((D_MODEL, P_COMMON), d_in),
        "w_in_rest": nrm((Lr, D_MODEL, P_REST), d_in),
        "mu_shift": unif((L, SHIFT_HI - SHIFT_LO), 0.0, 1.0),
        "mu_vres": unif((Lr, LORA_VRES), 0.0, 1.0),
        "ssm_lambda_re": -0.5 + nrm((L, G, N), 0.01),
        "ssm_lambda_im": math.pi * n_idx + nrm((L, G, N), 0.01),
        "ssm_log_dt": unif((L, G), math.log(DT_MIN), math.log(DT_MAX)),
        "ssm_b_re": nrm((L, G, N, C), (2.0 * C) ** -0.5),
        "ssm_b_im": nrm((L, G, N, C), (2.0 * C) ** -0.5),
        "ssm_c_re": nrm((L, G, C, N), N ** -0.5),
        "ssm_c_im": nrm((L, G, C, N), N ** -0.5),
        "ssm_d": nrm((L, SSM_WIDTH), 0.5),
        "ssm_w_glu": nrm((L, SSM_WIDTH, SSM_WIDTH), SSM_WIDTH ** -0.5),
        "rwkv_w0": unif((L, RWKV_WIDTH), -6.0, -1.0),
        "rwkv_w2": nrm((L, LORA_DECAY, RWKV_WIDTH), 0.5 * LORA_DECAY ** -0.5),
        "rwkv_a0": nrm((L, RWKV_WIDTH), 0.1),
        "rwkv_a2": nrm((L, LORA_ICLR, RWKV_WIDTH), 0.5 * LORA_ICLR ** -0.5),
        "rwkv_v0": nrm((Lr, RWKV_WIDTH), 0.1),
        "rwkv_v2": nrm((Lr, LORA_VRES, RWKV_WIDTH), 0.5 * LORA_VRES ** -0.5),
        "rwkv_g2": nrm((L, LORA_GATE, RWKV_WIDTH), LORA_GATE ** -0.5),
        "rwkv_k_k": 0.85 + nrm((L, RWKV_WIDTH), 0.02),
        "rwkv_k_a": gain((L, RWKV_WIDTH)),
        "rwkv_r_k": nrm((L, RWKV_HEADS, RWKV_HEAD), 0.1),
        "rwkv_lnx_w": gain((L, RWKV_WIDTH)),
        "rwkv_lnx_b": nrm((L, RWKV_WIDTH), 0.01),
        "w_up_ssm": nrm((L, SSM_WIDTH, D_MODEL), SSM_WIDTH ** -0.5),
        "w_up_rwkv": nrm((L, RWKV_WIDTH, D_MODEL), RWKV_WIDTH ** -0.5),
        "w_out": nrm((L, D_MODEL, D_MODEL), d_in),
        "ffn2_norm": gain((L, D_MODEL)),
        "ffn2_w_gate": nrm((L, D_MODEL, D_FF), d_in),
        "ffn2_w_up": nrm((L, D_MODEL, D_FF), d_in),
        "ffn2_w_down": nrm((L, D_FF, D_MODEL), D_FF ** -0.5),
        "final_norm": gain((D_MODEL,)),
    }


def reference(x, meta_tokens, ffn1_norm, ffn1_w_gate, ffn1_w_up, ffn1_w_down, mix_norm,
              w_in_first, w_in_rest, mu_shift, mu_vres,
              ssm_lambda_re, ssm_lambda_im, ssm_log_dt, ssm_b_re, ssm_b_im, ssm_c_re, ssm_c_im,
              ssm_d, ssm_w_glu,
              rwkv_w0, rwkv_w2, rwkv_a0, rwkv_a2, rwkv_v0, rwkv_v2, rwkv_g2,
              rwkv_k_k, rwkv_k_a, rwkv_r_k, rwkv_lnx_w, rwkv_lnx_b,
              w_up_ssm, w_up_rwkv, w_out,
              ffn2_norm, ffn2_w_gate, ffn2_w_up, ffn2_w_down, final_norm):
    bsz = x.shape[0]
    meta = jnp.broadcast_to(meta_tokens[None].astype(x.dtype), (bsz, N_META, D_MODEL))
    h_res = jnp.concatenate([meta, x], axis=1)
    v_first = None
    for i in range(DEPTH):
        h = rms_norm(h_res, ffn1_norm[i])
        h_res = h_res + 0.5 * swiglu(h, ffn1_w_gate[i], ffn1_w_up[i], ffn1_w_down[i])

        h = rms_norm(h_res, mix_norm[i])
        p = h @ (w_in_first if i == 0 else w_in_rest[i - 1])
        u = p[..., COL_U:COL_R]
        p_rw = p[..., SHIFT_LO:SHIFT_HI]
        p_rw = p_rw + mu_shift[i] * (token_shift(p_rw) - p_rw)
        xr = p_rw[..., COL_R - SHIFT_LO:COL_K - SHIFT_LO]
        xk = p_rw[..., COL_K - SHIFT_LO:COL_V - SHIFT_LO]
        xv = p_rw[..., COL_V - SHIFT_LO:COL_W - SHIFT_LO]
        xw = p_rw[..., COL_W - SHIFT_LO:COL_A - SHIFT_LO]
        xa = p_rw[..., COL_A - SHIFT_LO:COL_G - SHIFT_LO]
        xg = p_rw[..., COL_G - SHIFT_LO:COL_GATE_A - SHIFT_LO]
        if i == 0:
            v_first = xv
            v = xv
        else:
            xvr = p[..., P_COMMON:P_REST]
            xvr = xvr + mu_vres[i - 1] * (token_shift(xvr) - xvr)
            v = xv + (v_first - xv) * jax.nn.sigmoid(rwkv_v0[i - 1] + xvr @ rwkv_v2[i - 1])

        y_a = s5_branch(u, ssm_lambda_re[i], ssm_lambda_im[i], ssm_log_dt[i], ssm_b_re[i], ssm_b_im[i],
                        ssm_c_re[i], ssm_c_im[i], ssm_d[i], ssm_w_glu[i])
        y_b = rwkv7_branch(xr, xk, v, xw, xa, xg, rwkv_w0[i], rwkv_w2[i], rwkv_a0[i], rwkv_a2[i],
                           rwkv_g2[i], rwkv_k_k[i], rwkv_k_a[i], rwkv_r_k[i], rwkv_lnx_w[i], rwkv_lnx_b[i])
        g_a = jax.nn.sigmoid(p[..., COL_GATE_A:COL_GATE_B])
        g_b = jax.nn.sigmoid(p[..., COL_GATE_B:P_COMMON])
        merged = g_a * (y_a @ w_up_ssm[i]) + g_b * (y_b @ w_up_rwkv[i])
        h_res = h_res + merged @ w_out[i]

        h = rms_norm(h_res, ffn2_norm[i])
        h_res = h_res + 0.5 * swiglu(h, ffn2_w_gate[i], ffn2_w_up[i], ffn2_w_down[i])
    out = rms_norm(h_res, final_norm)
    return out[:, N_META:]
```

```cpp
#include <hip/hip_runtime.h>
#include <cstdio>
#include <cstdint>
namespace pg8 {
#define PG8_LAS __attribute__((address_space(3)))
#define PG8_GAS __attribute__((address_space(1)))
typedef unsigned short bf16_t;
typedef short bf16x8 __attribute__((ext_vector_type(8)));
typedef _Float16 f16x8 __attribute__((ext_vector_type(8)));
typedef float f32x4 __attribute__((ext_vector_type(4)));
typedef unsigned u32x4 __attribute__((ext_vector_type(4)));
constexpr int BM = 256, BK = 64, HALF = 128, HTB = HALF * BK * 2  , STAGE_BYTES = 8 * HTB, NXCD = 8, WGM = 8;

__host__ __device__ __forceinline__ int lds_byte(int r, int c) { const int st = (r >> 4) * 2 + (c >> 5), rr = r & 15, cc = c & 31, ob = rr * 64 + cc * 2; return st * 1024 + (ob ^ (((ob >> 9) & 1) << 5)); }
__host__ __device__ __forceinline__ void stage_rc(int b, int& R, int& C) { const int st = b / 1024, sb = b % 1024, swz = sb ^ (((sb >> 9) & 1) << 5); R = (st >> 1) * 16 + swz / 64; C = (st & 1) * 32 + (swz % 64) / 2; }
__host__ __device__ __forceinline__ int perm32(int rho) { const int n = rho >> 4, i = rho & 15; return 8 * (i >> 2) + 4 * n + (i & 3); }

struct Unit { int pm, pn; };
struct Gemm { const PG8_GAS bf16_t* A; const PG8_GAS bf16_t* Bt; int M, N, K; };

struct StaticOrder {
    int nM, nN, nwg, G, c;
    __host__ __device__ void init(int M, int N, int G_, int c_) { nM = M / BM; nN = N / BM; nwg = nM * nN; G = G_; c = c_; }
    __host__ __device__ bool next(int i, Unit& u) const {
        const long L = (long)i * G + c; if (L >= nwg) return false;
        int wgid = (int)L; { const int q = nwg / NXCD, r = nwg % NXCD, xcd = wgid % NXCD, off = wgid / NXCD; wgid = (xcd < r ? xcd * (q + 1) : r * (q + 1) + (xcd - r) * q) + off; }
        const int nig = WGM * nN, gid = wgid / nig, fm = gid * WGM, gsz = (nM - fm) < WGM ? (nM - fm) : WGM;
        u.pm = fm + ((wgid % nig) % gsz); u.pn = (wgid % nig) / gsz;
#if defined(__HIP_DEVICE_COMPILE__)
        u.pm = __builtin_amdgcn_readfirstlane(u.pm); u.pn = __builtin_amdgcn_readfirstlane(u.pn);
#endif
        return true;
    }
    __device__ __forceinline__ void a_ready(const Unit&) const {}
    __device__ __forceinline__ void done(const Unit&) const {}
};

__device__ __forceinline__ unsigned cvt_pk_bf16(float lo, float hi) { unsigned r; asm volatile("v_cvt_pk_bf16_f32 %0, %1, %2" : "=v"(r) : "v"(lo), "v"(hi)); return r; }
typedef float f32x2 __attribute__((ext_vector_type(2)));
__device__ __forceinline__ f32x2 gelu_pk(f32x2 v) {
    const f32x2 av = __builtin_elementwise_abs(v), d = av * 0.2316418882f + 1.0f;
    f32x2 t; t.x = __builtin_amdgcn_rcpf(d.x); t.y = __builtin_amdgcn_rcpf(d.y);
    f32x2 q = t * 0.5307027145f + (-0.7265760135f); q = q * t + 0.7107068705f; q = q * t + (-0.142248368f); q = q * t + 0.127414796f; q = q * t;
    const f32x2 s = (v * v) * (-0.72134752044f);
    f32x2 e; e.x = __builtin_amdgcn_exp2f(s.x); e.y = __builtin_amdgcn_exp2f(s.y);
    const f32x2 m = v * (q * e), r = v - m;
    f32x2 o; o.x = v.x < 0.f ? m.x : r.x; o.y = v.y < 0.f ? m.y : r.y; return o;
}

template <int ACT  > struct EpiBf16 {
    static constexpr bool PERM = true, AFTER_DRAIN = false; static_assert(ACT == 0 || ACT == 1, "EpiBf16: ACT is 0 (none) or 1 (gelu_pk)");
    bf16_t* O; int ldc; const float* bias; int split_cols; size_t split_stride; float scale0;
    __device__ __forceinline__ void operator()(const f32x4 (&acc)[2][2][4][2], const Unit& u, int wr, int wc, int fr, int fq) const {
        const int row0 = u.pm * BM + wr * 64 + fr; int colt = u.pn * BM; bf16_t* base = O;
        float sc = 1.f; if (split_cols) { const int t = colt / split_cols; base += (size_t)t * split_stride; colt -= t * split_cols; if (t == 0) sc = scale0; }
        const int col0 = colt + wc * 32 + 8 * fq, bcol0 = u.pn * BM + wc * 32 + 8 * fq;
        f32x4 bv[2][2];
#pragma unroll
        for (int bj = 0; bj < 2; ++bj)
#pragma unroll
            for (int n = 0; n < 2; ++n) bv[bj][n] = bias ? *(const f32x4*)(bias + bcol0 + bj * HALF + 4 * n) : (f32x4){0.f, 0.f, 0.f, 0.f};
#pragma unroll
        for (int ai = 0; ai < 2; ++ai)
#pragma unroll
            for (int m = 0; m < 4; ++m) { bf16_t* rowp = base + (size_t)(row0 + ai * HALF + m * 16) * ldc + col0;
#pragma unroll
                for (int bj = 0; bj < 2; ++bj) { f32x4 v0 = acc[ai][bj][m][0] + bv[bj][0], v1 = acc[ai][bj][m][1] + bv[bj][1];
                    if (ACT == 1) { f32x2 a = gelu_pk((f32x2){v0[0], v0[1]}), b = gelu_pk((f32x2){v0[2], v0[3]}), c = gelu_pk((f32x2){v1[0], v1[1]}), d = gelu_pk((f32x2){v1[2], v1[3]});
                        v0 = (f32x4){a.x, a.y, b.x, b.y}; v1 = (f32x4){c.x, c.y, d.x, d.y}; }
                    v0 = v0 * sc; v1 = v1 * sc; u32x4 w; w.x = cvt_pk_bf16(v0[0], v0[1]); w.y = cvt_pk_bf16(v0[2], v0[3]); w.z = cvt_pk_bf16(v1[0], v1[1]); w.w = cvt_pk_bf16(v1[2], v1[3]);
                    *(u32x4*)(rowp + bj * HALF) = w; } }
    }
};


template <class Epi, class Sched, bool ALIGN_EPI = false, bool SP2 = false, bool F16 = false>
__device__ __forceinline__ void gemm_phase(PG8_LAS unsigned char* lds, const Gemm g, const Sched& S, const Epi& E, const int tid) {
    const int wid = __builtin_amdgcn_readfirstlane(tid >> 6), lane = tid & 63, wr = wid >> 2, wc = wid & 3, fr = lane & 15, fq = lane >> 4;
    const int K = g.K, nt = K / BK;
    unsigned voffA[2], voffB[2];
#pragma unroll
    for (int i = 0; i < 2; ++i) { int R, C; stage_rc(tid * 16 + i * 8192, R, C); const int Rb = Epi::PERM ? ((R & ~31) + perm32(R & 31)) : R;
        voffA[i] = (unsigned)(R * K + C) * 2u; voffB[i] = (unsigned)(Rb * K + C) * 2u; }
    const size_t kstep = (size_t)(BK * 2);
    const size_t hstep = (size_t)HALF * K * 2;
    const size_t tstep = 2 * hstep;
    const unsigned ldsw = (unsigned)wid * 1024u;
    const int aoff = lds_byte(wr * 64 + fr, fq * 8), boff = lds_byte(wc * 32 + fr, fq * 8);
#define PG8_SA(b, h) (((b) * 2 + (h)) * HTB)
#define PG8_SB(b, h) ((4 + (b) * 2 + (h)) * HTB)
#define PG8_STAGE(bufoff, gbase, voff) do { _Pragma("unroll") for (int _i = 0; _i < 2; ++_i) \
        __builtin_amdgcn_global_load_lds((const PG8_GAS unsigned*)((const PG8_GAS char*)(gbase) + (voff)[_i]), (PG8_LAS unsigned*)(lds + (bufoff) + ldsw + _i * 8192), 16, 0, 0); } while (0)
#define PG8_LDA(dst, b, h) do { _Pragma("unroll") for (int m = 0; m < 4; ++m) _Pragma("unroll") for (int k = 0; k < 2; ++k) dst[m][k] = *(const PG8_LAS bf16x8*)(lds + PG8_SA(b, h) + aoff + m * 2048 + k * 1024); } while (0)
#define PG8_LDB(dst, b, h) do { _Pragma("unroll") for (int n = 0; n < 2; ++n) _Pragma("unroll") for (int k = 0; k < 2; ++k) dst[n][k] = *(const PG8_LAS bf16x8*)(lds + PG8_SB(b, h) + boff + n * 2048 + k * 1024); } while (0)
#define PG8_MMA(ai, bj, At, Bt) do { __builtin_amdgcn_s_setprio(1); _Pragma("unroll") for (int m = 0; m < 4; ++m) _Pragma("unroll") for (int n = 0; n < 2; ++n) _Pragma("unroll") for (int k = 0; k < 2; ++k) \
        acc[ai][bj][m][n] = F16 ? __builtin_amdgcn_mfma_f32_16x16x32_f16(__builtin_bit_cast(f16x8, Bt[n][k]), __builtin_bit_cast(f16x8, At[m][k]), acc[ai][bj][m][n], 0, 0, 0) \
                                : __builtin_amdgcn_mfma_f32_16x16x32_bf16(Bt[n][k], At[m][k], acc[ai][bj][m][n], 0, 0, 0); __builtin_amdgcn_s_setprio(0); } while (0)
#define PG8_WAIT_V(n) asm volatile("s_waitcnt vmcnt(" #n ")" ::: "memory")
#define PG8_WAIT_L(n) asm volatile("s_waitcnt lgkmcnt(" #n ")" ::: "memory")
#define PG8_BAR __builtin_amdgcn_s_barrier()
#define PG8_SCHED __builtin_amdgcn_sched_barrier(0)
    Unit cur, nxt; int ui = 0;
    if (!S.next(0, cur)) return;
    f32x4 acc[2][2][4][2];
#pragma unroll
    for (int a = 0; a < 2; ++a)
#pragma unroll
        for (int b = 0; b < 2; ++b)
#pragma unroll
            for (int m = 0; m < 4; ++m)
#pragma unroll
                for (int n = 0; n < 2; ++n) acc[a][b][m][n] = (f32x4){0.f, 0.f, 0.f, 0.f};
    bf16x8 At[4][2], B0[2][2], B1[2][2];
    const PG8_GAS char* cA = (const PG8_GAS char*)g.A + (size_t)cur.pm * tstep; const PG8_GAS char* cB = (const PG8_GAS char*)g.Bt + (size_t)cur.pn * tstep;
    S.a_ready(cur);
    if constexpr (SP2) {
        PG8_STAGE(PG8_SB(0, 0), cB, voffB); PG8_STAGE(PG8_SB(0, 1), cB + hstep, voffB); PG8_STAGE(PG8_SA(0, 0), cA, voffA); PG8_STAGE(PG8_SA(0, 1), cA + hstep, voffA);
        if (wr == 1) PG8_BAR;
        PG8_WAIT_V(2); PG8_BAR;
        PG8_STAGE(PG8_SB(1, 0), cB + kstep, voffB); PG8_STAGE(PG8_SA(1, 0), cA + kstep, voffA); PG8_STAGE(PG8_SB(1, 1), cB + hstep + kstep, voffB);
        PG8_WAIT_V(6); PG8_BAR;
    } else {
        PG8_STAGE(PG8_SB(0, 0), cB, voffB); PG8_STAGE(PG8_SA(0, 0), cA, voffA); PG8_STAGE(PG8_SB(0, 1), cB + hstep, voffB); PG8_STAGE(PG8_SA(0, 1), cA + hstep, voffA);
        if (wr == 1) PG8_BAR;
        PG8_WAIT_V(4); PG8_BAR;
        PG8_STAGE(PG8_SB(1, 0), cB + kstep, voffB); PG8_STAGE(PG8_SA(1, 0), cA + kstep, voffA); PG8_STAGE(PG8_SB(1, 1), cB + hstep + kstep, voffB);
        PG8_WAIT_V(6); PG8_BAR;
    }
    for (;;) {
        const bool has_next = S.next(ui + 1, nxt);
        const PG8_GAS char* nA = has_next ? (const PG8_GAS char*)g.A + (size_t)nxt.pm * tstep : cA; const PG8_GAS char* nB = has_next ? (const PG8_GAS char*)g.Bt + (size_t)nxt.pn * tstep : cB;
        for (int t = 0; t < nt; t += 2) {
            const bool last = (t == nt - 2);
            const PG8_GAS char* a1 = cA + (size_t)(t + 1) * kstep;
            const PG8_GAS char* a2 = last ? nA : cA + (size_t)(t + 2) * kstep; const PG8_GAS char* b2 = last ? nB : cB + (size_t)(t + 2) * kstep;
            const PG8_GAS char* a3 = a2 + kstep; const PG8_GAS char* b3 = b2 + kstep;
            if (last && has_next) S.a_ready(nxt);
            if constexpr (SP2) {
            PG8_LDB(B0, 0, 0); PG8_LDB(B1, 0, 1); PG8_SCHED; PG8_LDA(At, 0, 0); PG8_STAGE(PG8_SA(1, 1), a1 + hstep, voffA);
            PG8_WAIT_V(8); PG8_WAIT_L(0); PG8_BAR; PG8_MMA(0, 0, At, B0); PG8_MMA(0, 1, At, B1); PG8_BAR; PG8_SCHED;
            PG8_LDA(At, 0, 1); PG8_STAGE(PG8_SB(0, 0), b2, voffB); PG8_STAGE(PG8_SB(0, 1), b2 + hstep, voffB); PG8_STAGE(PG8_SA(0, 0), a2, voffA);
            PG8_WAIT_V(8); PG8_WAIT_L(0); PG8_BAR; PG8_MMA(1, 0, At, B0); PG8_MMA(1, 1, At, B1); PG8_BAR; PG8_SCHED;
            PG8_LDB(B0, 1, 0); PG8_LDB(B1, 1, 1); PG8_SCHED; PG8_LDA(At, 1, 0); PG8_STAGE(PG8_SA(0, 1), a2 + hstep, voffA);
            PG8_WAIT_V(8); PG8_WAIT_L(0); PG8_BAR; PG8_MMA(0, 0, At, B0); PG8_MMA(0, 1, At, B1); PG8_BAR; PG8_SCHED;
            PG8_LDA(At, 1, 1); PG8_STAGE(PG8_SB(1, 0), b3, voffB); PG8_STAGE(PG8_SB(1, 1), b3 + hstep, voffB); PG8_STAGE(PG8_SA(1, 0), a3, voffA);
            PG8_WAIT_V(8); PG8_WAIT_L(0); PG8_BAR; PG8_MMA(1, 0, At, B0); PG8_MMA(1, 1, At, B1); PG8_BAR; PG8_SCHED;
            } else {
            PG8_LDB(B0, 0, 0); PG8_SCHED; PG8_LDA(At, 0, 0); PG8_STAGE(PG8_SA(1, 1), a1 + hstep, voffA);
            PG8_WAIT_L(8); PG8_BAR; PG8_WAIT_L(0); PG8_MMA(0, 0, At, B0); PG8_BAR; PG8_SCHED;
            PG8_LDB(B1, 0, 1); PG8_STAGE(PG8_SB(0, 0), b2, voffB);
            PG8_BAR; PG8_WAIT_L(0); PG8_MMA(0, 1, At, B1); PG8_BAR;
            PG8_LDA(At, 0, 1); PG8_STAGE(PG8_SA(0, 0), a2, voffA);
            PG8_BAR; PG8_WAIT_L(0); PG8_MMA(1, 0, At, B0); PG8_BAR; PG8_SCHED;
            PG8_STAGE(PG8_SB(0, 1), b2 + hstep, voffB);
            PG8_WAIT_V(6); PG8_BAR; PG8_MMA(1, 1, At, B1); PG8_BAR;
            PG8_LDB(B0, 1, 0); PG8_SCHED; PG8_LDA(At, 1, 0); PG8_STAGE(PG8_SA(0, 1), a2 + hstep, voffA);
            PG8_WAIT_L(8); PG8_BAR; PG8_WAIT_L(0); PG8_MMA(0, 0, At, B0); PG8_BAR; PG8_SCHED;
            PG8_LDB(B1, 1, 1); PG8_STAGE(PG8_SB(1, 0), b3, voffB);
            PG8_BAR; PG8_WAIT_L(0); PG8_MMA(0, 1, At, B1); PG8_BAR;
            PG8_LDA(At, 1, 1); PG8_STAGE(PG8_SA(1, 0), a3, voffA);
            PG8_BAR; PG8_WAIT_L(0); PG8_MMA(1, 0, At, B0); PG8_BAR; PG8_SCHED;
            PG8_STAGE(PG8_SB(1, 1), b3 + hstep, voffB);
            PG8_WAIT_V(6); PG8_BAR; PG8_MMA(1, 1, At, B1); PG8_BAR;
            }
        }
        if constexpr (ALIGN_EPI) { if (wr == 0) PG8_BAR; }
        if constexpr (!Epi::AFTER_DRAIN) { E(acc, cur, wr, wc, fr, fq); S.done(cur); }
        if (!has_next) break;
#pragma unroll
        for (int a = 0; a < 2; ++a)
#pragma unroll
            for (int b = 0; b < 2; ++b)
#pragma unroll
                for (int m = 0; m < 4; ++m)
#pragma unroll
                    for (int n = 0; n < 2; ++n) acc[a][b][m][n] = (f32x4){0.f, 0.f, 0.f, 0.f};
        cur = nxt; cA = nA; cB = nB; ++ui;
        if constexpr (ALIGN_EPI) { if (wr == 1) PG8_BAR; }
    }
    PG8_WAIT_V(0);
    if constexpr (!ALIGN_EPI) { if (wr == 0) PG8_BAR; }
    PG8_BAR;
    if constexpr (Epi::AFTER_DRAIN) { E.fused(acc, cur, wr, wc, fr, fq, lds, wid, lane); S.done(cur); }
#undef PG8_SA
#undef PG8_SB
#undef PG8_STAGE
#undef PG8_LDA
#undef PG8_LDB
#undef PG8_MMA
#undef PG8_WAIT_V
#undef PG8_WAIT_L
#undef PG8_BAR
#undef PG8_SCHED
}
}
namespace pg8 {
constexpr int XD = 2048;
#define EPI_FENCE() asm volatile("" ::: "memory")
__device__ __forceinline__ float add_xor_lane(float s, int lane, int mask) { return s + __builtin_bit_cast(float, __builtin_amdgcn_ds_bpermute((lane ^ mask) << 2, __builtin_bit_cast(int, s))); }
__device__ __forceinline__ float sigmoidf_(float x) { return __builtin_amdgcn_rcpf(1.0f + __expf(-x)); }
__device__ __forceinline__ u32x4 pack8(const f32x4 v0, const f32x4 v1) {
    u32x4 w; w.x = cvt_pk_bf16(v0[0], v0[1]); w.y = cvt_pk_bf16(v0[2], v0[3]); w.z = cvt_pk_bf16(v1[0], v1[1]); w.w = cvt_pk_bf16(v1[2], v1[3]); return w;
}
__device__ __forceinline__ void unpack8(const u32x4 w, f32x4& v0, f32x4& v1) {
    v0[0] = __uint_as_float(w.x << 16); v0[1] = __uint_as_float(w.x & 0xffff0000u); v0[2] = __uint_as_float(w.y << 16); v0[3] = __uint_as_float(w.y & 0xffff0000u);
    v1[0] = __uint_as_float(w.z << 16); v1[1] = __uint_as_float(w.z & 0xffff0000u); v1[2] = __uint_as_float(w.w << 16); v1[3] = __uint_as_float(w.w & 0xffff0000u);
}
constexpr float SS_SCALE = 1048576.0f, SS_INV_SCALE = 1.0f / 1048576.0f;
typedef unsigned long long ss_t;
typedef _Float16 f16x2 __attribute__((ext_vector_type(2)));
__device__ __forceinline__ unsigned pkh2(float lo, float hi) { return __builtin_bit_cast(unsigned, (f16x2){(_Float16)lo, (_Float16)hi}); }
__device__ __forceinline__ u32x4 packh8(const f32x4 v0, const f32x4 v1) { u32x4 w; w.x = pkh2(v0[0], v0[1]); w.y = pkh2(v0[2], v0[3]); w.z = pkh2(v1[0], v1[1]); w.w = pkh2(v1[2], v1[3]); return w; }
__device__ __forceinline__ void unpackh2(unsigned w, float& lo, float& hi) { const f16x2 h = __builtin_bit_cast(f16x2, w); lo = (float)h[0]; hi = (float)h[1]; }
__device__ __forceinline__ void unpackh8(const u32x4 w, f32x4& v0, f32x4& v1) { float a, b, c, d, e, f, g, h; unpackh2(w.x, a, b); unpackh2(w.y, c, d); unpackh2(w.z, e, f); unpackh2(w.w, g, h); v0 = (f32x4){a, b, c, d}; v1 = (f32x4){e, f, g, h}; }
__device__ __forceinline__ void row_invs(const PG8_GAS ss_t* ss, int row0, float (&inv)[2][4]) {
    ss_t raw[2][4];
#pragma unroll
    for (int ai = 0; ai < 2; ++ai)
#pragma unroll
        for (int m = 0; m < 4; ++m) raw[ai][m] = ss[row0 + ai * HALF + m * 16];
#pragma unroll
    for (int ai = 0; ai < 2; ++ai)
#pragma unroll
        for (int m = 0; m < 4; ++m) inv[ai][m] = rsqrtf((float)(long long)raw[ai][m] * (SS_INV_SCALE / (float)XD) + 1e-6f);
}

__device__ __forceinline__ void row_invs_lds(const PG8_LAS float* tab, int pm, int r0, float (&inv)[2][4]) {
#pragma unroll
    for (int ai = 0; ai < 2; ++ai)
#pragma unroll
        for (int m = 0; m < 4; ++m) inv[ai][m] = tab[(pm & 7) * BM + r0 + ai * HALF + m * 16];
}
struct EpiSwiglu {
    static constexpr bool PERM = true, AFTER_DRAIN = false;
    const PG8_GAS ss_t* ss; PG8_GAS bf16_t* act; int ldc; const PG8_LAS float* tab;
    __device__ __forceinline__ void operator()(const f32x4 (&acc)[2][2][4][2], const Unit& u, int wr, int wc, int fr, int fq) const {
        const int row0 = u.pm * BM + wr * 64 + fr, col0 = u.pn * HALF + wc * 32 + 8 * fq;
        float inv[2][4]; if (tab) row_invs_lds(tab, u.pm, wr * 64 + fr, inv); else row_invs(ss, row0, inv);
#pragma unroll
        for (int ai = 0; ai < 2; ++ai)
#pragma unroll
            for (int m = 0; m < 4; ++m) {
                const int row = row0 + ai * HALF + m * 16;
                f32x4 h[2];
#pragma unroll
                for (int n = 0; n < 2; ++n) {
                    const f32x4 g = acc[ai][0][m][n] * inv[ai][m], up = acc[ai][1][m][n] * inv[ai][m];
#pragma unroll
                    for (int j = 0; j < 4; ++j) h[n][j] = g[j] * sigmoidf_(g[j]) * up[j];
                }
                *(PG8_GAS u32x4*)(act + (size_t)row * ldc + col0) = pack8(h[0], h[1]);
            }
    }
    static constexpr bool THIN_PAIRED = true;
    __device__ __forceinline__ void thin(int row, int pn, int w, int fq, const f32x4 v0, const f32x4 v1) const {
        typedef unsigned u32x2v __attribute__((ext_vector_type(2)));
        const float inv = rsqrtf((float)(long long)ss[row] * (SS_INV_SCALE / (float)XD) + 1e-6f);
        f32x4 h;
#pragma unroll
        for (int j = 0; j < 4; ++j) { const float g = v0[j] * inv; h[j] = g * sigmoidf_(g) * (v1[j] * inv); }
        u32x2v o; o.x = cvt_pk_bf16(h[0], h[1]); o.y = cvt_pk_bf16(h[2], h[3]);
        *(PG8_GAS u32x2v*)(act + (size_t)row * ldc + pn * HALF + 16 * w + 4 * fq) = o;
    }
};

struct EpiResid {
    static constexpr bool PERM = true, AFTER_DRAIN = false;
    PG8_GAS bf16_t* X16; PG8_GAS bf16_t* XB; PG8_GAS ss_t* ss; float scale; int noss;
    __device__ __forceinline__ void operator()(const f32x4 (&acc)[2][2][4][2], const Unit& u, int wr, int wc, int fr, int fq) const {
        const int row0 = u.pm * BM + wr * 64 + fr, col0 = u.pn * BM + wc * 32 + 8 * fq;
#pragma unroll
        for (int ai = 0; ai < 2; ++ai)
#pragma unroll
            for (int m = 0; m < 4; ++m) {
                const int row = row0 + ai * HALF + m * 16; float s = 0.f;
                u32x4 xo[2];
#pragma unroll
                for (int bj = 0; bj < 2; ++bj) xo[bj] = *(const PG8_GAS u32x4*)(X16 + (size_t)row * XD + col0 + bj * HALF);
#pragma unroll
                for (int bj = 0; bj < 2; ++bj) {
                    f32x4 x0, x1; unpackh8(xo[bj], x0, x1);
                    x0 += acc[ai][bj][m][0] * scale; x1 += acc[ai][bj][m][1] * scale;
                    *(PG8_GAS u32x4*)(X16 + (size_t)row * XD + col0 + bj * HALF) = packh8(x0, x1);
                    *(PG8_GAS u32x4*)(XB + (size_t)row * XD + col0 + bj * HALF) = pack8(x0, x1);
                    s += ((x0[0] * x0[0] + x0[1] * x0[1]) + (x0[2] * x0[2] + x0[3] * x0[3])) + ((x1[0] * x1[0] + x1[1] * x1[1]) + (x1[2] * x1[2] + x1[3] * x1[3]));
                }
                s = add_xor_lane(s, fr + 16 * fq, 16); s = add_xor_lane(s, fr + 16 * fq, 32);
                if (fq == 0 && !noss) __hip_atomic_fetch_add(ss + row, (ss_t)(long long)(s * SS_SCALE + 0.5f), __ATOMIC_RELAXED, __HIP_MEMORY_SCOPE_AGENT);
                if (m & 1) EPI_FENCE();
            }
    }
    static constexpr bool THIN_PAIRED = false;
    __device__ __forceinline__ void thin(int row, int pn, int w, int fq, const f32x4 v0, const f32x4 v1) const {
        typedef unsigned u32x2v __attribute__((ext_vector_type(2)));
        float s = 0.f;
#pragma unroll
        for (int t = 0; t < 2; ++t) { const size_t off = (size_t)row * XD + pn * BM + 32 * w + 16 * t + 4 * fq;
            const u32x2v xo = *(const PG8_GAS u32x2v*)(X16 + off); const f32x4 d = (t ? v1 : v0) * scale;
            float x0, x1, x2, x3; unpackh2(xo.x, x0, x1); unpackh2(xo.y, x2, x3); x0 += d[0]; x1 += d[1]; x2 += d[2]; x3 += d[3];
            u32x2v o; o.x = pkh2(x0, x1); o.y = pkh2(x2, x3); *(PG8_GAS u32x2v*)(X16 + off) = o;
            o.x = cvt_pk_bf16(x0, x1); o.y = cvt_pk_bf16(x2, x3); *(PG8_GAS u32x2v*)(XB + off) = o;
            s += (x0 * x0 + x1 * x1) + (x2 * x2 + x3 * x3); }
        if (!noss) __hip_atomic_fetch_add(ss + row, (ss_t)(long long)(s * SS_SCALE + 0.5f), __ATOMIC_RELAXED, __HIP_MEMORY_SCOPE_AGENT);
    }
};

template <size_t O_U2, size_t O_RKV, size_t O_GA, size_t O_GB, size_t O_LIN, int mp> struct EpiWin {
    static constexpr bool PERM = true, AFTER_DRAIN = false;
    const PG8_GAS ss_t* ss; PG8_GAS unsigned char* ov; const PG8_LAS float* tab;
    __device__ __forceinline__ void operator()(const f32x4 (&acc)[2][2][4][2], const Unit& u, int wr, int wc, int fr, int fq) const {
        PG8_GAS bf16_t* U2 = (PG8_GAS bf16_t*)(ov + O_U2); PG8_GAS bf16_t* RKV = (PG8_GAS bf16_t*)(ov + O_RKV); PG8_GAS bf16_t* GA = (PG8_GAS bf16_t*)(ov + O_GA); PG8_GAS bf16_t* GB = (PG8_GAS bf16_t*)(ov + O_GB); PG8_GAS bf16_t* LIN = (PG8_GAS bf16_t*)(ov + O_LIN);
        const int row0 = u.pm * BM + wr * 64 + fr, cl = wc * 32 + 8 * fq; const int pn = u.pn;
        float inv[2][4]; if (tab) row_invs_lds(tab, u.pm, wr * 64 + fr, inv); else row_invs(ss, row0, inv);
#pragma unroll
        for (int ai = 0; ai < 2; ++ai)
#pragma unroll
            for (int m = 0; m < 4; ++m) {
                const int row = row0 + ai * HALF + m * 16;
#pragma unroll
                for (int bj = 0; bj < 2; ++bj) {
                    f32x4 v0 = acc[ai][bj][m][0] * inv[ai][m], v1 = acc[ai][bj][m][1] * inv[ai][m];
                    const int c = bj * HALF + cl;
                    PG8_GAS bf16_t* dst;
                    if (pn < 4) { const int ch = pn * BM + c, g = ch >> 4; dst = U2 + ((size_t)g * 1040 + (row >> 4)) * 256 + (row & 15) * 16 + (ch & 15); }
                    else if (pn < 16) { const int t = (pn - 4) >> 2; dst = RKV + ((size_t)t * mp + row) * 1024 + ((pn - 4) & 3) * BM + c; }
                    else if (pn < 32) {
#pragma unroll
                        for (int j = 0; j < 4; ++j) { v0[j] = sigmoidf_(v0[j]); v1[j] = sigmoidf_(v1[j]); }
                        dst = (pn < 24 ? GA + (size_t)row * XD + (pn - 16) * BM : GB + (size_t)row * XD + (pn - 24) * BM) + c;
                    } else dst = LIN + (size_t)row * 512 + (pn - 32) * BM + c;
                    __builtin_nontemporal_store(pack8(v0, v1), (PG8_GAS u32x4*)dst);
                }
            }
    }
    static constexpr bool THIN_PAIRED = false;
    __device__ __forceinline__ void thin(int row, int pn, int w, int fq, const f32x4 a0, const f32x4 a1) const {
        typedef unsigned u32x2v __attribute__((ext_vector_type(2)));
        PG8_GAS bf16_t* U2 = (PG8_GAS bf16_t*)(ov + O_U2); PG8_GAS bf16_t* RKV = (PG8_GAS bf16_t*)(ov + O_RKV); PG8_GAS bf16_t* GA = (PG8_GAS bf16_t*)(ov + O_GA); PG8_GAS bf16_t* GB = (PG8_GAS bf16_t*)(ov + O_GB); PG8_GAS bf16_t* LIN = (PG8_GAS bf16_t*)(ov + O_LIN);
        const float inv = rsqrtf((float)(long long)ss[row] * (SS_INV_SCALE / (float)XD) + 1e-6f);
#pragma unroll
        for (int t = 0; t < 2; ++t) { f32x4 v = (t ? a1 : a0) * inv; const int c = 32 * w + 16 * t + 4 * fq;
            PG8_GAS bf16_t* dst;
            if (pn < 4) { const int ch = pn * BM + c, g = ch >> 4; dst = U2 + ((size_t)g * 1040 + (row >> 4)) * 256 + (row & 15) * 16 + (ch & 15); }
            else if (pn < 16) { const int tt = (pn - 4) >> 2; dst = RKV + ((size_t)tt * mp + row) * 1024 + ((pn - 4) & 3) * BM + c; }
            else if (pn < 32) {
#pragma unroll
                for (int j = 0; j < 4; ++j) v[j] = sigmoidf_(v[j]);
                dst = (pn < 24 ? GA + (size_t)row * XD + (pn - 16) * BM : GB + (size_t)row * XD + (pn - 24) * BM) + c;
            } else dst = LIN + (size_t)row * 512 + (pn - 32) * BM + c;
            u32x2v o; o.x = cvt_pk_bf16(v[0], v[1]); o.y = cvt_pk_bf16(v[2], v[3]); *(PG8_GAS u32x2v*)dst = o; }
    }
};

struct EpiGlu {
    static constexpr bool PERM = true, AFTER_DRAIN = false;
    const PG8_GAS bf16_t* aux; PG8_GAS bf16_t* out; int ldc;
    __device__ __forceinline__ void operator()(const f32x4 (&acc)[2][2][4][2], const Unit& u, int wr, int wc, int fr, int fq) const {
        const int row0 = u.pm * BM + wr * 64 + fr, col0 = u.pn * BM + wc * 32 + 8 * fq;
#pragma unroll
        for (int ai = 0; ai < 2; ++ai)
#pragma unroll
            for (int m = 0; m < 4; ++m) {
#pragma unroll
                for (int bj = 0; bj < 2; ++bj) {
                    const size_t off = (size_t)(row0 + ai * HALF + m * 16) * ldc + col0 + bj * HALF;
                    f32x4 a0, a1; unpack8(*(const PG8_GAS u32x4*)(aux + off), a0, a1);
                    f32x4 v0 = acc[ai][bj][m][0], v1 = acc[ai][bj][m][1];
#pragma unroll
                    for (int j = 0; j < 4; ++j) { v0[j] = a0[j] * sigmoidf_(v0[j]); v1[j] = a1[j] * sigmoidf_(v1[j]); }
                    *(PG8_GAS u32x4*)(out + off) = pack8(v0, v1);
                }
                if (m & 1) EPI_FENCE();
            }
    }
    static constexpr bool THIN_PAIRED = false;
    __device__ __forceinline__ void thin(int row, int pn, int w, int fq, const f32x4 a0, const f32x4 a1) const {
        typedef unsigned u32x2v __attribute__((ext_vector_type(2)));
#pragma unroll
        for (int t = 0; t < 2; ++t) { const size_t off = (size_t)row * ldc + pn * BM + 32 * w + 16 * t + 4 * fq; const f32x4 v = t ? a1 : a0;
            const u32x2v x = *(const PG8_GAS u32x2v*)(aux + off);
            const float x0 = __uint_as_float(x.x << 16), x1 = __uint_as_float(x.x & 0xffff0000u), x2 = __uint_as_float(x.y << 16), x3 = __uint_as_float(x.y & 0xffff0000u);
            u32x2v o; o.x = cvt_pk_bf16(x0 * sigmoidf_(v[0]), x1 * sigmoidf_(v[1])); o.y = cvt_pk_bf16(x2 * sigmoidf_(v[2]), x3 * sigmoidf_(v[3])); *(PG8_GAS u32x2v*)(out + off) = o; }
    }
};

template <bool ACCUM> struct EpiGateMul {
    static constexpr bool PERM = true, AFTER_DRAIN = false;
    const PG8_GAS bf16_t* gate; PG8_GAS bf16_t* out;
    __device__ __forceinline__ void operator()(const f32x4 (&acc)[2][2][4][2], const Unit& u, int wr, int wc, int fr, int fq) const {
        const int row0 = u.pm * BM + wr * 64 + fr, col0 = u.pn * BM + wc * 32 + 8 * fq;
#pragma unroll
        for (int ai = 0; ai < 2; ++ai)
#pragma unroll
            for (int m = 0; m < 4; ++m) {
#pragma unroll
                for (int bj = 0; bj < 2; ++bj) {
                    const size_t off = (size_t)(row0 + ai * HALF + m * 16) * XD + col0 + bj * HALF;
                    f32x4 g0, g1; unpack8(__builtin_nontemporal_load((const PG8_GAS u32x4*)(gate + off)), g0, g1);
                    f32x4 v0 = acc[ai][bj][m][0] * g0, v1 = acc[ai][bj][m][1] * g1;
                    if (ACCUM) { f32x4 p0, p1; unpack8(__builtin_nontemporal_load((const PG8_GAS u32x4*)(out + off)), p0, p1); v0 += p0; v1 += p1; }
                    *(PG8_GAS u32x4*)(out + off) = pack8(v0, v1);
                }
                if (m & 1) EPI_FENCE();
            }
    }
    static constexpr bool THIN_PAIRED = false;
    __device__ __forceinline__ void thin(int row, int pn, int w, int fq, const f32x4 a0, const f32x4 a1) const {
        typedef unsigned u32x2v __attribute__((ext_vector_type(2)));
#pragma unroll
        for (int t = 0; t < 2; ++t) { const size_t off = (size_t)row * XD + pn * BM + 32 * w + 16 * t + 4 * fq; const f32x4 v = t ? a1 : a0;
            const u32x2v x = *(const PG8_GAS u32x2v*)(gate + off);
            float r0 = v[0] * __uint_as_float(x.x << 16), r1 = v[1] * __uint_as_float(x.x & 0xffff0000u), r2 = v[2] * __uint_as_float(x.y << 16), r3 = v[3] * __uint_as_float(x.y & 0xffff0000u);
            if (ACCUM) { const u32x2v p = *(const PG8_GAS u32x2v*)(out + off); r0 += __uint_as_float(p.x << 16); r1 += __uint_as_float(p.x & 0xffff0000u); r2 += __uint_as_float(p.y << 16); r3 += __uint_as_float(p.y & 0xffff0000u); }
            u32x2v o; o.x = cvt_pk_bf16(r0, r1); o.y = cvt_pk_bf16(r2, r3); *(PG8_GAS u32x2v*)(out + off) = o; }
    }
};

template <size_t o_a, size_t o_b, size_t o_c, size_t o_d> struct EpiLora {
    static constexpr bool PERM = true, AFTER_DRAIN = false;
    PG8_GAS unsigned char* ov;
    __device__ __forceinline__ void operator()(const f32x4 (&acc)[2][2][4][2], const Unit& u, int wr, int wc, int fr, int fq) const {
        const int row0 = u.pm * BM + wr * 64 + fr, kind = u.pn >> 2, col0 = (u.pn & 3) * BM + wc * 32 + 8 * fq;
        PG8_GAS bf16_t* ob = (PG8_GAS bf16_t*)(ov + (kind == 0 ? o_a : kind == 1 ? o_b : kind == 2 ? o_c : o_d));
#pragma unroll
        for (int ai = 0; ai < 2; ++ai)
#pragma unroll
            for (int m = 0; m < 4; ++m)
#pragma unroll
                for (int bj = 0; bj < 2; ++bj)
                    *(PG8_GAS u32x4*)(ob + (size_t)(row0 + ai * HALF + m * 16) * 1024 + col0 + bj * HALF) = pack8(acc[ai][bj][m][0], acc[ai][bj][m][1]);
    }
    static constexpr bool THIN_PAIRED = false;
    __device__ __forceinline__ void thin(int row, int pn, int w, int fq, const f32x4 a0, const f32x4 a1) const {
        typedef unsigned u32x2v __attribute__((ext_vector_type(2)));
        const int kind = pn >> 2;
        PG8_GAS bf16_t* ob = (PG8_GAS bf16_t*)(ov + (kind == 0 ? o_a : kind == 1 ? o_b : kind == 2 ? o_c : o_d));
#pragma unroll
        for (int t = 0; t < 2; ++t) { const size_t off = (size_t)row * 1024 + (pn & 3) * BM + 32 * w + 16 * t + 4 * fq; const f32x4 v = t ? a1 : a0;
            u32x2v o; o.x = cvt_pk_bf16(v[0], v[1]); o.y = cvt_pk_bf16(v[2], v[3]); *(PG8_GAS u32x2v*)(ob + off) = o; }
    }
};

template <class Epi, bool F16 = false> __device__ __forceinline__ void thin_gemm(PG8_LAS unsigned char* lds, const Gemm g, const Epi& E, int G, int c, int row_base, const int tid) {
    const int w = __builtin_amdgcn_readfirstlane(tid >> 6), lane = tid & 63, fr = lane & 15, fq = lane >> 4, K = g.K, nks = K / 32, nU = g.N / 32;
    PG8_LAS f32x4* P = (PG8_LAS f32x4*)lds;
    for (int u = G - 1 - c; u < nU; u += G) {
        const int pn = u >> 3, wq = u & 7;
        const int r0 = Epi::THIN_PAIRED ? 16 * wq : 32 * wq, r1 = Epi::THIN_PAIRED ? HALF + 16 * wq : 32 * wq + 16;
        const PG8_GAS bf16_t* ap = g.A + (size_t)(row_base + fr) * K + 8 * fq;
        const PG8_GAS bf16_t* b0 = g.Bt + (size_t)(pn * BM + r0 + fr) * K + 8 * fq;
        const PG8_GAS bf16_t* b1 = g.Bt + (size_t)(pn * BM + r1 + fr) * K + 8 * fq;
        f32x4 acc0 = {0.f, 0.f, 0.f, 0.f}, acc1 = {0.f, 0.f, 0.f, 0.f};
        for (int ks = w; ks < nks; ks += 64) {
            bf16x8 av[8], bv0[8], bv1[8];
#pragma unroll
            for (int s = 0; s < 8; ++s) { const int kk = ks + 8 * s; const bool ok = kk < nks; const int ko = ok ? 32 * kk : 0;
                av[s] = *(const PG8_GAS bf16x8*)(ap + ko); bv0[s] = *(const PG8_GAS bf16x8*)(b0 + ko); bv1[s] = *(const PG8_GAS bf16x8*)(b1 + ko);
                if (!ok) av[s] = (bf16x8){0, 0, 0, 0, 0, 0, 0, 0}; }
#pragma unroll
            for (int s = 0; s < 8; ++s) {
                if (F16) { acc0 = __builtin_amdgcn_mfma_f32_16x16x32_f16(__builtin_bit_cast(f16x8, bv0[s]), __builtin_bit_cast(f16x8, av[s]), acc0, 0, 0, 0); acc1 = __builtin_amdgcn_mfma_f32_16x16x32_f16(__builtin_bit_cast(f16x8, bv1[s]), __builtin_bit_cast(f16x8, av[s]), acc1, 0, 0, 0); }
                else { acc0 = __builtin_amdgcn_mfma_f32_16x16x32_bf16(bv0[s], av[s], acc0, 0, 0, 0); acc1 = __builtin_amdgcn_mfma_f32_16x16x32_bf16(bv1[s], av[s], acc1, 0, 0, 0); } }
        }
        P[(w * 2 + 0) * 64 + lane] = acc0; P[(w * 2 + 1) * 64 + lane] = acc1;
        __syncthreads();
        if (w == 0) {
            f32x4 s0 = P[lane], s1 = P[64 + lane];
#pragma unroll
            for (int ww = 1; ww < 8; ++ww) { s0 += P[(ww * 2 + 0) * 64 + lane]; s1 += P[(ww * 2 + 1) * 64 + lane]; }
            E.thin(row_base + fr, pn, wq, fq, s0, s1);
        }
        __syncthreads();
    }
}
}
constexpr int NWAVES = 8;
constexpr int DM = 2048, BATCH = 4, SEQ = 4096, DEPTH = 4, NMETA = 16, DFF = 5632;
constexpr int MR = BATCH * SEQ;
constexpr int MROWS = MR + NMETA;
constexpr int MP = 16640;
constexpr int TSEQ = SEQ + NMETA;
constexpr int SW = 1024, NG = 64, NS = 64, SGC = 16;
constexpr int RW_W = 1024, NH = 16, HD = 64;
constexpr int P_FIRST = 8480, P_REST = 8512, NIN = 8704;
constexpr int U2_CR = 1040;
constexpr float NORM_EPS = 1e-6f;
#ifndef MK_MULTI
#define MK_MULTI 0
#endif
enum In { I_X = 0, I_META, I_F1N, I_F1G, I_F1U, I_F1D, I_MIXN, I_WIN0, I_WINR, I_MUSH, I_MUVR, I_LRE, I_LIM, I_LDT, I_BRE, I_BIM, I_CRE, I_CIM, I_SD, I_WGLU,
          I_W0, I_W2, I_A0, I_A2, I_V0, I_V2, I_G2, I_KK, I_KA, I_RK, I_LNW, I_LNB, I_WUA, I_WUB, I_WO, I_F2N, I_F2G, I_F2U, I_F2D, I_FINN, N_IN };

constexpr size_t MiB = 1u << 20;
constexpr size_t WS_CTL = 0, CTL_ZERO_BYTES = 1 * MiB;
constexpr size_t WS_LPAR = 1 * MiB;
constexpr size_t WS_X = 2 * MiB;
constexpr size_t WS_XB = 132 * MiB;
constexpr size_t WS_SSP = 197 * MiB, SS_STRIDE = 256 * 1024;
constexpr size_t WS_VF = 200 * MiB;
constexpr size_t WS_W = 233 * MiB, W_SLOT = 204 * MiB;
constexpr size_t WO_GU1 = 0, WO_D1 = 44 * MiB, WO_IN = 66 * MiB, WO_GLU = 100 * MiB, WO_UA = 102 * MiB, WO_UB = 106 * MiB, WO_O = 110 * MiB, WO_GU2 = 118 * MiB, WO_D2 = 162 * MiB, WO_S5 = 184 * MiB, WO_LORA = 200 * MiB;
constexpr size_t WS_OV = WS_W + 2 * W_SLOT;
constexpr size_t OV_ACT = 0;
constexpr size_t OV_U2 = 0, OV_RKV = 33 * MiB, OV_LIN = 131 * MiB, OV_GA = 148 * MiB, OV_GB = 213 * MiB, OV_YPRE = 278 * MiB, OV_YA = 311 * MiB, OV_RW = 344 * MiB,
                 OV_O = 729 * MiB, OV_YB = 794 * MiB, OV_GT = 827 * MiB, OV_RKS = 860 * MiB, OV_MG = 862 * MiB, OV_BK = 927 * MiB, OV_END = 930 * MiB;
constexpr size_t OV_LA = OV_RW + 128 * MiB, OV_DEC = OV_RW + 128 * MiB, OV_ICLR = OV_MG, OV_VG = OV_YB;
constexpr int LKP = 384;
constexpr size_t WS_END = WS_OV + OV_END;
static_assert((size_t)MP * DM * 4 == 130 * MiB && (size_t)MP * DFF * 2 <= 179 * MiB && (size_t)MROWS * NH * 6 * HD * 4 <= 385 * MiB, "d_ws map");
constexpr int CW_TMO = 0, CW_CODE = 1, CW_BAR = 4096;

constexpr int RING_OFF = 0, RING_BYTES = 131072;
constexpr int LDSCTL_OFF = RING_BYTES, MISC_OFF = LDSCTL_OFF + 320;
constexpr int LDS_BYTES = 147456;
static_assert(MISC_OFF + 128 <= LDS_BYTES, "LDS map");

#define GAS __attribute__((address_space(1)))
#define LAS __attribute__((address_space(3)))
typedef unsigned short bf16;
typedef unsigned v4u __attribute__((ext_vector_type(4)));
typedef unsigned v2u __attribute__((ext_vector_type(2)));
typedef float f32x4 __attribute__((ext_vector_type(4)));
typedef float f32x2 __attribute__((ext_vector_type(2)));
typedef GAS unsigned gu32;
#define RLX_AGENT __ATOMIC_RELAXED, __HIP_MEMORY_SCOPE_AGENT
#define LDS_WAIT() asm volatile("s_waitcnt lgkmcnt(0)" ::: "memory")
#define VM_WAIT() asm volatile("s_waitcnt vmcnt(0)" ::: "memory")
__device__ __forceinline__ unsigned f2bf(float f) { unsigned u = __builtin_bit_cast(unsigned, f); return (u + 0x7fffu + ((u >> 16) & 1u)) >> 16; }
__device__ __forceinline__ unsigned pk2(float lo, float hi) { return f2bf(lo) | (f2bf(hi) << 16); }
__device__ __forceinline__ float bf2f(bf16 h) { return __uint_as_float((unsigned)h << 16); }
__device__ __forceinline__ float sigm(float x) { return 1.0f / (1.0f + __expf(-x)); }
#define XB_TMO      128
#define XB_XCNT(j)  (256  + 64 * (j))
#define XB_XSUB(j)  (1280 + 64 * (j))
#define XB_XGEN(j)  (2304 + 64 * (j))
#define XB_TOP      3328
#define XB_TOPGEN   3392
#define XCD_BAR_WORDS 3456
#define XB_SPIN_CAP (1u << 18)

__device__ __forceinline__ unsigned xb_ld(unsigned* p)              { return __hip_atomic_load(p, __ATOMIC_RELAXED, __HIP_MEMORY_SCOPE_AGENT); }
__device__ __forceinline__ unsigned xb_add(unsigned* p, unsigned v) { return __hip_atomic_fetch_add(p, v, __ATOMIC_RELAXED, __HIP_MEMORY_SCOPE_AGENT); }
__device__ __forceinline__ unsigned xb_xcc_id() { return (unsigned)__builtin_amdgcn_s_getreg((3 << 11) | 20) & 0xFu; }
#define XB_SPIN(cond, bar) do { unsigned _sp = 0; while (cond) { __builtin_amdgcn_s_sleep(1); \
    if ((++_sp & 255u) == 0u) { if (xb_ld(&(bar)[XB_TMO])) break; if (_sp > XB_SPIN_CAP) { atomicAdd(&(bar)[XB_TMO], 1u); break; } } } } while (0)

struct XcdBarrier {
    unsigned* bar; unsigned x;
    volatile LAS unsigned* st;
};

__device__ __forceinline__ XcdBarrier xcd_barrier_post(unsigned* bar, volatile LAS unsigned* st) {
    XcdBarrier b; b.bar = bar; b.x = xb_xcc_id(); b.st = st;
    if (threadIdx.x == 0) (void)xb_add(&bar[XB_XCNT(b.x)], 1u);
    return b;
}
__device__ __forceinline__ void xcd_barrier_complete(unsigned* bar, unsigned x, unsigned& nloc, unsigned& nx) {
    const unsigned G = gridDim.x * gridDim.y * gridDim.z;
    unsigned sum, cnt, mine, sp = 0u;
    for (;;) {
        sum = 0u; cnt = 0u; mine = 0u;
#pragma unroll
        for (unsigned j = 0; j < 16; ++j) { const unsigned c = xb_ld(&bar[XB_XCNT(j)]); sum += c; cnt += (c > 0u) ? 1u : 0u; mine = (j == x) ? c : mine; }
        if (sum == G) break;
        __builtin_amdgcn_s_sleep(1);
        if ((++sp & 255u) == 0u) { if (xb_ld(&bar[XB_TMO])) break; if (sp > XB_SPIN_CAP) { atomicAdd(&bar[XB_TMO], 1u); break; } }
    }
    nloc = mine > 0u ? mine : 1u; nx = cnt > 0u ? cnt : 1u;
}

__device__ __forceinline__ void xcd_barrier(const XcdBarrier& b) {
    asm volatile("s_waitcnt vmcnt(0)" ::: "memory");
    __syncthreads();
    if (threadIdx.x == 0) {
        unsigned* bar = b.bar;
        __builtin_amdgcn_s_waitcnt(0);
        unsigned nloc = b.st[0], nx = b.st[1];
        if (nloc == 0u) { xcd_barrier_complete(bar, b.x, nloc, nx); b.st[0] = nloc; b.st[1] = nx; }
        const unsigned old = xb_add(&bar[XB_XSUB(b.x)], 1u);
        const unsigned gen = old / nloc;
        if (old + 1u == (gen + 1u) * nloc) {
            __builtin_amdgcn_fence(__ATOMIC_RELEASE, "agent");
            asm volatile("s_waitcnt vmcnt(0)" ::: "memory");
            const unsigned og = xb_add(&bar[XB_TOP], 1u);
            const unsigned tg = og / nx;
            if (og + 1u == (tg + 1u) * nx) xb_add(&bar[XB_TOPGEN], 1u);
            else XB_SPIN(xb_ld(&bar[XB_TOPGEN]) == tg, bar);
            __builtin_amdgcn_fence(__ATOMIC_ACQUIRE, "agent");
            xb_add(&bar[XB_XGEN(b.x)], 1u);
            asm volatile("s_waitcnt vmcnt(0)" ::: "memory");
        } else {
            XB_SPIN(xb_ld(&bar[XB_XGEN(b.x)]) == gen, bar);
            __builtin_amdgcn_fence(__ATOMIC_ACQUIRE, "agent");
            asm volatile("s_waitcnt vmcnt(0)" ::: "memory");
        }
    }
    __syncthreads();
}
struct Frame {
    LAS unsigned char* lds;
    volatile LAS unsigned* MISC;
    gu32* ctl;
    int tid, lane, wave, vcu, G;
    GAS unsigned char* ws;
};
#define FX16(F) ((GAS bf16*)((F).ws + WS_X))
#define FXB(F)  ((GAS bf16*)((F).ws + WS_XB))
#define FVF(F)  ((GAS bf16*)((F).ws + WS_VF))
#define FSSA(F) ((GAS unsigned long long*)((F).ws + WS_SSP))
#define FSSB(F) ((GAS unsigned long long*)((F).ws + WS_SSP + SS_STRIDE))
#define FSSC(F) ((GAS unsigned long long*)((F).ws + WS_SSP + 2 * SS_STRIDE))
__device__ __forceinline__ const GAS float* inp(const Frame& F, int k) {
    const LAS unsigned* t = (const LAS unsigned*)(F.lds + LDSCTL_OFF) + 2 * k;
    const unsigned lo = __builtin_amdgcn_readfirstlane(t[0]), hi = __builtin_amdgcn_readfirstlane(t[1]);
    return (const GAS float*)(((unsigned long long)hi << 32) | lo);
}
__device__ __forceinline__ float row16_sum(float x) {
    x += __builtin_bit_cast(float, __builtin_amdgcn_update_dpp(0, __builtin_bit_cast(int, x), 0xB1, 0xF, 0xF, false));
    x += __builtin_bit_cast(float, __builtin_amdgcn_update_dpp(0, __builtin_bit_cast(int, x), 0x4E, 0xF, 0xF, false));
    x += __builtin_bit_cast(float, __builtin_amdgcn_update_dpp(0, __builtin_bit_cast(int, x), 0x124, 0xF, 0xF, false));
    x += __builtin_bit_cast(float, __builtin_amdgcn_update_dpp(0, __builtin_bit_cast(int, x), 0x128, 0xF, 0xF, false));
    return x;
}
__device__ __forceinline__ float lane_bcast(float x, int j) { return __builtin_bit_cast(float, __builtin_amdgcn_readlane(__builtin_bit_cast(int, x), j)); }
__device__ __forceinline__ float wave_sum(float v) {
    v = row16_sum(v);
    return (lane_bcast(v, 0) + lane_bcast(v, 16)) + (lane_bcast(v, 32) + lane_bcast(v, 48));
}
__device__ __forceinline__ int seq_row(int b, int s) { return s < NMETA ? MR + s : b * SEQ + (s - NMETA); }
__device__ __forceinline__ int prev_row(int row) { if (row >= MR) return row > MR ? row - 1 : -1; return (row & (SEQ - 1)) ? row - 1 : MR + NMETA - 1; }

__device__ __forceinline__ void px_init(Frame& F) {
    const int gw = F.vcu * NWAVES + F.wave, NGW = F.G * NWAVES;
    const GAS float* xin = inp(F, I_X); const GAS float* meta = inp(F, I_META);
    for (int m = gw; m < MP; m += NGW) {
        const GAS float* src = m < MR ? xin + (size_t)m * DM : (m < MROWS ? meta + (size_t)(m - MR) * DM : nullptr);
        f32x4 v[8]; float s = 0.f;
#pragma unroll
        for (int j = 0; j < 8; ++j) { v[j] = src ? __builtin_nontemporal_load((const GAS f32x4*)src + F.lane + 64 * j) : (f32x4){0.f, 0.f, 0.f, 0.f}; s += (v[j][0] * v[j][0] + v[j][1] * v[j][1]) + (v[j][2] * v[j][2] + v[j][3] * v[j][3]); }
        s = wave_sum(s);
#pragma unroll
        for (int j = 0; j < 8; ++j) {
            v2u w; w.x = pg8::pkh2(v[j][0], v[j][1]); w.y = pg8::pkh2(v[j][2], v[j][3]);
            ((GAS v2u*)(FX16(F) + (size_t)m * DM))[F.lane + 64 * j] = w;
            w.x = pk2(v[j][0], v[j][1]); w.y = pk2(v[j][2], v[j][3]);
            ((GAS v2u*)(FXB(F) + (size_t)m * DM))[F.lane + 64 * j] = w;
        }
        if (F.lane == 0) { unsigned zlo = 0u; asm volatile("" : "+v"(zlo));
            FSSC(F)[m] = (unsigned long long)(long long)(s * pg8::SS_SCALE + 0.5f); FSSA(F)[m] = (unsigned long long)zlo; }
    }
}
__device__ __forceinline__ int tr_drow(int map, int c0) {
    if (map == 1) return (c0 >> 7) * 256 + (c0 & 127);
    if (map == 2) return (c0 >> 7) * 256 + 128 + (c0 & 127);
    if (map == 3) {
        if (c0 < 4096) return c0; if (c0 < 4384) return 8192 + (c0 - 4096); if (c0 < 8480) return 4096 + (c0 - 4384); return 8192 + 288 + (c0 - 8480); }
    return c0;
}
struct TrDesc { const GAS float* W; GAS bf16* WT; const GAS float* gain; int K, N, map, f16; };
__device__ __forceinline__ int tr_items(const TrDesc& d) { return (d.K / 64) * ((d.N + 63) / 64); }
__device__ __forceinline__ void tr_tile_load(const TrDesc& d, int it, int lane, f32x4 (&v)[16]) {
    const int nbn = (d.N + 63) / 64, kb = it / nbn, nb = it - kb * nbn, k0 = 64 * kb, n0 = 64 * nb, rg = lane >> 4, j = lane & 15;
    const bool nok = n0 + 4 * j < d.N;
#pragma unroll
    for (int i = 0; i < 16; ++i) { const int kk = 8 * (i >> 1) + 2 * rg + (i & 1);
        v[i] = nok ? __builtin_nontemporal_load((const GAS f32x4*)(d.W + (size_t)(k0 + kk) * d.N + n0 + 4 * j)) : (f32x4){0.f, 0.f, 0.f, 0.f}; }
}
__device__ __forceinline__ void tr_tile_finish(const TrDesc& d, int it, int lane, const f32x4 (&v)[16], LAS unsigned* scr) {
    const int nbn = (d.N + 63) / 64, kb = it / nbn, nb = it - kb * nbn, k0 = 64 * kb, n0 = 64 * nb, rg = lane >> 4, j = lane & 15;
#pragma unroll
    for (int i = 0; i < 8; ++i) { const int kk = 8 * i + 2 * rg; float g0 = 1.f, g1 = 1.f; if (d.gain) { g0 = d.gain[k0 + kk]; g1 = d.gain[k0 + kk + 1]; }
#pragma unroll
        for (int e = 0; e < 4; ++e) scr[(4 * j + e) * 36 + (kk >> 1)] = d.f16 ? pg8::pkh2(v[2 * i][e] * g0, v[2 * i + 1][e] * g1) : pk2(v[2 * i][e] * g0, v[2 * i + 1][e] * g1); }
    LDS_WAIT(); asm volatile("" ::: "memory");
    const int c = lane & 7;
#pragma unroll
    for (int i = 0; i < 8; ++i) { const int n = (lane >> 3) + 8 * i;
        const v4u o = *(const LAS v4u*)(scr + n * 36 + 4 * c);
        const int col = n0 + n;
        if (col < d.N) *(GAS v4u*)(d.WT + (size_t)(tr_drow(d.map, col & ~31) + (col & 31)) * d.K + k0 + 8 * c) = o; }
    LDS_WAIT(); asm volatile("" ::: "memory");
}
constexpr int TR_NMAT = 11;
__device__ __forceinline__ TrDesc tr_desc(Frame& F, int L, int m) {
    GAS unsigned char* wb = F.ws + WS_W + (size_t)(L & 1) * W_SLOT; const int P = L == 0 ? P_FIRST : P_REST; TrDesc d;
    switch (m) {
    case 0:  d = TrDesc{inp(F, I_F1G) + (size_t)L * DM * DFF, (GAS bf16*)(wb + WO_GU1), inp(F, I_F1N) + (size_t)L * DM, DM, DFF, 1, 0}; break;
    case 1:  d = TrDesc{inp(F, I_F1U) + (size_t)L * DM * DFF, (GAS bf16*)(wb + WO_GU1), inp(F, I_F1N) + (size_t)L * DM, DM, DFF, 2, 0}; break;
    case 2:  d = TrDesc{inp(F, I_F1D) + (size_t)L * DFF * DM, (GAS bf16*)(wb + WO_D1), nullptr, DFF, DM, 0, 0}; break;
    case 3:  d = TrDesc{L == 0 ? inp(F, I_WIN0) : inp(F, I_WINR) + (size_t)(L - 1) * DM * P_REST, (GAS bf16*)(wb + WO_IN), inp(F, I_MIXN) + (size_t)L * DM, DM, P, 3, 0}; break;
    case 4:  d = TrDesc{inp(F, I_WGLU) + (size_t)L * SW * SW, (GAS bf16*)(wb + WO_GLU), nullptr, SW, SW, 0, 0}; break;
    case 5:  d = TrDesc{inp(F, I_WUA) + (size_t)L * SW * DM, (GAS bf16*)(wb + WO_UA), nullptr, SW, DM, 0, 0}; break;
    case 6:  d = TrDesc{inp(F, I_WUB) + (size_t)L * RW_W * DM, (GAS bf16*)(wb + WO_UB), nullptr, RW_W, DM, 0, 0}; break;
    case 7:  d = TrDesc{inp(F, I_WO) + (size_t)L * DM * DM, (GAS bf16*)(wb + WO_O), nullptr, DM, DM, 0, 0}; break;
    case 8:  d = TrDesc{inp(F, I_F2G) + (size_t)L * DM * DFF, (GAS bf16*)(wb + WO_GU2), inp(F, I_F2N) + (size_t)L * DM, DM, DFF, 1, 0}; break;
    case 9:  d = TrDesc{inp(F, I_F2U) + (size_t)L * DM * DFF, (GAS bf16*)(wb + WO_GU2), inp(F, I_F2N) + (size_t)L * DM, DM, DFF, 2, 0}; break;
    default: d = TrDesc{inp(F, I_F2D) + (size_t)L * DFF * DM, (GAS bf16*)(wb + WO_D2), nullptr, DFF, DM, 0, 0}; break;
    }
    return d;
}
__device__ __forceinline__ bool tr_decode(int L, int t, int& m, int& it) {
    const int P = L == 0 ? P_FIRST : P_REST;
    constexpr int n_gu = (DM / 64) * (DFF / 64), n_dn = (DFF / 64) * (DM / 64), n_gl = (SW / 64) * (SW / 64), n_up = (SW / 64) * (DM / 64), n_wo = (DM / 64) * (DM / 64);
    const int n_in = (DM / 64) * ((P + 63) / 64);
    const int cnt[TR_NMAT] = {n_gu, n_gu, n_dn, n_in, n_gl, n_up, n_up, n_wo, n_gu, n_gu, n_dn};
    int r = t;
#pragma unroll
    for (int i = 0; i < TR_NMAT; ++i) { if (r < cnt[i]) { m = i; it = r; return true; } r -= cnt[i]; }
    return false;
}
__device__ __forceinline__ void tr_matrix(Frame& F, const TrDesc& d) {
    LAS unsigned* scr = (LAS unsigned*)(F.lds + RING_OFF + F.wave * 16384);
    const int gw = F.vcu * NWAVES + F.wave, NGW = F.G * NWAVES, nitems = tr_items(d);
    for (int it = gw; it < nitems; it += NGW) { f32x4 v[16]; tr_tile_load(d, it, F.lane, v); tr_tile_finish(d, it, F.lane, v, scr); }
}
__device__ __forceinline__ void pw_zero_rows(Frame& F, int L) {
    GAS unsigned char* wb = F.ws + WS_W + (size_t)(L & 1) * W_SLOT; const int P = L == 0 ? P_FIRST : P_REST;
    const int gw = F.vcu * NWAVES + F.wave, NGW = F.G * NWAVES;
    for (int r = P + gw; r < NIN; r += NGW) { GAS v4u* z = (GAS v4u*)((GAS bf16*)(wb + WO_IN) + (size_t)r * DM);
#pragma unroll
        for (int j = 0; j < 4; ++j) z[F.lane + 64 * j] = (v4u){0u, 0u, 0u, 0u}; }
}
__device__ __forceinline__ void pw_weights(Frame& F, int L) {
    for (int m = 0; m < TR_NMAT; ++m) { const TrDesc d = tr_desc(F, L, m); tr_matrix(F, d); }
}

constexpr size_t S5_KC_BYTES = (size_t)NG * 256 * 384 * 2;
__device__ __forceinline__ float gelu_tanh(float y) { const float t2 = 1.5957691216057308f * (y + 0.044715f * y * y * y); return y * __builtin_amdgcn_rcpf(1.0f + __expf(-t2)); }
__device__ __forceinline__ void abar_pow(float lr, float li, float dt, int p, float& re, float& im) {
    const double ang = (double)p * (double)li * (double)dt;
    const double k = __builtin_rint(ang * 0.15915494309189535);
    const float r = (float)(ang - k * 6.283185307179586);
    const float mag = expf((float)((double)p * (double)lr * (double)dt));
    re = mag * cosf(r); im = mag * sinf(r);
}
__device__ __forceinline__ void s5_build(Frame& F, int L) {
    LAS float* APR = (LAS float*)(F.lds + RING_OFF);
    LAS float* API = APR + 17 * 64;
    LAS float* BBR = API + 17 * 64;
    LAS float* BBI = BBR + 1024;
    LAS float* CR = BBI + 1024;
    LAS float* CI = CR + 1024;
    LAS float* KT = CI + 1024;
    GAS unsigned char* wb = F.ws + WS_W + (size_t)(L & 1) * W_SLOT;
    for (int g = F.vcu; g < NG; g += F.G) {
        const size_t lg = (size_t)L * NG + g;
        const float dt = expf(inp(F, I_LDT)[lg]);
        for (int i = F.tid; i < 17 * 64; i += NWAVES * 64) { const int p = i >> 6, n = i & 63; float pr, pi;
            abar_pow(inp(F, I_LRE)[lg * NS + n], inp(F, I_LIM)[lg * NS + n], dt, p, pr, pi);
            APR[i] = pr; API[i] = pi; }
        for (int i = F.tid; i < 1024; i += NWAVES * 64) { const int n = i >> 4;
            const float lr = inp(F, I_LRE)[lg * NS + n], li = inp(F, I_LIM)[lg * NS + n]; float are, aim;
            abar_pow(lr, li, dt, 1, are, aim);
            const float den = lr * lr + li * li, nr = are - 1.0f, ni = aim;
            const float qre = (nr * lr + ni * li) / den, qim = (ni * lr - nr * li) / den;
            const float br = inp(F, I_BRE)[lg * 1024 + i], bi = inp(F, I_BIM)[lg * 1024 + i];
            BBR[i] = qre * br - qim * bi; BBI[i] = qre * bi + qim * br;
            CR[i] = inp(F, I_CRE)[lg * 1024 + i]; CI[i] = inp(F, I_CIM)[lg * 1024 + i]; }
        __syncthreads();
        for (int i = F.tid; i < 4096; i += NWAVES * 64) { const int tau = i >> 8, c = (i >> 4) & 15, cp = i & 15; float acc = 0.f;
            for (int n = 0; n < 64; ++n) { const float cr = CR[c * 64 + n], ci = CI[c * 64 + n], ar = APR[tau * 64 + n], ai = API[tau * 64 + n], br = BBR[n * 16 + cp], bi = BBI[n * 16 + cp];
                const float mr = cr * ar - ci * ai, mi = cr * ai + ci * ar; acc += mr * br - mi * bi; }
            KT[i] = acc; }
        __syncthreads();
        GAS unsigned* KC = (GAS unsigned*)(wb + WO_S5) + (size_t)g * 256 * 192;
        GAS unsigned* BE = (GAS unsigned*)(wb + WO_S5 + S5_KC_BYTES) + (size_t)g * 128 * 128;
        for (int i = F.tid; i < 256 * 192; i += NWAVES * 64) { const int row = i / 192, cp2 = i - row * 192, t = row >> 4, c = row & 15; float v[2];
#pragma unroll
            for (int e = 0; e < 2; ++e) { const int col = 2 * cp2 + e;
                if (col < 256) { const int j = col >> 4, cq = col & 15; v[e] = j <= t ? KT[((t - j) * 16 + c) * 16 + cq] : 0.f; }
                else { const int n = (col - 256) & 63; const float cr = CR[c * 64 + n], ci = CI[c * 64 + n], ar = APR[(t + 1) * 64 + n], ai = API[(t + 1) * 64 + n];
                    v[e] = col < 320 ? cr * ar - ci * ai : -(cr * ai + ci * ar); } }
            KC[i] = pk2(v[0], v[1]); }
        for (int i = F.tid; i < 128 * 128; i += NWAVES * 64) { const int n2 = i >> 7, cp2 = i & 127, n = n2 & 63; float v[2];
#pragma unroll
            for (int e = 0; e < 2; ++e) { const int col = 2 * cp2 + e, j = col >> 4, cq = col & 15; const float ar = APR[(15 - j) * 64 + n], ai = API[(15 - j) * 64 + n], br = BBR[n * 16 + cq], bi = BBI[n * 16 + cq];
                v[e] = n2 < 64 ? ar * br - ai * bi : ar * bi + ai * br; }
            BE[i] = pk2(v[0], v[1]); }
        __syncthreads();
    }
}
typedef short bfx8 __attribute__((ext_vector_type(8)));
typedef __bf16 bf2v __attribute__((ext_vector_type(2)));
__device__ __forceinline__ unsigned cvt2(float a, float b) { const f32x2 v = {a, b}; const bf2v r = __builtin_convertvector(v, bf2v); return __builtin_bit_cast(unsigned, r); }
__device__ __forceinline__ float bfu(unsigned short u) { return __uint_as_float((unsigned)u << 16); }
__device__ __forceinline__ void wait_vm(int n) {
    switch (n) {
    case 0: asm volatile("s_waitcnt vmcnt(0)" ::: "memory"); break; case 1: asm volatile("s_waitcnt vmcnt(1)" ::: "memory"); break; case 2: asm volatile("s_waitcnt vmcnt(2)" ::: "memory"); break;
    case 3: asm volatile("s_waitcnt vmcnt(3)" ::: "memory"); break; case 4: asm volatile("s_waitcnt vmcnt(4)" ::: "memory"); break; case 5: asm volatile("s_waitcnt vmcnt(5)" ::: "memory"); break;
    case 6: asm volatile("s_waitcnt vmcnt(6)" ::: "memory"); break; case 7: asm volatile("s_waitcnt vmcnt(7)" ::: "memory"); break; case 8: asm volatile("s_waitcnt vmcnt(8)" ::: "memory"); break;
    case 9: asm volatile("s_waitcnt vmcnt(9)" ::: "memory"); break; case 10: asm volatile("s_waitcnt vmcnt(10)" ::: "memory"); break; case 11: asm volatile("s_waitcnt vmcnt(11)" ::: "memory"); break;
    case 12: asm volatile("s_waitcnt vmcnt(12)" ::: "memory"); break; default: asm volatile("s_waitcnt vmcnt(0)" ::: "memory"); break; }
}
__device__ __forceinline__ void s5_unit(Frame& F, int L, int b, int g) {
    const int lane = F.lane, w = F.wave, fr = lane & 15, fq = lane >> 4;
    GAS unsigned char* wb = F.ws + WS_W + (size_t)(L & 1) * W_SLOT;
    const GAS unsigned char* U2b = F.ws + WS_OV + OV_U2 + (size_t)g * U2_CR * 512;
    const GAS bf16* KC = (const GAS bf16*)(wb + WO_S5) + (size_t)g * 256 * 384;
    const GAS bf16* BE = (const GAS bf16*)(wb + WO_S5 + S5_KC_BYTES) + (size_t)g * 128 * 256;
    GAS bf16* YPRE = (GAS bf16*)(F.ws + WS_OV + OV_YPRE);
    constexpr int SLP = 136, UD = 5, UNS = 7;
    LAS bf16* SLh = (LAS bf16*)(F.lds + RING_OFF);
    LAS unsigned char* UR = F.lds + RING_OFF + 256 * SLP * 2;
    static_assert(256 * SLP * 2 + UNS * 8192 <= RING_BYTES, "S5 LDS map");
    const int ur = 2 * w + (lane >> 5), upc = ((lane & 31) ^ ur) * 16;
#define S5_ISSUE(ct_) do { const int c_ = (ct_) * 16 + ur; const int row_ = c_ == 0 ? 1024 : (c_ > 256 ? b * 256 + 255 : b * 256 + c_ - 1); \
        __builtin_amdgcn_global_load_lds((const GAS unsigned*)(U2b + (size_t)row_ * 512 + upc), (LAS unsigned*)(UR + ((ct_) % UNS) * 8192 + w * 1024), 16, 0, 0); } while (0)
#define S5_FRAG(sl_, p_) (*(const LAS bfx8*)((sl_) + ((((p_)) ^ fr) << 4)))
    {
        bfx8 wf[8];
#pragma unroll
        for (int ks = 0; ks < 8; ++ks) wf[ks] = *(const GAS bfx8*)(BE + (size_t)(16 * w + fr) * 256 + ks * 32 + 8 * fq);
        asm volatile("s_waitcnt vmcnt(0)" ::: "memory");
#pragma unroll
        for (int i = 0; i < UD; ++i) S5_ISSUE(i);
#pragma unroll
        for (int ct = 0; ct < 16; ++ct) {
            if (ct + UD < 16) S5_ISSUE(ct + UD);
            wait_vm(15 - ct < UD ? 15 - ct : UD);
            __builtin_amdgcn_s_barrier(); asm volatile("" ::: "memory");
            const LAS unsigned char* sl = UR + (ct % UNS) * 8192 + fr * 512;
            f32x4 acc = {0.f, 0.f, 0.f, 0.f};
#pragma unroll
            for (int ks = 0; ks < 8; ++ks) acc = __builtin_amdgcn_mfma_f32_16x16x32_bf16(wf[ks], S5_FRAG(sl, ks * 4 + fq), acc, 0, 0, 0);
            v2u o; o.x = cvt2(acc[0], acc[1]); o.y = cvt2(acc[2], acc[3]);
            *(LAS v2u*)(SLh + (ct * 16 + fr) * SLP + 16 * w + 4 * fq) = o;
        }
    }
    __syncthreads();
    {
        const int n = lane; const size_t lg = (size_t)L * NG + g;
        const float lr_ = inp(F, I_LRE)[lg * NS + n], li_ = inp(F, I_LIM)[lg * NS + n], dt_ = expf(inp(F, I_LDT)[lg]);
        float a_re, a_im, A_re, A_im; abar_pow(lr_, li_, dt_, 16, a_re, a_im); abar_pow(lr_, li_, dt_, 512, A_re, A_im);
        LAS float* TT = (LAS float*)UR;
        LAS bf16* seg = SLh + (size_t)(32 * w) * SLP;
        float pre[32], pim[32]; float sre = 0.f, sim = 0.f;
#pragma unroll
        for (int j = 0; j < 32; ++j) { const float cre = bfu(seg[j * SLP + n]), cim = bfu(seg[j * SLP + 64 + n]);
            const float nre = a_re * sre - a_im * sim + cre, nim = a_re * sim + a_im * sre + cim; sre = nre; sim = nim; pre[j] = sre; pim[j] = sim; }
        TT[w * 128 + n] = sre; TT[w * 128 + 64 + n] = sim;
        __syncthreads();
        float ire = 0.f, iim = 0.f;
        for (int k = 0; k < w; ++k) { const float tre = TT[k * 128 + n], tim = TT[k * 128 + 64 + n]; const float nre = A_re * ire - A_im * iim + tre, nim = A_re * iim + A_im * ire + tim; ire = nre; iim = nim; }
        float qre = a_re, qim = a_im;
#pragma unroll
        for (int j = 0; j < 32; ++j) { const float ore = pre[j] + qre * ire - qim * iim, oim = pim[j] + qre * iim + qim * ire;
            const unsigned o2 = cvt2(ore, oim); seg[j * SLP + n] = (bf16)o2; seg[j * SLP + 64 + n] = (bf16)(o2 >> 16);
            const float nq = qre * a_re - qim * a_im; qim = qre * a_im + qim * a_re; qre = nq; }
    }
    __syncthreads();
    {
        bfx8 wf[2][12];
#pragma unroll
        for (int tt = 0; tt < 2; ++tt)
#pragma unroll
            for (int ks = 0; ks < 12; ++ks) wf[tt][ks] = *(const GAS bfx8*)(KC + (size_t)(16 * (2 * w + tt) + fr) * 384 + ks * 32 + 8 * fq);
        const f32x4 d4 = *(const GAS f32x4*)(inp(F, I_SD) + (size_t)L * SW + g * SGC + 4 * fq);
        asm volatile("s_waitcnt vmcnt(0)" ::: "memory");
#pragma unroll
        for (int i = 0; i < UD; ++i) S5_ISSUE(i);
#pragma unroll
        for (int ct = 0; ct < 17; ++ct) {
            int nafter = 0;
            if (ct < UD) nafter = (UD - 1 - ct) + 3 * ct;
            else { nafter = 0;
#pragma unroll
                for (int j = ct - UD + 1; j < ct; ++j) nafter += 2 + (j + UD <= 16 ? 1 : 0); }
            wait_vm(nafter);
            __builtin_amdgcn_s_barrier(); asm volatile("" ::: "memory");
            const LAS unsigned char* sl = UR + (ct % UNS) * 8192 + fr * 512;
            const int c = ct * 16 + fr, cc = c <= 256 ? c : 256;
            f32x4 acc[2] = {{0.f, 0.f, 0.f, 0.f}, {0.f, 0.f, 0.f, 0.f}};
#pragma unroll
            for (int ks = 0; ks < 8; ++ks) { const bfx8 af = S5_FRAG(sl, ks * 4 + fq);
                acc[0] = __builtin_amdgcn_mfma_f32_16x16x32_bf16(wf[0][ks], af, acc[0], 0, 0, 0); acc[1] = __builtin_amdgcn_mfma_f32_16x16x32_bf16(wf[1][ks], af, acc[1], 0, 0, 0); }
#pragma unroll
            for (int ks = 0; ks < 4; ++ks) {
                bfx8 sf = {0, 0, 0, 0, 0, 0, 0, 0};
                if (cc >= 1) sf = *(const LAS bfx8*)(SLh + (cc - 1) * SLP + ks * 32 + 8 * fq);
                acc[0] = __builtin_amdgcn_mfma_f32_16x16x32_bf16(wf[0][8 + ks], sf, acc[0], 0, 0, 0); acc[1] = __builtin_amdgcn_mfma_f32_16x16x32_bf16(wf[1][8 + ks], sf, acc[1], 0, 0, 0);
            }
#pragma unroll
            for (int tt = 0; tt < 2; ++tt) { const int t = 2 * w + tt; const int row = cc == 0 ? MR + t : b * SEQ + (cc - 1) * 16 + t;
                const v2u uu = *(const LAS v2u*)(sl + (((2 * t + (fq >> 1)) ^ fr) << 4) + (fq & 1) * 8);
                const float u0 = __uint_as_float(uu.x << 16), u1 = __uint_as_float(uu.x & 0xffff0000u), u2 = __uint_as_float(uu.y << 16), u3 = __uint_as_float(uu.y & 0xffff0000u);
                v2u o; o.x = pk2(gelu_tanh(acc[tt][0] + d4[0] * u0), gelu_tanh(acc[tt][1] + d4[1] * u1)); o.y = pk2(gelu_tanh(acc[tt][2] + d4[2] * u2), gelu_tanh(acc[tt][3] + d4[3] * u3));
                *(GAS v2u*)(YPRE + (size_t)row * SW + g * SGC + 4 * fq) = o; }
            asm volatile("" ::: "memory");
            if (ct + UD < 17) S5_ISSUE(ct + UD);
        }
    }
#undef S5_ISSUE
#undef S5_FRAG
    __syncthreads();
}

__device__ __forceinline__ void lora_weights(Frame& F, int L) {
    GAS unsigned char* wb = F.ws + WS_W + (size_t)(L & 1) * W_SLOT;
    GAS v4u* WL = (GAS v4u*)(wb + WO_LORA);
    const GAS float* w2 = inp(F, I_W2) + (size_t)L * 64 * RW_W; const GAS float* a2 = inp(F, I_A2) + (size_t)L * 64 * RW_W; const GAS float* g2 = inp(F, I_G2) + (size_t)L * 160 * RW_W;
    const GAS float* v2 = inp(F, I_V2) + (size_t)(L > 0 ? L - 1 : 0) * 32 * RW_W;
    for (int i = (int)(F.vcu * (NWAVES * 64) + F.tid); i < 4096 * (LKP / 8); i += F.G * NWAVES * 64) {
        const int row = i / (LKP / 8), k0 = (i - row * (LKP / 8)) * 8, kind = row >> 10, ch = row & 1023; float v[8];
#pragma unroll
        for (int e = 0; e < 8; ++e) { const int k = k0 + e; float x = 0.f;
            if (kind == 0) { if (k < 64) x = w2[(size_t)k * RW_W + ch]; }
            else if (kind == 1) { if (k >= 64 && k < 128) x = a2[(size_t)(k - 64) * RW_W + ch]; }
            else if (kind == 2) { if (k >= 128 && k < 288) x = g2[(size_t)(k - 128) * RW_W + ch]; }
            else { if (L > 0 && k >= 288 && k < 320) x = v2[(size_t)(k - 288) * RW_W + ch]; }
            v[e] = x; }
        v4u o; o.x = pk2(v[0], v[1]); o.y = pk2(v[2], v[3]); o.z = pk2(v[4], v[5]); o.w = pk2(v[6], v[7]); WL[i] = o;
    }
}
__device__ __forceinline__ void lora_inputs(Frame& F, int L) {
    const int gw = F.vcu * NWAVES + F.wave, NGW = F.G * NWAVES, k0 = 8 * F.lane;
    const GAS bf16* LIN = (const GAS bf16*)(F.ws + WS_OV + OV_LIN); GAS bf16* LA = (GAS bf16*)(F.ws + WS_OV + OV_LA);
    if (k0 >= LKP) return;
    f32x4 m0 = {0.f, 0.f, 0.f, 0.f}, m1 = m0;
    if (k0 < 288) { const GAS float* ms = inp(F, I_MUSH) + (size_t)L * 3360 + 3072 + k0; m0 = *(const GAS f32x4*)ms; m1 = *(const GAS f32x4*)(ms + 4); }
    else if (k0 < 320 && L > 0) { const GAS float* mv = inp(F, I_MUVR) + (size_t)(L - 1) * 32 + (k0 - 288); m0 = *(const GAS f32x4*)mv; m1 = *(const GAS f32x4*)(mv + 4); }
    const bool live = k0 < 288 || (k0 < 320 && L > 0);
    for (int row = gw; row < MROWS; row += NGW) {
        v4u o = {0u, 0u, 0u, 0u};
        if (live) { const int prow = prev_row(row);
            f32x4 x0, x1, p0 = {0.f, 0.f, 0.f, 0.f}, p1 = p0;
            pg8::unpack8(*(const GAS v4u*)(LIN + (size_t)row * 512 + k0), x0, x1);
            if (prow >= 0) pg8::unpack8(*(const GAS v4u*)(LIN + (size_t)prow * 512 + k0), p0, p1);
            x0 = x0 + m0 * (p0 - x0); x1 = x1 + m1 * (p1 - x1);
            if (k0 < 64) {
#pragma unroll
                for (int e = 0; e < 4; ++e) { x0[e] = 1.0f - 2.0f * __builtin_amdgcn_rcpf(1.0f + __expf(2.0f * x0[e])); x1[e] = 1.0f - 2.0f * __builtin_amdgcn_rcpf(1.0f + __expf(2.0f * x1[e])); }
            } else if (k0 >= 128 && k0 < 288) {
#pragma unroll
                for (int e = 0; e < 4; ++e) { x0[e] = __builtin_amdgcn_rcpf(1.0f + __expf(-x0[e])); x1[e] = __builtin_amdgcn_rcpf(1.0f + __expf(-x1[e])); }
            }
            o.x = pk2(x0[0], x0[1]); o.y = pk2(x0[2], x0[3]); o.z = pk2(x1[0], x1[1]); o.w = pk2(x1[2], x1[3]); }
        *(GAS v4u*)(LA + (size_t)row * LKP + k0) = o;
    }
}
__device__ __forceinline__ f32x4 ld_bf4(const GAS bf16* p) { const v2u u = *(const GAS v2u*)p; return (f32x4){__uint_as_float(u.x << 16), __uint_as_float(u.x & 0xffff0000u), __uint_as_float(u.y << 16), __uint_as_float(u.y & 0xffff0000u)}; }
constexpr int REC_TB = 32, REC_F = 6 * HD, REC_LF = REC_F + 4, REC_NBLK = (TSEQ + REC_TB - 1) / REC_TB, REC_OBUF = 2 * REC_TB * REC_LF;
__device__ __forceinline__ void rwkv_rec_unit(Frame& F, int L, int b, int h, int q) {
    GAS float* O = (GAS float*)(F.ws + WS_OV + OV_O);
    LAS float* buf = (LAS float*)(F.lds + RING_OFF);
    const bool loader = F.wave >= 4;
    const int lt = F.tid - 256;
    const int rg = F.lane >> 4, j = F.lane & 15, lrow = (F.wave & 3) * 4 + rg, vrow = q * 16 + lrow;
    f32x4 S = {0.f, 0.f, 0.f, 0.f};
    const int ltk = lt >> 4, lj = lt & 15, C = h * HD + 4 * lj;
    const GAS bf16* RKVp = (const GAS bf16*)(F.ws + WS_OV + OV_RKV); const GAS bf16* DECp = (const GAS bf16*)(F.ws + WS_OV + OV_DEC); const GAS bf16* ICLp = (const GAS bf16*)(F.ws + WS_OV + OV_ICLR);
    const GAS bf16* VGp = (const GAS bf16*)(F.ws + WS_OV + OV_VG);
    LAS float* PL = (LAS float*)(F.lds + LDSCTL_OFF + 1024);
    for (int pi = F.wave; pi < 9; pi += NWAVES) {
        const GAS float* src = pi < 3 ? inp(F, I_MUSH) + (size_t)L * 3360 + pi * 1024 : pi == 3 ? inp(F, I_W0) + (size_t)L * RW_W : pi == 4 ? inp(F, I_A0) + (size_t)L * RW_W : pi == 5 ? inp(F, I_V0) + (size_t)(L > 0 ? L - 1 : 0) * RW_W
                             : pi == 6 ? inp(F, I_KK) + (size_t)L * RW_W : pi == 7 ? inp(F, I_KA) + (size_t)L * RW_W : inp(F, I_RK) + (size_t)L * RW_W;
        const float x = src[h * HD + F.lane];
        PL[pi * 64 + F.lane] = (pi == 5 && L == 0) ? 0.f : x; }
    __syncthreads();
    v2u rr[2][2], rk_[2][2], rv[2][2], rvg[2], rvf[2], rdc[2], ric[2];
#define REC_LOAD(blk) do { \
        _Pragma("unroll") for (int p_ = 0; p_ < 2; ++p_) { int s_ = (blk) * REC_TB + ltk + 16 * p_; s_ = s_ > TSEQ - 1 ? TSEQ - 1 : s_; const int sp_ = s_ > 0 ? s_ - 1 : 0; \
            const size_t ro_ = (size_t)seq_row(b, s_) * RW_W + C, rp_ = (size_t)seq_row(b, sp_) * RW_W + C; \
            rr[p_][0] = *(const GAS v2u*)(RKVp + ro_); rr[p_][1] = *(const GAS v2u*)(RKVp + rp_); \
            rk_[p_][0] = *(const GAS v2u*)(RKVp + (size_t)MP * 1024 + ro_); rk_[p_][1] = *(const GAS v2u*)(RKVp + (size_t)MP * 1024 + rp_); \
            rv[p_][0] = *(const GAS v2u*)(RKVp + (size_t)2 * MP * 1024 + ro_); rv[p_][1] = *(const GAS v2u*)(RKVp + (size_t)2 * MP * 1024 + rp_); \
            rdc[p_] = *(const GAS v2u*)(DECp + ro_); ric[p_] = *(const GAS v2u*)(ICLp + ro_); \
            if (L > 0) { rvg[p_] = *(const GAS v2u*)(VGp + ro_); rvf[p_] = *(const GAS v2u*)(FVF(F) + ro_); } } } while (0)
#define UB4(u) ((f32x4){__uint_as_float((u).x << 16), __uint_as_float((u).x & 0xffff0000u), __uint_as_float((u).y << 16), __uint_as_float((u).y & 0xffff0000u)})
#define REC_STORE(bi, blk) do { int lj2_ = lt & 15; asm volatile("" : "+v"(lj2_)); const LAS float* plj = PL + 4 * lj2_;     \
        _Pragma("unroll") for (int p_ = 0; p_ < 2; ++p_) { const int tk_ = ltk + 16 * p_, s_ = (blk) * REC_TB + tk_; const float pm_ = s_ > 0 ? 1.f : 0.f; \
            f32x4 xr_, xk_, xv_, dec_, icl_, vv_; \
            { const f32x4 mu_r = *(const LAS f32x4*)(plj), mu_k = *(const LAS f32x4*)(plj + 64), mu_v = *(const LAS f32x4*)(plj + 128); \
              const f32x4 r1_ = UB4(rr[p_][0]), k1_ = UB4(rk_[p_][0]), v1_ = UB4(rv[p_][0]); \
              xr_ = r1_ + mu_r * (UB4(rr[p_][1]) * pm_ - r1_); xk_ = k1_ + mu_k * (UB4(rk_[p_][1]) * pm_ - k1_); xv_ = v1_ + mu_v * (UB4(rv[p_][1]) * pm_ - v1_); } \
            asm volatile("" ::: "memory"); \
            { const f32x4 wl_ = UB4(rdc[p_]) + *(const LAS f32x4*)(plj + 192), al_ = UB4(ric[p_]) + *(const LAS f32x4*)(plj + 256); vv_ = xv_; \
              if (L > 0) { const f32x4 vf_ = UB4(rvf[p_]), vg_ = UB4(rvg[p_]) + *(const LAS f32x4*)(plj + 320); \
                  _Pragma("unroll") for (int e_ = 0; e_ < 4; ++e_) vv_[e_] = xv_[e_] + (vf_[e_] - xv_[e_]) * __builtin_amdgcn_rcpf(1.0f + __expf(-vg_[e_])); } \
              _Pragma("unroll") for (int e_ = 0; e_ < 4; ++e_) {        \
                  dec_[e_] = __expf(-0.60653066f * __builtin_amdgcn_rcpf(1.0f + __expf(-wl_[e_]))); icl_[e_] = __builtin_amdgcn_rcpf(1.0f + __expf(-al_[e_])); } } \
            asm volatile("" ::: "memory"); \
            const f32x4 kkc = *(const LAS f32x4*)(plj + 384), kac = *(const LAS f32x4*)(plj + 448), rkc = *(const LAS f32x4*)(plj + 512); \
            f32x4 kk_, k2_, bb_, wr_; float skk_ = 0.f, srk_ = 0.f, sbr_ = 0.f, skr_ = 0.f; \
            _Pragma("unroll") for (int e_ = 0; e_ < 4; ++e_) { \
                kk_[e_] = xk_[e_] * kkc[e_]; skk_ += kk_[e_] * kk_[e_]; k2_[e_] = xk_[e_] * (1.0f + (icl_[e_] - 1.0f) * kac[e_]); \
                srk_ += xr_[e_] * k2_[e_] * rkc[e_]; skr_ += k2_[e_] * xr_[e_]; } \
            const float inv_ = rsqrtf(row16_sum(skk_) + 1e-12f); \
            _Pragma("unroll") for (int e_ = 0; e_ < 4; ++e_) { kk_[e_] *= inv_; bb_[e_] = kk_[e_] * icl_[e_]; sbr_ += bb_[e_] * xr_[e_]; wr_[e_] = dec_[e_] * xr_[e_]; } \
            const float br_ = row16_sum(sbr_), kr_ = row16_sum(skr_); \
            LAS float* rec_ = buf + (bi) * (REC_TB * REC_LF) + tk_ * REC_LF + 4 * lj; \
            *(LAS f32x4*)(rec_) = dec_; *(LAS f32x4*)(rec_ + HD) = k2_; *(LAS f32x4*)(rec_ + 2 * HD) = -kk_; *(LAS f32x4*)(rec_ + 3 * HD) = bb_; *(LAS f32x4*)(rec_ + 4 * HD) = wr_; *(LAS f32x4*)(rec_ + 5 * HD) = vv_; \
            if (lj == 0) *(LAS f32x2*)(rec_ + REC_F) = (f32x2){br_, kr_}; \
            if (q == 0 && s_ < TSEQ) { const size_t ro_ = (size_t)seq_row(b, s_) * RW_W + C; const float rks_ = row16_sum(srk_); \
                *(GAS f32x4*)((GAS float*)(F.ws + WS_OV + OV_RW) + ro_) = vv_; if (lj == 0) ((GAS float*)(F.ws + WS_OV + OV_RKS))[(size_t)seq_row(b, s_) * NH + h] = rks_; \
                if (L == 0) { v2u o_; o_.x = pk2(xv_[0], xv_[1]); o_.y = pk2(xv_[2], xv_[3]); *(GAS v2u*)(FVF(F) + ro_) = o_; } } \
            asm volatile("" ::: "memory"); } } while (0)
#define REC_LD(X, tk) do { const LAS float* q_ = rp + (tk) * REC_LF; w##X = *(const LAS f32x4*)(q_); k##X = *(const LAS f32x4*)(q_ + HD); a##X = *(const LAS f32x4*)(q_ + 2 * HD); b##X = *(const LAS f32x4*)(q_ + 3 * HD); r##X = *(const LAS f32x4*)(q_ + 4 * HD); \
        v##X = q_[5 * HD - 4 * j + vrow]; s##X = *(const LAS f32x2*)(q_ + REC_F - 4 * j); } while (0)
#define REC_STEP(X, tk) do { float t0_, t1_, u0_, u1_, q0_, q1_, q2_, q3_, o_; \
        asm("v_mul_f32 %4, %0, %12\n\tv_mul_f32 %5, %0, %16\n\tv_fmac_f32 %4, %1, %13\n\tv_fmac_f32 %5, %1, %17\n\t" \
            "v_mul_f32 %6, %2, %14\n\tv_mul_f32 %7, %2, %18\n\tv_fmac_f32 %6, %3, %15\n\tv_fmac_f32 %7, %3, %19\n\t" \
            "v_add_f32 %4, %4, %6\n\tv_add_f32 %5, %5, %7\n\t" \
            "v_mul_f32 %8, %28, %24\n\t" \
            "v_add_f32_dpp %4, %4, %4 quad_perm:[1,0,3,2] row_mask:0xf bank_mask:0xf bound_ctrl:1\n\tv_add_f32_dpp %5, %5, %5 quad_perm:[1,0,3,2] row_mask:0xf bank_mask:0xf bound_ctrl:1\n\t" \
            "v_mul_f32 %9, %28, %25\n\t" \
            "v_add_f32_dpp %4, %4, %4 quad_perm:[2,3,0,1] row_mask:0xf bank_mask:0xf bound_ctrl:1\n\tv_add_f32_dpp %5, %5, %5 quad_perm:[2,3,0,1] row_mask:0xf bank_mask:0xf bound_ctrl:1\n\t" \
            "v_mul_f32 %10, %28, %26\n\t" \
            "v_add_f32_dpp %4, %4, %4 row_ror:4 row_mask:0xf bank_mask:0xf bound_ctrl:1\n\tv_add_f32_dpp %5, %5, %5 row_ror:4 row_mask:0xf bank_mask:0xf bound_ctrl:1\n\t" \
            "v_mul_f32 %11, %28, %27\n\t" \
            "v_add_f32_dpp %4, %4, %4 row_ror:8 row_mask:0xf bank_mask:0xf bound_ctrl:1\n\tv_add_f32_dpp %5, %5, %5 row_ror:8 row_mask:0xf bank_mask:0xf bound_ctrl:1\n\t" \
            "v_fma_f32 %0, %0, %20, %8\n\tv_fma_f32 %1, %1, %21, %9\n\tv_fma_f32 %2, %2, %22, %10\n\tv_fma_f32 %3, %3, %23, %11" \
            : "+v"(S[0]), "+v"(S[1]), "+v"(S[2]), "+v"(S[3]), "=&v"(t0_), "=&v"(u0_), "=&v"(t1_), "=&v"(u1_), "=&v"(q0_), "=&v"(q1_), "=&v"(q2_), "=&v"(q3_) \
            : "v"(a##X[0]), "v"(a##X[1]), "v"(a##X[2]), "v"(a##X[3]), "v"(r##X[0]), "v"(r##X[1]), "v"(r##X[2]), "v"(r##X[3]), "v"(w##X[0]), "v"(w##X[1]), "v"(w##X[2]), "v"(w##X[3]), \
              "v"(k##X[0]), "v"(k##X[1]), "v"(k##X[2]), "v"(k##X[3]), "v"(v##X)); \
        asm("v_fmac_f32 %0, %5, %7\n\tv_fmac_f32 %1, %5, %8\n\tv_fmac_f32 %2, %5, %9\n\tv_fmac_f32 %3, %5, %10\n\tv_fma_f32 %4, %5, %11, %6\n\tv_fmac_f32 %4, %13, %12" \
            : "+v"(S[0]), "+v"(S[1]), "+v"(S[2]), "+v"(S[3]), "=&v"(o_) \
            : "v"(t0_), "v"(u0_), "v"(b##X[0]), "v"(b##X[1]), "v"(b##X[2]), "v"(b##X[3]), "v"(s##X[0]), "v"(s##X[1]), "v"(v##X)); \
        ob[(tk) * 16 + lrow] = o_; } while (0)
    const bool conv = F.wave >= 5 && L + 1 < DEPTH;
    LAS unsigned* cscr = (LAS unsigned*)(buf + REC_OBUF + 2 * REC_TB * 16) + (F.wave - 5) * (64 * 36);
    int ct = F.vcu * 3 + (F.wave - 5);
    if (loader) { REC_LOAD(0); REC_STORE(0, 0); REC_LOAD(1); }
    __syncthreads();
    for (int blk = 0; blk < REC_NBLK; ++blk) {
        const int s0 = blk * REC_TB, nt = TSEQ - s0 < REC_TB ? TSEQ - s0 : REC_TB;
        LAS float* ob = buf + REC_OBUF + (blk & 1) * (REC_TB * 16);
        if (loader) {
            if (blk + 1 < REC_NBLK) REC_STORE((blk + 1) & 1, blk + 1);
            if (blk > 0) { const LAS float* pb = buf + REC_OBUF + ((blk - 1) & 1) * (REC_TB * 16); const int ps0 = s0 - REC_TB;
#pragma unroll
                for (int i = 0; i < 2; ++i) { const int idx = lt + 256 * i, tk = idx >> 4, r = idx & 15; O[(size_t)seq_row(b, ps0 + tk) * RW_W + h * HD + q * 16 + r] = pb[idx]; } }
            if (conv) { int m_, it_;
                if (tr_decode(L + 1, ct, m_, it_)) { const TrDesc d = tr_desc(F, L + 1, m_); f32x4 cv[16]; tr_tile_load(d, it_, F.lane, cv); tr_tile_finish(d, it_, F.lane, cv, cscr); ct += 3 * F.G; } }
            if (blk + 2 < REC_NBLK) REC_LOAD(blk + 2);
        } else {
            const LAS float* rp = buf + (blk & 1) * (REC_TB * REC_LF) + 4 * j;
            f32x4 wA, kA, aA, bA, rA, wB, kB, aB, bB, rB; float vA, vB; f32x2 sA, sB;
            REC_LD(A, 0);
            if (nt == REC_TB) {
#pragma unroll
                for (int tk = 0; tk < REC_TB; tk += 2) {
                    REC_LD(B, tk + 1);
                    REC_STEP(A, tk);
                    if (tk + 2 < REC_TB) REC_LD(A, tk + 2);
                    REC_STEP(B, tk + 1);
                }
            } else {
                for (int tk = 0; tk < nt; tk += 2) {
                    REC_LD(B, tk + 1);
                    REC_STEP(A, tk);
                    if (tk + 2 < nt) REC_LD(A, tk + 2);
                    REC_STEP(B, tk + 1);
                }
            }
        }
        __syncthreads();
    }
    if (loader) { const int lb = REC_NBLK - 1, ps0 = lb * REC_TB, nt = TSEQ - ps0; const LAS float* pb = buf + REC_OBUF + (lb & 1) * (REC_TB * 16);
        int b2 = b; asm volatile("" : "+s"(b2));
#pragma unroll
        for (int i = 0; i < 2; ++i) { const int idx = lt + 256 * i, tk = idx >> 4, r = idx & 15; if (tk < nt) O[(size_t)seq_row(b2, ps0 + tk) * RW_W + h * HD + q * 16 + r] = pb[idx]; } }
    if (conv) {
        for (;;) { int m_, it_; if (!tr_decode(L + 1, ct, m_, it_)) break;
            const TrDesc d = tr_desc(F, L + 1, m_); f32x4 cv[16]; tr_tile_load(d, it_, F.lane, cv); tr_tile_finish(d, it_, F.lane, cv, cscr); ct += 3 * F.G; }
    }
    __syncthreads();
#undef REC_LOAD
#undef UB4
#undef REC_STORE
#undef REC_LD
#undef REC_STEP
}
constexpr int CH_T = 16, CH_N = TSEQ / CH_T;
constexpr int CR_BYTES = 12288, CR_AT = 0, CR_RT = 2048, CR_BK = 4096, CR_ARK = 8192, CR_VT = 9216, CR_GT = 11264, CR_W15 = 11776;
constexpr size_t OV_CR = OV_RW + 192 * MiB;
static_assert(TSEQ % CH_T == 0, "chunks"); static_assert(OV_CR + (size_t)BATCH * NH * CH_N * CR_BYTES <= OV_O, "chunk records");
typedef short bfx4 __attribute__((ext_vector_type(4)));
__device__ __forceinline__ float sigm_(float x) { return __builtin_amdgcn_rcpf(1.0f + __expf(-x)); }
template <int CTRL, int RMASK> __device__ __forceinline__ float dppf(float x) { return __builtin_bit_cast(float, __builtin_amdgcn_update_dpp(0, __builtin_bit_cast(int, x), CTRL, RMASK, 0xF, false)); }
__device__ __forceinline__ void wave_sum2(float& x, float& y) {
    x += dppf<0xB1, 0xF>(x); y += dppf<0xB1, 0xF>(y); x += dppf<0x4E, 0xF>(x); y += dppf<0x4E, 0xF>(y); x += dppf<0x124, 0xF>(x); y += dppf<0x124, 0xF>(y); x += dppf<0x128, 0xF>(x); y += dppf<0x128, 0xF>(y);
    x += dppf<0x142, 0xA>(x); y += dppf<0x142, 0xA>(y); x += dppf<0x143, 0xC>(x); y += dppf<0x143, 0xC>(y);
    x = lane_bcast(x, 63); y = lane_bcast(y, 63);
}
__device__ __forceinline__ LAS float* rwkv_prep_par(Frame& F, int L, int h) {
    constexpr float LOG2E = 1.4426950408889634f; const int lane = F.lane; const size_t lc = (size_t)L * RW_W + h * HD;
    LAS float* pp = (LAS float*)(F.lds + RING_OFF + 8 * 12288 + F.wave * 2304);
    const GAS float* mu = inp(F, I_MUSH) + (size_t)L * 3360 + h * HD;
    pp[lane] = mu[lane]; pp[64 + lane] = mu[1024 + lane]; pp[128 + lane] = mu[2048 + lane];
    pp[192 + lane] = -LOG2E * (inp(F, I_W0) + lc)[lane]; pp[256 + lane] = -LOG2E * (inp(F, I_A0) + lc)[lane];
    float v0 = 0.f; if (L > 0) v0 = -LOG2E * (inp(F, I_V0) + (lc - RW_W))[lane];
    pp[320 + lane] = v0; pp[384 + lane] = (inp(F, I_KK) + lc)[lane]; pp[448 + lane] = (inp(F, I_KA) + lc)[lane]; pp[512 + lane] = (inp(F, I_RK) + lc)[lane];
    return pp;
}
__device__ __forceinline__ void rwkv_prep_item(Frame& F, int L, int b, int h, int c, const LAS float* pp) {
    const int lane = F.lane, c16 = lane & 15, g = lane >> 4;
    LAS unsigned char* pl = F.lds + RING_OFF + F.wave * 12288;
    LAS bf16* M = (LAS bf16*)pl; LAS float* NT = (LAS float*)(pl + 9216); LAS float* AKT = NT + 256; LAS float* XGT = AKT + 256;
    GAS unsigned char* rec = F.ws + WS_OV + OV_CR + ((size_t)(b * NH + h) * CH_N + c) * CR_BYTES;
    const int rb = c == 0 ? MR : b * SEQ + (c - 1) * CH_T;
    const int rprev = c == 0 ? MR : (c == 1 ? MR + NMETA - 1 : rb - 1); const float pm0 = c == 0 ? 0.f : 1.f;
    constexpr float LOG2E = 1.4426950408889634f;
    const float mu_r = pp[lane], mu_k = pp[64 + lane], mu_v = pp[128 + lane], w0 = pp[192 + lane], a0 = pp[256 + lane], v0 = pp[320 + lane], k_k = pp[384 + lane], k_a = pp[448 + lane], r_k = pp[512 + lane];
    constexpr size_t PL = (size_t)MP * 1024;
    const GAS bf16* Rg = (const GAS bf16*)(F.ws + WS_OV + OV_RKV) + h * HD; GAS bf16* VFg = FVF(F) + h * HD;
    const int wrow = lane >> 3, wpc = lane & 7; v4u wr_[2], wk_[2], wv_[2], wf_[2];
#pragma unroll
    for (int i = 0; i < 2; ++i) { const size_t ro = (size_t)(rb + 8 * i + wrow) * 1024 + wpc * 8;
        wr_[i] = __builtin_nontemporal_load((const GAS v4u*)(Rg + ro)); wk_[i] = __builtin_nontemporal_load((const GAS v4u*)(Rg + PL + ro)); wv_[i] = __builtin_nontemporal_load((const GAS v4u*)(Rg + 2 * PL + ro));
        wf_[i] = (v4u){0u, 0u, 0u, 0u}; if (L > 0) wf_[i] = *(const GAS v4u*)(VFg + ro); }
    unsigned dl[8], il[8], gl[8];
    {
        const GAS bf16* LAg = (const GAS bf16*)(F.ws + WS_OV + OV_LA) + (size_t)(rb + c16) * LKP + 8 * g;
        const GAS bf16* WLg = (const GAS bf16*)(F.ws + WS_W + (size_t)(L & 1) * W_SLOT + WO_LORA) + (size_t)(h * HD + c16) * LKP + 8 * g;
        LAS float* TS = (LAS float*)pl;
#pragma unroll
        for (int kd = 0; kd < 3; ++kd) { const int kind = kd == 2 ? 3 : kd, kb = kd == 0 ? 0 : kd == 1 ? 64 : 288, nks = kd == 2 ? 1 : 2;
            if (kd == 2 && L == 0) break;
            bfx8 lb[2];
#pragma unroll
            for (int sk = 0; sk < nks; ++sk) lb[sk] = *(const GAS bfx8*)(LAg + kb + 32 * sk);
#pragma unroll
            for (int tile = 0; tile < 4; ++tile) { f32x4 acc = {0.f, 0.f, 0.f, 0.f};
#pragma unroll
                for (int sk = 0; sk < nks; ++sk) acc = __builtin_amdgcn_mfma_f32_16x16x32_bf16(*(const GAS bfx8*)(WLg + (size_t)(kind * 1024 + 16 * tile) * LKP + kb + 32 * sk), lb[sk], acc, 0, 0, 0);
#pragma unroll
                for (int e = 0; e < 4; ++e) TS[(16 * tile + 4 * g + e) * 20 + c16] = acc[e]; }
#pragma unroll
            for (int q = 0; q < 4; ++q) { const f32x4 v = *(const LAS f32x4*)(TS + lane * 20 + 4 * q);
#pragma unroll
                for (int e = 0; e < 2; ++e) { const unsigned u2 = cvt2(v[2 * e], v[2 * e + 1]); if (kd == 0) dl[2 * q + e] = u2; else if (kd == 1) il[2 * q + e] = u2; else gl[2 * q + e] = u2; } }
            asm volatile("" ::: "memory");
        }
    }
#pragma unroll
    for (int i = 0; i < 2; ++i) { LAS bf16* wp = M + (8 * i + wrow) * 72 + wpc * 8;
        *(LAS bfx8*)(wp) = __builtin_bit_cast(bfx8, wr_[i]); *(LAS bfx8*)(wp + 1152) = __builtin_bit_cast(bfx8, wk_[i]); *(LAS bfx8*)(wp + 2304) = __builtin_bit_cast(bfx8, wv_[i]); *(LAS bfx8*)(wp + 3456) = __builtin_bit_cast(bfx8, wf_[i]); }
    GAS bf16* Vout = (GAS bf16*)(F.ws + WS_OV + OV_RW) + h * HD; GAS float* RKS = (GAS float*)(F.ws + WS_OV + OV_RKS);
    float pr = bfu((Rg + (size_t)rprev * 1024)[lane]) * pm0, pk = bfu((Rg + PL + (size_t)rprev * 1024)[lane]) * pm0, pv = bfu((Rg + 2 * PL + (size_t)rprev * 1024)[lane]) * pm0;
    float cum = 0.f, wex = 1.f, Ah[16], rksv = 0.f; unsigned Bp[8], Kq[8], Vq[8], bkl = 0u; float vlo = 0.f;
    LAS bf16* VO = (LAS bf16*)NT;
#pragma unroll
    for (int hf = 0; hf < 2; ++hf) {
#pragma unroll
        for (int e = 0; e < 8; ++e) { const int t = 8 * hf + e; const size_t ro = (size_t)(rb + t) * 1024;
            const float r1 = bfu(M[t * 72 + lane]), k1 = bfu(M[1152 + t * 72 + lane]), v1 = bfu(M[2304 + t * 72 + lane]), vf1 = bfu(M[3456 + t * 72 + lane]);
            const float xr = r1 + mu_r * (pr - r1), xk = k1 + mu_k * (pk - k1), xv = v1 + mu_v * (pv - v1); pr = r1; pk = k1; pv = v1;
#define PKF(a_) ((t & 1) ? __uint_as_float((a_)[t >> 1] & 0xffff0000u) : __uint_as_float((a_)[t >> 1] << 16))
            const float sg = __builtin_amdgcn_rcpf(1.0f + __builtin_amdgcn_exp2f(__builtin_fmaf(PKF(dl), -LOG2E, w0))), icl = __builtin_amdgcn_rcpf(1.0f + __builtin_amdgcn_exp2f(__builtin_fmaf(PKF(il), -LOG2E, a0)));
            float vv = xv; if (L > 0) vv = xv + (vf1 - xv) * __builtin_amdgcn_rcpf(1.0f + __builtin_amdgcn_exp2f(__builtin_fmaf(PKF(gl), -LOG2E, v0)));
#undef PKF
            float kk = xk * k_k; const float k2 = xk * (1.0f + (icl - 1.0f) * k_a);
            float skk = kk * kk, rks = xr * k2 * r_k; wave_sum2(skk, rks);
            kk *= __builtin_amdgcn_rsqf(skk + 1e-12f);
            rksv = lane == t ? rks : rksv;
            cum = __builtin_fmaf(sg, -0.60653066f * LOG2E, cum); const float win = __builtin_amdgcn_exp2f(cum), iwin = __builtin_amdgcn_exp2f(-cum);
            const float ah = -kk * wex, rh = xr * win, bh = kk * icl * iwin, kh = k2 * iwin; wex = win; Ah[t] = ah;
            const unsigned ar = cvt2(ah, rh), bk = cvt2(bh, kh);
            M[t * 72 + lane] = (bf16)ar; M[1152 + t * 72 + lane] = (bf16)(ar >> 16); M[2304 + t * 72 + lane] = (bf16)bk; M[3456 + t * 72 + lane] = (bf16)(bk >> 16);
            if (t & 1) { Bp[t >> 1] = (bkl & 0xffffu) | (bk << 16); Kq[t >> 1] = (bkl >> 16) | (bk & 0xffff0000u); Vq[t >> 1] = cvt2(vlo, vv); VO[(t - 1) * 72 + lane] = (bf16)Vq[t >> 1]; VO[t * 72 + lane] = (bf16)(Vq[t >> 1] >> 16); } else { bkl = bk; vlo = vv; } }
    }
    int l2_ = lane; asm volatile("" : "+v"(l2_));
    if (l2_ < 16) RKS[(size_t)(rb + l2_) * NH + h] = rksv; const int wrow2 = l2_ >> 3, wpc2 = l2_ & 7;
#pragma unroll
    for (int i = 0; i < 2; ++i) __builtin_nontemporal_store(__builtin_bit_cast(v4u, *(const LAS bfx8*)(VO + (8 * i + wrow2) * 72 + wpc2 * 8)), (GAS v4u*)(Vout + (size_t)(rb + 8 * i + wrow2) * 1024 + wpc2 * 8));
    if (L == 0) {
#pragma unroll
        for (int i = 0; i < 2; ++i) *(GAS v4u*)(VFg + (size_t)(rb + 8 * i + wrow2) * 1024 + wpc2 * 8) = __builtin_bit_cast(v4u, *(const LAS bfx8*)(VO + (8 * i + wrow2) * 72 + wpc2 * 8)); }
    f32x4 Nm = {0.f, 0.f, 0.f, 0.f}, AK = Nm, RB = Nm, RK = Nm;
#pragma unroll
    for (int s = 0; s < 2; ++s) { const int o = c16 * 72 + 32 * s + 8 * g;
        const bfx8 at = *(const LAS bfx8*)(M + o), rt = *(const LAS bfx8*)(M + 1152 + o), bt = *(const LAS bfx8*)(M + 2304 + o), kt = *(const LAS bfx8*)(M + 3456 + o);
        Nm = __builtin_amdgcn_mfma_f32_16x16x32_bf16(bt, at, Nm, 0, 0, 0); AK = __builtin_amdgcn_mfma_f32_16x16x32_bf16(kt, at, AK, 0, 0, 0);
        RB = __builtin_amdgcn_mfma_f32_16x16x32_bf16(bt, rt, RB, 0, 0, 0); RK = __builtin_amdgcn_mfma_f32_16x16x32_bf16(kt, rt, RK, 0, 0, 0); }
#pragma unroll
    for (int e = 0; e < 4; ++e) { const int s = 4 * g + e; if (!(s < c16)) { Nm[e] = 0.f; AK[e] = 0.f; } if (!(s <= c16)) { RB[e] = 0.f; RK[e] = 0.f; } }
    *(LAS f32x4*)(NT + c16 * 16 + 4 * g) = Nm; *(LAS f32x4*)(AKT + c16 * 16 + 4 * g) = AK;
    { v4u o; o.x = cvt2(RB[0], RB[1]); o.y = cvt2(RB[2], RB[3]); o.z = cvt2(RK[0], RK[1]); o.w = cvt2(RK[2], RK[3]); __builtin_nontemporal_store(o, (GAS v4u*)(rec + CR_ARK + lane * 16)); }
    float X[16], Gx[16];
#pragma unroll
    for (int t = 0; t < 16; ++t) { float xa = Ah[t], xg = AKT[t * 16 + c16];
#pragma unroll
        for (int q = 0; q < (t + 3) / 4; ++q) { const f32x4 n4 = *(const LAS f32x4*)(NT + t * 16 + 4 * q);
#pragma unroll
            for (int e = 0; e < 4; ++e) if (4 * q + e < t) { xa += n4[e] * X[4 * q + e]; xg += n4[e] * Gx[4 * q + e]; } }
        X[t] = xa; Gx[t] = xg; }
#pragma unroll
    for (int t = 0; t < 16; t += 2) { const unsigned x2 = cvt2(X[t], X[t + 1]); M[t * 72 + lane] = (bf16)x2; M[(t + 1) * 72 + lane] = (bf16)(x2 >> 16); }
#pragma unroll
    for (int t = 0; t < 16; ++t) XGT[t * 16 + c16] = Gx[t];
#pragma unroll
    for (int s = 0; s < 2; ++s) { const int o = c16 * 72 + 32 * s + 4 * g;
        const v2u a0_ = __builtin_bit_cast(v2u, *(const LAS bfx4*)(M + o)), a1_ = __builtin_bit_cast(v2u, *(const LAS bfx4*)(M + o + 16)), r0_ = __builtin_bit_cast(v2u, *(const LAS bfx4*)(M + 1152 + o)), r1_ = __builtin_bit_cast(v2u, *(const LAS bfx4*)(M + 1152 + o + 16));
        __builtin_nontemporal_store((v4u){a0_.x, a0_.y, a1_.x, a1_.y}, (GAS v4u*)(rec + CR_AT + s * 1024 + lane * 16)); __builtin_nontemporal_store((v4u){r0_.x, r0_.y, r1_.x, r1_.y}, (GAS v4u*)(rec + CR_RT + s * 1024 + lane * 16)); }
    { const f32x4 xg = *(const LAS f32x4*)(XGT + c16 * 16 + 4 * g); v2u o; o.x = cvt2(xg[0], xg[1]); o.y = cvt2(xg[2], xg[3]); __builtin_nontemporal_store(o, (GAS v2u*)(rec + CR_GT + lane * 8)); }
    *(GAS float*)(rec + CR_W15 + lane * 4) = wex;
#pragma unroll
    for (int q = 0; q < 4; ++q) {
        __builtin_nontemporal_store((v4u){Bp[2 * q], Bp[2 * q + 1], Kq[2 * q], Kq[2 * q + 1]}, (GAS v4u*)(rec + CR_BK + g * 1024 + (c16 + 16 * q) * 16));
        __builtin_nontemporal_store((v2u){Vq[2 * q], Vq[2 * q + 1]}, (GAS v2u*)(rec + CR_VT + g * 512 + (c16 + 16 * q) * 8)); }
}
__device__ __forceinline__ void rwkv_chunk_rec(Frame& F, int L, int b, int h) {
    const int lane = F.lane, c16 = lane & 15, g = lane >> 4, w = F.wave;
    const GAS unsigned char* recs = F.ws + WS_OV + OV_CR + (size_t)(b * NH + h) * CH_N * CR_BYTES;
    LAS unsigned char* ring = F.lds + RING_OFF;
    constexpr int DIST = 6, NSLOT = 8;
    __syncthreads();
    if (w >= 4) {
        const int p0 = (w - 4) * 3;
#define CR_ISSUE(cc) do { const GAS unsigned char* gs_ = recs + (size_t)(cc) * CR_BYTES + p0 * 1024 + lane * 16; LAS unsigned char* ld_ = ring + ((cc) % NSLOT) * CR_BYTES + p0 * 1024; \
        _Pragma("unroll") for (int i_ = 0; i_ < 3; ++i_) __builtin_amdgcn_global_load_lds((const GAS unsigned*)(gs_ + i_ * 1024), (LAS unsigned*)(ld_ + i_ * 1024), 16, 0, 2); } while (0)
        for (int cc = 0; cc < DIST; ++cc) CR_ISSUE(cc);
        for (int c = 0; c < CH_N; ++c) {
            if (c + DIST < CH_N) { CR_ISSUE(c + DIST); asm volatile("s_waitcnt vmcnt(18)" ::: "memory"); } else asm volatile("s_waitcnt vmcnt(0)" ::: "memory");
            __builtin_amdgcn_s_barrier();
        }
#undef CR_ISSUE
    } else {
        f32x4 ST[4];
#pragma unroll
        for (int n = 0; n < 4; ++n) ST[n] = (f32x4){0.f, 0.f, 0.f, 0.f};
        v4u SB0 = {0u, 0u, 0u, 0u}, SB1 = SB0;
        GAS float* O = (GAS float*)(F.ws + WS_OV + OV_O) + h * HD + 16 * w + c16;
        for (int c = 0; c < CH_N; ++c) {
            __builtin_amdgcn_s_barrier(); asm volatile("" ::: "memory");
            const LAS unsigned char* sl = ring + (c % NSLOT) * CR_BYTES;
            const bfx8 AT0 = *(const LAS bfx8*)(sl + CR_AT + lane * 16), AT1 = *(const LAS bfx8*)(sl + CR_AT + 1024 + lane * 16), RT0 = *(const LAS bfx8*)(sl + CR_RT + lane * 16), RT1 = *(const LAS bfx8*)(sl + CR_RT + 1024 + lane * 16);
            const bfx8 ARK = *(const LAS bfx8*)(sl + CR_ARK + lane * 16);
            bfx8 BK[4]; f32x4 W15[4];
#pragma unroll
            for (int n = 0; n < 4; ++n) { BK[n] = *(const LAS bfx8*)(sl + CR_BK + n * 1024 + lane * 16); W15[n] = *(const LAS f32x4*)(sl + CR_W15 + (16 * n + 4 * g) * 4); }
            const v2u VT = *(const LAS v2u*)(sl + CR_VT + w * 512 + lane * 8), GT = *(const LAS v2u*)(sl + CR_GT + lane * 8);
            const bfx8 sb0 = __builtin_bit_cast(bfx8, SB0), sb1 = __builtin_bit_cast(bfx8, SB1);
            f32x4 Z = {0.f, 0.f, 0.f, 0.f}, OT = Z;
            Z = __builtin_amdgcn_mfma_f32_16x16x32_bf16(AT0, sb0, Z, 0, 0, 0); Z = __builtin_amdgcn_mfma_f32_16x16x32_bf16(AT1, sb1, Z, 0, 0, 0);
            Z = __builtin_amdgcn_mfma_f32_16x16x16bf16_1k(__builtin_bit_cast(bfx4, GT), __builtin_bit_cast(bfx4, VT), Z, 0, 0, 0);
            OT = __builtin_amdgcn_mfma_f32_16x16x32_bf16(RT0, sb0, OT, 0, 0, 0); OT = __builtin_amdgcn_mfma_f32_16x16x32_bf16(RT1, sb1, OT, 0, 0, 0);
            v4u zv; zv.x = cvt2(Z[0], Z[1]); zv.y = cvt2(Z[2], Z[3]); zv.z = VT.x; zv.w = VT.y;
            const bfx8 zvb = __builtin_bit_cast(bfx8, zv);
            OT = __builtin_amdgcn_mfma_f32_16x16x32_bf16(ARK, zvb, OT, 0, 0, 0);
#pragma unroll
            for (int n = 0; n < 4; ++n) ST[n] = __builtin_amdgcn_mfma_f32_16x16x32_bf16(BK[n], zvb, ST[n], 0, 0, 0) * W15[n];
            SB0.x = cvt2(ST[0][0], ST[0][1]); SB0.y = cvt2(ST[0][2], ST[0][3]); SB0.z = cvt2(ST[1][0], ST[1][1]); SB0.w = cvt2(ST[1][2], ST[1][3]);
            SB1.x = cvt2(ST[2][0], ST[2][1]); SB1.y = cvt2(ST[2][2], ST[2][3]); SB1.z = cvt2(ST[3][0], ST[3][1]); SB1.w = cvt2(ST[3][2], ST[3][3]);
            const int rb = c == 0 ? MR : b * SEQ + (c - 1) * CH_T;
#pragma unroll
            for (int e = 0; e < 4; ++e) __builtin_nontemporal_store(OT[e], O + (size_t)(rb + 4 * g + e) * RW_W);
        }
    }
    __syncthreads();
}
constexpr int CONV_EARLY = 0;
__device__ __forceinline__ void conv_share(Frame& F, int L, int wg, int nwg, int lo, int hi) {
    LAS unsigned* cscr = (LAS unsigned*)(F.lds + RING_OFF + F.wave * 16384);
    for (int ct = lo + wg * NWAVES + F.wave; ct < hi; ct += nwg * NWAVES) { int m_, it_; if (!tr_decode(L, ct, m_, it_)) break;
        const TrDesc d = tr_desc(F, L, m_); f32x4 cv[16]; tr_tile_load(d, it_, F.lane, cv); tr_tile_finish(d, it_, F.lane, cv, cscr); }
}
struct PostIn { f32x4 o; v2u v, g; float rk; };
__device__ __forceinline__ PostIn rwkv_post_load(Frame& F, int row, int hq) {
    const int hl = F.lane >> 4, j = F.lane & 15, h = 4 * hq + hl, C = h * HD + 4 * j; const size_t RC = (size_t)row * RW_W + C;
    PostIn p; p.o = __builtin_nontemporal_load((const GAS f32x4*)((const GAS float*)(F.ws + WS_OV + OV_O) + RC));
    p.v = __builtin_nontemporal_load((const GAS v2u*)((const GAS bf16*)(F.ws + WS_OV + OV_RW) + RC));
    p.g = __builtin_nontemporal_load((const GAS v2u*)((const GAS bf16*)(F.ws + WS_OV + OV_GT) + RC));
    p.rk = ((const GAS float*)(F.ws + WS_OV + OV_RKS))[(size_t)row * NH + h];
    return p;
}
__device__ __forceinline__ f32x4 ub4(const v2u u) { return (f32x4){__uint_as_float(u.x << 16), __uint_as_float(u.x & 0xffff0000u), __uint_as_float(u.y << 16), __uint_as_float(u.y & 0xffff0000u)}; }
__device__ __forceinline__ void rwkv_post_finish(Frame& F, const PostIn& p, int row, int hq, const f32x4 lw, const f32x4 lb) {
    const int hl = F.lane >> 4, j = F.lane & 15, h = 4 * hq + hl, C = h * HD + 4 * j; const size_t RC = (size_t)row * RW_W + C;
    const f32x4 o = p.o;
    const float mean = row16_sum((o[0] + o[1]) + (o[2] + o[3])) * (1.0f / HD); const f32x4 d = o - mean;
    const float var = row16_sum((d[0] * d[0] + d[1] * d[1]) + (d[2] * d[2] + d[3] * d[3])) * (1.0f / HD);
    const float rs = rsqrtf(var + HD * 1e-5f);
    const f32x4 y = (d * rs * lw + lb + p.rk * ub4(p.v)) * ub4(p.g);
    v2u w; w.x = pk2(y[0], y[1]); w.y = pk2(y[2], y[3]);
    *(GAS v2u*)((GAS bf16*)(F.ws + WS_OV + OV_YB) + RC) = w;
}
__device__ __forceinline__ void rwkv_post_all(Frame& F, int L, int gw, int NGW) {
    const int hq = gw & 3;
    const int hl = F.lane >> 4, j = F.lane & 15, C = (4 * hq + hl) * HD + 4 * j; const size_t LC = (size_t)L * RW_W + C;
    const f32x4 lw = *(const GAS f32x4*)(inp(F, I_LNW) + LC), lb = *(const GAS f32x4*)(inp(F, I_LNB) + LC);
    constexpr int NT = MROWS * 4;
    for (int t = gw; t < NT; t += 4 * NGW) {
        PostIn p[4];
#pragma unroll
        for (int i = 0; i < 4; ++i) { const int ti = t + i * NGW; p[i] = rwkv_post_load(F, (ti < NT ? ti : t) >> 2, hq); }
#pragma unroll
        for (int i = 0; i < 4; ++i) { const int ti = t + i * NGW; if (ti < NT) rwkv_post_finish(F, p[i], ti >> 2, hq, lw, lb); }
    }
}
__device__ __forceinline__ void final_norm(Frame& F, GAS float* out) {
    const int gw = F.vcu * NWAVES + F.wave, NGW = F.G * NWAVES; const GAS float* gn = inp(F, I_FINN);
    for (int m = gw; m < MR; m += NGW) {
        f32x4 v[8]; float s = 0.f;
#pragma unroll
        for (int j = 0; j < 4; ++j) { pg8::unpackh8(((const GAS v4u*)(FX16(F) + (size_t)m * DM))[F.lane + 64 * j], v[2 * j], v[2 * j + 1]);
            s += ((v[2 * j][0] * v[2 * j][0] + v[2 * j][1] * v[2 * j][1]) + (v[2 * j][2] * v[2 * j][2] + v[2 * j][3] * v[2 * j][3])) + ((v[2 * j + 1][0] * v[2 * j + 1][0] + v[2 * j + 1][1] * v[2 * j + 1][1]) + (v[2 * j + 1][2] * v[2 * j + 1][2] + v[2 * j + 1][3] * v[2 * j + 1][3])); }
        const float inv = rsqrtf(wave_sum(s) * (1.0f / DM) + NORM_EPS);
#pragma unroll
        for (int j = 0; j < 4; ++j) { const int c8 = 8 * (F.lane + 64 * j);
            ((GAS f32x4*)(out + (size_t)m * DM + c8))[0] = v[2 * j] * inv * ((const GAS f32x4*)(gn + c8))[0]; ((GAS f32x4*)(out + (size_t)m * DM + c8))[1] = v[2 * j + 1] * inv * ((const GAS f32x4*)(gn + c8))[1]; }
    }
}
constexpr int INVTAB_OFF = LDSCTL_OFF + 4096;
__device__ __forceinline__ const LAS float* fill_inv_table(Frame& F, const GAS unsigned long long* ss, int G, int c) {
    if (G != 256) return nullptr;
    LAS float* tab = (LAS float*)(F.lds + INVTAB_OFF); const int base = 8 * (c & 7) * 256;
#pragma unroll
    for (int i = 0; i < 4; ++i) { const int r = F.tid + 512 * i; tab[r] = rsqrtf((float)(long long)ss[base + r] * (pg8::SS_INV_SCALE / (float)DM) + 1e-6f); }
    __syncthreads();
    return tab;
}
constexpr int NPH = 14;
struct Args { const float* in[N_IN]; float* out; unsigned char* ws; int l_lo, l_hi, ph_lo, ph_hi; };
__global__ void __launch_bounds__(NWAVES * 64, 2) mk_fwd(Args args) {
    extern __shared__ __attribute__((aligned(16))) unsigned char lds[];
    Frame F;
    F.lds = (LAS unsigned char*)lds;
    F.MISC = (volatile LAS unsigned*)(F.lds + MISC_OFF);
    F.tid = threadIdx.x; F.lane = F.tid & 63; F.wave = __builtin_amdgcn_readfirstlane(F.tid >> 6);
    F.G = gridDim.x; { const int bx = blockIdx.x; F.vcu = (F.G % 8 == 0) ? (bx % 8) * (F.G / 8) + bx / 8 : bx; }
    F.ws = (GAS unsigned char*)args.ws;
    F.ctl = (gu32*)(args.ws + WS_CTL);
    for (int u = F.tid; u < (LDS_BYTES - LDSCTL_OFF) / 4; u += NWAVES * 64) ((LAS unsigned*)(F.lds + LDSCTL_OFF))[u] = 0u;
    __syncthreads();
    if (F.tid < N_IN) ((LAS unsigned long long*)(F.lds + LDSCTL_OFF))[F.tid] = (unsigned long long)args.in[F.tid];
    __syncthreads();
    XcdBarrier bar; bar.bar = (unsigned*)(F.ctl + CW_BAR); bar.x = 0; bar.st = nullptr;
    if (!MK_MULTI) bar = xcd_barrier_post((unsigned*)(F.ctl + CW_BAR), F.MISC + 8);
#define GRID_BAR() do { if (MK_MULTI) { if (F.tid == 0) __hip_atomic_store(F.ctl + CW_TMO, 0xBADBA0u, RLX_AGENT); } else { xcd_barrier(bar); } } while (0)
    const int lo = args.ph_lo, hi = args.ph_hi;
#ifndef PH_MASK
#define PH_MASK 0x3FFF
#endif
#define IN(k) ((((PH_MASK) >> (k)) & 1) && lo <= (k) && (k) < hi)
#define BOTH(k) (IN(k) && IN((k) + 1))
#ifndef REPEAT_MASK
#define REPEAT_MASK 0
#endif
#define PHASE(k) for (int rep_ = (IN(k) ? 1 + (((REPEAT_MASK) >> (k)) & 1) : 0); rep_ > 0; --rep_)
    const int wave0_ = __builtin_amdgcn_readfirstlane((int)threadIdx.x >> 6);
#define PH_ENV() int lane_; asm volatile("v_mbcnt_lo_u32_b32 %0, -1, 0\n\tv_mbcnt_hi_u32_b32 %0, -1, %0" : "=v"(lane_));     \
    unsigned char* wsl_ = args.ws; int bx_ = (int)blockIdx.x, tid_ = (wave0_ << 6) | lane_, G_ = (int)gridDim.x, Lp = L; asm volatile("" : "+s"(wsl_), "+s"(bx_), "+s"(G_), "+s"(Lp), "+v"(tid_)); GAS unsigned char* wsl = (GAS unsigned char*)wsl_; \
    F.ws = wsl; F.tid = tid_; F.lane = tid_ & 63; F.wave = __builtin_amdgcn_readfirstlane(tid_ >> 6); F.G = G_; F.vcu = (G_ % 8 == 0) ? (bx_ % 8) * (G_ / 8) + bx_ / 8 : bx_; \
    GAS unsigned char* ov = wsl + WS_OV; GAS unsigned char* wb = wsl + WS_W + (size_t)(Lp & 1) * W_SLOT; (void)ov; (void)wb; \
    const int gw = F.vcu * NWAVES + F.wave, NGW = F.G * NWAVES; (void)gw; (void)NGW;

    for (int L = args.l_lo; L < args.l_hi; ++L) {
        PHASE(0) { PH_ENV();
            if (Lp == 0 || G_ != 256) {
                if (Lp == 0) px_init(F);
                s5_build(F, Lp); lora_weights(F, Lp); pw_zero_rows(F, Lp);
                if (Lp == 0) { __syncthreads(); conv_share(F, 0, bx_, G_, 0, 1 << 30); }
                if (BOTH(0)) GRID_BAR(); } }
        PHASE(1) { PH_ENV();
            pg8::Gemm g{FXB(F), (const GAS bf16*)(wb + WO_GU1), MR, 2 * DFF, DM}; pg8::StaticOrder S; S.init(MR, 2 * DFF, G_, bx_);
            pg8::EpiSwiglu E{FSSC(F), (GAS bf16*)(ov + OV_ACT), DFF, fill_inv_table(F, FSSC(F), G_, bx_)};
            pg8::gemm_phase<pg8::EpiSwiglu, pg8::StaticOrder, true, true>(F.lds + RING_OFF, g, S, E, tid_); pg8::thin_gemm(F.lds + RING_OFF, g, E, G_, bx_, MR, tid_);
            if (BOTH(1)) GRID_BAR();
        }
        PHASE(2) { PH_ENV();
            pg8::Gemm g{(const GAS bf16*)(ov + OV_ACT), (const GAS bf16*)(wb + WO_D1), MR, DM, DFF}; pg8::StaticOrder S; S.init(MR, DM, G_, bx_);
            pg8::EpiResid E{FX16(F), FXB(F), FSSA(F), ((REPEAT_MASK & 4) && rep_ == 2) ? 0.0f : 0.5f, ((REPEAT_MASK & 4) && rep_ == 2) ? 1 : 0};
            pg8::gemm_phase<pg8::EpiResid, pg8::StaticOrder, true, true>(F.lds + RING_OFF, g, S, E, tid_); pg8::thin_gemm(F.lds + RING_OFF, g, E, G_, bx_, MR, tid_);
            if (BOTH(2)) GRID_BAR();
        }
        PHASE(3) { PH_ENV();
            pg8::Gemm g{FXB(F), (const GAS bf16*)(wb + WO_IN), MR, NIN, DM}; pg8::StaticOrder S; S.init(MR, NIN, G_, bx_);
            typedef pg8::EpiWin<OV_U2, OV_RKV, OV_GA, OV_GB, OV_LIN, MP> EpiW; EpiW E{FSSA(F), ov, fill_inv_table(F, FSSA(F), G_, bx_)};
            pg8::gemm_phase<EpiW, pg8::StaticOrder, true, true>(F.lds + RING_OFF, g, S, E, tid_); pg8::thin_gemm(F.lds + RING_OFF, g, E, G_, bx_, MR, tid_);
            if (Lp + 1 < DEPTH && G_ == 256 && bx_ >= 128) { const int vs = F.vcu, gs = F.G; F.vcu = bx_ - 128; F.G = 128; s5_build(F, Lp + 1); lora_weights(F, Lp + 1); pw_zero_rows(F, Lp + 1); F.vcu = vs; F.G = gs;
                __syncthreads(); conv_share(F, Lp + 1, bx_ - 128, 128, 0, CONV_EARLY); }
            if (BOTH(3)) GRID_BAR();
        }
        PHASE(4) { PH_ENV();
            { unsigned zlo = 0u; asm volatile("" : "+v"(zlo)); const unsigned long long z64 = zlo;
              for (int i = bx_ * (NWAVES * 64) + F.tid; i < MP; i += F.G * NWAVES * 64) { FSSA(F)[i] = z64; FSSB(F)[i] = z64; FSSC(F)[i] = z64; } }
            for (int u = F.vcu; u < BATCH * NG; u += F.G) s5_unit(F, Lp, u >> 6, u & 63);
            lora_inputs(F, Lp);
            if (BOTH(4)) GRID_BAR();
        }
        PHASE(5) { PH_ENV();
            { int KL = LKP; asm volatile("" : "+s"(KL));
              pg8::Gemm g{(const GAS bf16*)(ov + OV_LA), (const GAS bf16*)(wb + WO_LORA) + (size_t)2048 * LKP, MR, 1024, KL}; pg8::StaticOrder S; S.init(MR, 1024, G_, bx_);
              typedef pg8::EpiLora<OV_GT, OV_GT, OV_GT, OV_GT> EpiL; EpiL E{ov};
              pg8::gemm_phase<EpiL, pg8::StaticOrder, true, true>(F.lds + RING_OFF, g, S, E, tid_); pg8::thin_gemm(F.lds + RING_OFF, g, E, G_, bx_, MR, tid_); }
        }
        PHASE(6) { PH_ENV();
            { pg8::Gemm g{(const GAS bf16*)(ov + OV_YPRE), (const GAS bf16*)(wb + WO_GLU), MR, SW, SW}; pg8::StaticOrder S; S.init(MR, SW, G_, bx_);
              pg8::EpiGlu E{(const GAS bf16*)(ov + OV_YPRE), (GAS bf16*)(ov + OV_YA), SW};
              pg8::gemm_phase<pg8::EpiGlu, pg8::StaticOrder, true, true>(F.lds + RING_OFF, g, S, E, tid_); pg8::thin_gemm(F.lds + RING_OFF, g, E, G_, bx_, MR, tid_); }
            __syncthreads();
            { const int bh = gw & 63; const LAS float* pp = rwkv_prep_par(F, Lp, bh & 15);
              for (int it = gw; it < BATCH * NH * CH_N; it += NGW) { int bb = bh >> 4, hh = bh & 15; asm volatile("" : "+s"(bb), "+s"(hh));
                  rwkv_prep_item(F, Lp, bb, hh, it >> 6, pp); } }
            if (IN(6) && IN(7)) GRID_BAR();
        }
        PHASE(7) { PH_ENV();
            const int nrec = G_ > 64 ? 64 : G_;
            for (int u = bx_; u < BATCH * NH; u += nrec) { if (bx_ < nrec) rwkv_chunk_rec(F, Lp, u >> 4, u & 15); else break; }
            if (Lp + 1 < DEPTH) { const int lo = G_ == 256 ? CONV_EARLY : 0; if (G_ > 64) { if (bx_ >= 64) conv_share(F, Lp + 1, bx_ - 64, G_ - 64, lo, 1 << 30); } else conv_share(F, Lp + 1, bx_, G_, lo, 1 << 30); }
            else if (G_ > 64 && bx_ >= 64) {
                pg8::Gemm g{(const GAS bf16*)(ov + OV_YA), (const GAS bf16*)(wb + WO_UA), MR, DM, SW}; pg8::StaticOrder S; S.init(MR, DM, G_ - 64, bx_ - 64);
                pg8::EpiGateMul<false> E{(const GAS bf16*)(ov + OV_GA), (GAS bf16*)(ov + OV_MG)};
                pg8::gemm_phase<pg8::EpiGateMul<false>, pg8::StaticOrder, true, true>(F.lds + RING_OFF, g, S, E, tid_); pg8::thin_gemm(F.lds + RING_OFF, g, E, G_ - 64, bx_ - 64, MR, tid_); }
            if (BOTH(7)) GRID_BAR();
        }
        PHASE(8) { PH_ENV();
            rwkv_post_all(F, Lp, gw, NGW);
            if (!(Lp + 1 == DEPTH && G_ > 64))
            { pg8::Gemm g{(const GAS bf16*)(ov + OV_YA), (const GAS bf16*)(wb + WO_UA), MR, DM, SW}; pg8::StaticOrder S; S.init(MR, DM, G_, bx_);
              pg8::EpiGateMul<false> E{(const GAS bf16*)(ov + OV_GA), (GAS bf16*)(ov + OV_MG)};
              pg8::gemm_phase<pg8::EpiGateMul<false>, pg8::StaticOrder, true, true>(F.lds + RING_OFF, g, S, E, tid_); pg8::thin_gemm(F.lds + RING_OFF, g, E, G_, bx_, MR, tid_); }
            if (BOTH(8)) GRID_BAR();
        }
        PHASE(9) { PH_ENV();
            pg8::Gemm g{(const GAS bf16*)(ov + OV_YB), (const GAS bf16*)(wb + WO_UB), MR, DM, RW_W}; pg8::StaticOrder S; S.init(MR, DM, G_, bx_);
            pg8::EpiGateMul<true> E{(const GAS bf16*)(ov + OV_GB), (GAS bf16*)(ov + OV_MG)};
            pg8::gemm_phase<pg8::EpiGateMul<true>, pg8::StaticOrder, true, true>(F.lds + RING_OFF, g, S, E, tid_); pg8::thin_gemm(F.lds + RING_OFF, g, E, G_, bx_, MR, tid_);
            if (BOTH(9)) GRID_BAR();
        }
        PHASE(10) { PH_ENV();
            pg8::Gemm g{(const GAS bf16*)(ov + OV_MG), (const GAS bf16*)(wb + WO_O), MR, DM, DM}; pg8::StaticOrder S; S.init(MR, DM, G_, bx_);
            pg8::EpiResid E{FX16(F), FXB(F), FSSB(F), 1.0f};
            pg8::gemm_phase<pg8::EpiResid, pg8::StaticOrder, true, true>(F.lds + RING_OFF, g, S, E, tid_); pg8::thin_gemm(F.lds + RING_OFF, g, E, G_, bx_, MR, tid_);
            if (BOTH(10)) GRID_BAR();
        }
        PHASE(11) { PH_ENV();
            pg8::Gemm g{FXB(F), (const GAS bf16*)(wb + WO_GU2), MR, 2 * DFF, DM}; pg8::StaticOrder S; S.init(MR, 2 * DFF, G_, bx_);
            pg8::EpiSwiglu E{FSSB(F), (GAS bf16*)(ov + OV_ACT), DFF, fill_inv_table(F, FSSB(F), G_, bx_)};
            pg8::gemm_phase<pg8::EpiSwiglu, pg8::StaticOrder, true, true>(F.lds + RING_OFF, g, S, E, tid_); pg8::thin_gemm(F.lds + RING_OFF, g, E, G_, bx_, MR, tid_);
            if (BOTH(11)) GRID_BAR();
        }
        PHASE(12) { PH_ENV();
            pg8::Gemm g{(const GAS bf16*)(ov + OV_ACT), (const GAS bf16*)(wb + WO_D2), MR, DM, DFF}; pg8::StaticOrder S; S.init(MR, DM, G_, bx_);
            pg8::EpiResid E{FX16(F), FXB(F), FSSC(F), 0.5f};
            pg8::gemm_phase<pg8::EpiResid, pg8::StaticOrder, true, true>(F.lds + RING_OFF, g, S, E, tid_); pg8::thin_gemm(F.lds + RING_OFF, g, E, G_, bx_, MR, tid_);
            if (IN(13) || L + 1 < args.l_hi) GRID_BAR();
        }
        if (IN(13) && L == DEPTH - 1) { PH_ENV(); final_norm(F, (GAS float*)args.out); }
    }
#undef IN
#undef BOTH
}

extern "C" void kernel_launch(void* const* d_in, const int* in_sizes, int n_in, void* d_out, int out_size, void* d_ws, size_t ws_size, hipStream_t stream) {
    static int grid = 0;
    if (grid == 0) {
        if (n_in != N_IN || in_sizes[0] != MR * DM || out_size != MR * DM || ws_size < WS_END) {
            fprintf(stderr, "kernel_launch: built for %d inputs, x/out of %d floats, >= %zu bytes of workspace; got n_in %d, in0 %d, out %d, ws %zu; nothing launched\n", (int)N_IN, MR * DM, (size_t)WS_END, n_in, n_in > 0 ? in_sizes[0] : -1, out_size, ws_size);
            grid = -1; return; }
        int dev = 0, cus = 0, per_cu = 0;
        if (hipGetDevice(&dev) != hipSuccess || hipDeviceGetAttribute(&cus, hipDeviceAttributeMultiprocessorCount, dev) != hipSuccess) { fprintf(stderr, "kernel_launch: device query failed\n"); grid = -1; return; }
        if (hipFuncSetAttribute((const void*)mk_fwd, hipFuncAttributeMaxDynamicSharedMemorySize, LDS_BYTES) != hipSuccess) { fprintf(stderr, "kernel_launch: hipFuncSetAttribute failed\n"); grid = -1; return; }
        if (hipOccupancyMaxActiveBlocksPerMultiprocessor(&per_cu, (const void*)mk_fwd, NWAVES * 64, LDS_BYTES) != hipSuccess || per_cu < 1)
            fprintf(stderr, "kernel_launch: note: occupancy query reports %d workgroups per CU\n", per_cu);
        (void)hipGetLastError();
        grid = cus;
    }
    if (grid < 0) return;
    if (hipMemsetAsync((char*)d_ws + WS_CTL, 0, CTL_ZERO_BYTES, stream) != hipSuccess) { fprintf(stderr, "kernel_launch: memset failed\n"); return; }
    Args a{};
    for (int i = 0; i < N_IN; ++i) a.in[i] = (const float*)d_in[i];
    a.out = (float*)d_out; a.ws = (unsigned char*)d_ws;
#if MK_MULTI
    for (int L = 0; L < DEPTH; ++L) for (int p = 0; p < NPH; ++p) { if (p == NPH - 1 && L != DEPTH - 1) continue; a.l_lo = L; a.l_hi = L + 1; a.ph_lo = p; a.ph_hi = p + 1;
        hipLaunchKernelGGL(mk_fwd, dim3(grid), dim3(NWAVES * 64), LDS_BYTES, stream, a); }
#else
    a.l_lo = 0; a.l_hi = DEPTH; a.ph_lo = 0; a.ph_hi = NPH;
    hipLaunchKernelGGL(mk_fwd, dim3(grid), dim3(NWAVES * 64), LDS_BYTES, stream, a);
#endif
    const hipError_t le = hipPeekAtLastError();
    if (le != hipSuccess) fprintf(stderr, "kernel_launch: launch failed: %s\n", hipGetErrorName(le));
}
```

```cpp
#include <hip/hip_runtime.h>
#include <cstdio>
#include <cstdint>
namespace pg8 {
#define PG8_LAS __attribute__((address_space(3)))
#define PG8_GAS __attribute__((address_space(1)))
typedef unsigned short bf16_t;
typedef short bf16x8 __attribute__((ext_vector_type(8)));
typedef _Float16 f16x8 __attribute__((ext_vector_type(8)));
typedef float f32x4 __attribute__((ext_vector_type(4)));
typedef unsigned u32x4 __attribute__((ext_vector_type(4)));
constexpr int BM = 256, BK = 64, HALF = 128, HTB = HALF * BK * 2  , STAGE_BYTES = 8 * HTB, NXCD = 8, WGM = 8;

__host__ __device__ __forceinline__ int lds_byte(int r, int c) { const int st = (r >> 4) * 2 + (c >> 5), rr = r & 15, cc = c & 31, ob = rr * 64 + cc * 2; return st * 1024 + (ob ^ (((ob >> 9) & 1) << 5)); }
__host__ __device__ __forceinline__ void stage_rc(int b, int& R, int& C) { const int st = b / 1024, sb = b % 1024, swz = sb ^ (((sb >> 9) & 1) << 5); R = (st >> 1) * 16 + swz / 64; C = (st & 1) * 32 + (swz % 64) / 2; }
__host__ __device__ __forceinline__ int perm32(int rho) { const int n = rho >> 4, i = rho & 15; return 8 * (i >> 2) + 4 * n + (i & 3); }

struct Unit { int pm, pn; };
struct Gemm { const PG8_GAS bf16_t* A; const PG8_GAS bf16_t* Bt; int M, N, K; };

struct StaticOrder {
    int nM, nN, nwg, G, c;
    __host__ __device__ void init(int M, int N, int G_, int c_) { nM = M / BM; nN = N / BM; nwg = nM * nN; G = G_; c = c_; }
    __host__ __device__ bool next(int i, Unit& u) const {
        const long L = (long)i * G + c; if (L >= nwg) return false;
        int wgid = (int)L; { const int q = nwg / NXCD, r = nwg % NXCD, xcd = wgid % NXCD, off = wgid / NXCD; wgid = (xcd < r ? xcd * (q + 1) : r * (q + 1) + (xcd - r) * q) + off; }
        const int nig = WGM * nN, gid = wgid / nig, fm = gid * WGM, gsz = (nM - fm) < WGM ? (nM - fm) : WGM;
        u.pm = fm + ((wgid % nig) % gsz); u.pn = (wgid % nig) / gsz;
#if defined(__HIP_DEVICE_COMPILE__)
        u.pm = __builtin_amdgcn_readfirstlane(u.pm); u.pn = __builtin_amdgcn_readfirstlane(u.pn);
#endif
        return true;
    }
    __device__ __forceinline__ void a_ready(const Unit&) const {}
    __device__ __forceinline__ void done(const Unit&) const {}
};

__device__ __forceinline__ unsigned cvt_pk_bf16(float lo, float hi) { unsigned r; asm volatile("v_cvt_pk_bf16_f32 %0, %1, %2" : "=v"(r) : "v"(lo), "v"(hi)); return r; }
typedef float f32x2 __attribute__((ext_vector_type(2)));
__device__ __forceinline__ f32x2 gelu_pk(f32x2 v) {
    const f32x2 av = __builtin_elementwise_abs(v), d = av * 0.2316418882f + 1.0f;
    f32x2 t; t.x = __builtin_amdgcn_rcpf(d.x); t.y = __builtin_amdgcn_rcpf(d.y);
    f32x2 q = t * 0.5307027145f + (-0.7265760135f); q = q * t + 0.7107068705f; q = q * t + (-0.142248368f); q = q * t + 0.127414796f; q = q * t;
    const f32x2 s = (v * v) * (-0.72134752044f);
    f32x2 e; e.x = __builtin_amdgcn_exp2f(s.x); e.y = __builtin_amdgcn_exp2f(s.y);
    const f32x2 m = v * (q * e), r = v - m;
    f32x2 o; o.x = v.x < 0.f ? m.x : r.x; o.y = v.y < 0.f ? m.y : r.y; return o;
}

template <int ACT  > struct EpiBf16 {
    static constexpr bool PERM = true, AFTER_DRAIN = false; static_assert(ACT == 0 || ACT == 1, "EpiBf16: ACT is 0 (none) or 1 (gelu_pk)");
    bf16_t* O; int ldc; const float* bias; int split_cols; size_t split_stride; float scale0;
    __device__ __forceinline__ void operator()(const f32x4 (&acc)[2][2][4][2], const Unit& u, int wr, int wc, int fr, int fq) const {
        const int row0 = u.pm * BM + wr * 64 + fr; int colt = u.pn * BM; bf16_t* base = O;
        float sc = 1.f; if (split_cols) { const int t = colt / split_cols; base += (size_t)t * split_stride; colt -= t * split_cols; if (t == 0) sc = scale0; }
        const int col0 = colt + wc * 32 + 8 * fq, bcol0 = u.pn * BM + wc * 32 + 8 * fq;
        f32x4 bv[2][2];
#pragma unroll
        for (int bj = 0; bj < 2; ++bj)
#pragma unroll
            for (int n = 0; n < 2; ++n) bv[bj][n] = bias ? *(const f32x4*)(bias + bcol0 + bj * HALF + 4 * n) : (f32x4){0.f, 0.f, 0.f, 0.f};
#pragma unroll
        for (int ai = 0; ai < 2; ++ai)
#pragma unroll
            for (int m = 0; m < 4; ++m) { bf16_t* rowp = base + (size_t)(row0 + ai * HALF + m * 16) * ldc + col0;
#pragma unroll
                for (int bj = 0; bj < 2; ++bj) { f32x4 v0 = acc[ai][bj][m][0] + bv[bj][0], v1 = acc[ai][bj][m][1] + bv[bj][1];
                    if (ACT == 1) { f32x2 a = gelu_pk((f32x2){v0[0], v0[1]}), b = gelu_pk((f32x2){v0[2], v0[3]}), c = gelu_pk((f32x2){v1[0], v1[1]}), d = gelu_pk((f32x2){v1[2], v1[3]});
                        v0 = (f32x4){a.x, a.y, b.x, b.y}; v1 = (f32x4){c.x, c.y, d.x, d.y}; }
                    v0 = v0 * sc; v1 = v1 * sc; u32x4 w; w.x = cvt_pk_bf16(v0[0], v0[1]); w.y = cvt_pk_bf16(v0[2], v0[3]); w.z = cvt_pk_bf16(v1[0], v1[1]); w.w = cvt_pk_bf16(v1[2], v1[3]);
                    *(u32x4*)(rowp + bj * HALF) = w; } }
    }
};


template <class Epi, class Sched, bool ALIGN_EPI = false, bool SP2 = false, bool F16 = false>
__device__ __forceinline__ void gemm_phase(PG8_LAS unsigned char* lds, const Gemm g, const Sched& S, const Epi& E, const int tid) {
    const int wid = __builtin_amdgcn_readfirstlane(tid >> 6), lane = tid & 63, wr = wid >> 2, wc = wid & 3, fr = lane & 15, fq = lane >> 4;
    const int K = g.K, nt = K / BK;
    unsigned voffA[2], voffB[2];
#pragma unroll
    for (int i = 0; i < 2; ++i) { int R, C; stage_rc(tid * 16 + i * 8192, R, C); const int Rb = Epi::PERM ? ((R & ~31) + perm32(R & 31)) : R;
        voffA[i] = (unsigned)(R * K + C) * 2u; voffB[i] = (unsigned)(Rb * K + C) * 2u; }
    const size_t kstep = (size_t)(BK * 2);
    const size_t hstep = (size_t)HALF * K * 2;
    const size_t tstep = 2 * hstep;
    const unsigned ldsw = (unsigned)wid * 1024u;
    const int aoff = lds_byte(wr * 64 + fr, fq * 8), boff = lds_byte(wc * 32 + fr, fq * 8);
#define PG8_SA(b, h) (((b) * 2 + (h)) * HTB)
#define PG8_SB(b, h) ((4 + (b) * 2 + (h)) * HTB)
#define PG8_STAGE(bufoff, gbase, voff) do { _Pragma("unroll") for (int _i = 0; _i < 2; ++_i) \
        __builtin_amdgcn_global_load_lds((const PG8_GAS unsigned*)((const PG8_GAS char*)(gbase) + (voff)[_i]), (PG8_LAS unsigned*)(lds + (bufoff) + ldsw + _i * 8192), 16, 0, 0); } while (0)
#define PG8_LDA(dst, b, h) do { _Pragma("unroll") for (int m = 0; m < 4; ++m) _Pragma("unroll") for (int k = 0; k < 2; ++k) dst[m][k] = *(const PG8_LAS bf16x8*)(lds + PG8_SA(b, h) + aoff + m * 2048 + k * 1024); } while (0)
#define PG8_LDB(dst, b, h) do { _Pragma("unroll") for (int n = 0; n < 2; ++n) _Pragma("unroll") for (int k = 0; k < 2; ++k) dst[n][k] = *(const PG8_LAS bf16x8*)(lds + PG8_SB(b, h) + boff + n * 2048 + k * 1024); } while (0)
#define PG8_MMA(ai, bj, At, Bt) do { __builtin_amdgcn_s_setprio(1); _Pragma("unroll") for (int m = 0; m < 4; ++m) _Pragma("unroll") for (int n = 0; n < 2; ++n) _Pragma("unroll") for (int k = 0; k < 2; ++k) \
        acc[ai][bj][m][n] = F16 ? __builtin_amdgcn_mfma_f32_16x16x32_f16(__builtin_bit_cast(f16x8, Bt[n][k]), __builtin_bit_cast(f16x8, At[m][k]), acc[ai][bj][m][n], 0, 0, 0) \
                                : __builtin_amdgcn_mfma_f32_16x16x32_bf16(Bt[n][k], At[m][k], acc[ai][bj][m][n], 0, 0, 0); __builtin_amdgcn_s_setprio(0); } while (0)
#define PG8_WAIT_V(n) asm volatile("s_waitcnt vmcnt(" #n ")" ::: "memory")
#define PG8_WAIT_L(n) asm volatile("s_waitcnt lgkmcnt(" #n ")" ::: "memory")
#define PG8_BAR __builtin_amdgcn_s_barrier()
#define PG8_SCHED __builtin_amdgcn_sched_barrier(0)
    Unit cur, nxt; int ui = 0;
    if (!S.next(0, cur)) return;
    f32x4 acc[2][2][4][2];
#pragma unroll
    for (int a = 0; a < 2; ++a)
#pragma unroll
        for (int b = 0; b < 2; ++b)
#pragma unroll
            for (int m = 0; m < 4; ++m)
#pragma unroll
                for (int n = 0; n < 2; ++n) acc[a][b][m][n] = (f32x4){0.f, 0.f, 0.f, 0.f};
    bf16x8 At[4][2], B0[2][2], B1[2][2];
    const PG8_GAS char* cA = (const PG8_GAS char*)g.A + (size_t)cur.pm * tstep; const PG8_GAS char* cB = (const PG8_GAS char*)g.Bt + (size_t)cur.pn * tstep;
    S.a_ready(cur);
    if constexpr (SP2) {
        PG8_STAGE(PG8_SB(0, 0), cB, voffB); PG8_STAGE(PG8_SB(0, 1), cB + hstep, voffB); PG8_STAGE(PG8_SA(0, 0), cA, voffA); PG8_STAGE(PG8_SA(0, 1), cA + hstep, voffA);
        if (wr == 1) PG8_BAR;
        PG8_WAIT_V(2); PG8_BAR;
        PG8_STAGE(PG8_SB(1, 0), cB + kstep, voffB); PG8_STAGE(PG8_SA(1, 0), cA + kstep, voffA); PG8_STAGE(PG8_SB(1, 1), cB + hstep + kstep, voffB);
        PG8_WAIT_V(6); PG8_BAR;
    } else {
        PG8_STAGE(PG8_SB(0, 0), cB, voffB); PG8_STAGE(PG8_SA(0, 0), cA, voffA); PG8_STAGE(PG8_SB(0, 1), cB + hstep, voffB); PG8_STAGE(PG8_SA(0, 1), cA + hstep, voffA);
        if (wr == 1) PG8_BAR;
        PG8_WAIT_V(4); PG8_BAR;
        PG8_STAGE(PG8_SB(1, 0), cB + kstep, voffB); PG8_STAGE(PG8_SA(1, 0), cA + kstep, voffA); PG8_STAGE(PG8_SB(1, 1), cB + hstep + kstep, voffB);
        PG8_WAIT_V(6); PG8_BAR;
    }
    for (;;) {
        const bool has_next = S.next(ui + 1, nxt);
        const PG8_GAS char* nA = has_next ? (const PG8_GAS char*)g.A + (size_t)nxt.pm * tstep : cA; const PG8_GAS char* nB = has_next ? (const PG8_GAS char*)g.Bt + (size_t)nxt.pn * tstep : cB;
        for (int t = 0; t < nt; t += 2) {
            const bool last = (t == nt - 2);
            const PG8_GAS char* a1 = cA + (size_t)(t + 1) * kstep;
            const PG8_GAS char* a2 = last ? nA : cA + (size_t)(t + 2) * kstep; const PG8_GAS char* b2 = last ? nB : cB + (size_t)(t + 2) * kstep;
            const PG8_GAS char* a3 = a2 + kstep; const PG8_GAS char* b3 = b2 + kstep;
            if (last && has_next) S.a_ready(nxt);
            if constexpr (SP2) {
            PG8_LDB(B0, 0, 0); PG8_LDB(B1, 0, 1); PG8_SCHED; PG8_LDA(At, 0, 0); PG8_STAGE(PG8_SA(1, 1), a1 + hstep, voffA);
            PG8_WAIT_V(8); PG8_WAIT_L(0); PG8_BAR; PG8_MMA(0, 0, At, B0); PG8_MMA(0, 1, At, B1); PG8_BAR; PG8_SCHED;
            PG8_LDA(At, 0, 1); PG8_STAGE(PG8_SB(0, 0), b2, voffB); PG8_STAGE(PG8_SB(0, 1), b2 + hstep, voffB); PG8_STAGE(PG8_SA(0, 0), a2, voffA);
            PG8_WAIT_V(8); PG8_WAIT_L(0); PG8_BAR; PG8_MMA(1, 0, At, B0); PG8_MMA(1, 1, At, B1); PG8_BAR; PG8_SCHED;
            PG8_LDB(B0, 1, 0); PG8_LDB(B1, 1, 1); PG8_SCHED; PG8_LDA(At, 1, 0); PG8_STAGE(PG8_SA(0, 1), a2 + hstep, voffA);
            PG8_WAIT_V(8); PG8_WAIT_L(0); PG8_BAR; PG8_MMA(0, 0, At, B0); PG8_MMA(0, 1, At, B1); PG8_BAR; PG8_SCHED;
            PG8_LDA(At, 1, 1); PG8_STAGE(PG8_SB(1, 0), b3, voffB); PG8_STAGE(PG8_SB(1, 1), b3 + hstep, voffB); PG8_STAGE(PG8_SA(1, 0), a3, voffA);
            PG8_WAIT_V(8); PG8_WAIT_L(0); PG8_BAR; PG8_MMA(1, 0, At, B0); PG8_MMA(1, 1, At, B1); PG8_BAR; PG8_SCHED;
            } else {
            PG8_LDB(B0, 0, 0); PG8_SCHED; PG8_LDA(At, 0, 0); PG8_STAGE(PG8_SA(1, 1), a1 + hstep, voffA);
            PG8_WAIT_L(8); PG8_BAR; PG8_WAIT_L(0); PG8_MMA(0, 0, At, B0); PG8_BAR; PG8_SCHED;
            PG8_LDB(B1, 0, 1); PG8_STAGE(PG8_SB(0, 0), b2, voffB);
            PG8_BAR; PG8_WAIT_L(0); PG8_MMA(0, 1, At, B1); PG8_BAR;
            PG8_LDA(At, 0, 1); PG8_STAGE(PG8_SA(0, 0), a2, voffA);
            PG8_BAR; PG8_WAIT_L(0); PG8_MMA(1, 0, At, B0); PG8_BAR; PG8_SCHED;
            PG8_STAGE(PG8_SB(0, 1), b2 + hstep, voffB);
            PG8_WAIT_V(6); PG8_BAR; PG8_MMA(1, 1, At, B1); PG8_BAR;
            PG8_LDB(B0, 1, 0); PG8_SCHED; PG8_LDA(At, 1, 0); PG8_STAGE(PG8_SA(0, 1), a2 + hstep, voffA);
            PG8_WAIT_L(8); PG8_BAR; PG8_WAIT_L(0); PG8_MMA(0, 0, At, B0); PG8_BAR; PG8_SCHED;
            PG8_LDB(B1, 1, 1); PG8_STAGE(PG8_SB(1, 0), b3, voffB);
            PG8_BAR; PG8_WAIT_L(0); PG8_MMA(0, 1, At, B1); PG8_BAR;
            PG8_LDA(At, 1, 1); PG8_STAGE(PG8_SA(1, 0), a3, voffA);
            PG8_BAR; PG8_WAIT_L(0); PG8_MMA(1, 0, At, B0); PG8_BAR; PG8_SCHED;
            PG8_STAGE(PG8_SB(1, 1), b3 + hstep, voffB);
            PG8_WAIT_V(6); PG8_BAR; PG8_MMA(1, 1, At, B1); PG8_BAR;
            }
        }
        if constexpr (ALIGN_EPI) { if (wr == 0) PG8_BAR; }
        if constexpr (!Epi::AFTER_DRAIN) { E(acc, cur, wr, wc, fr, fq); S.done(cur); }
        if (!has_next) break;
#pragma unroll
        for (int a = 0; a < 2; ++a)
#pragma unroll
            for (int b = 0; b < 2; ++b)
#pragma unroll
                for (int m = 0; m < 4; ++m)
#pragma unroll
                    for (int n = 0; n < 2; ++n) acc[a][b][m][n] = (f32x4){0.f, 0.f, 0.f, 0.f};
        cur = nxt; cA = nA; cB = nB; ++ui;
        if constexpr (ALIGN_EPI) { if (wr == 1) PG8_BAR; }
    }
    PG8_WAIT_V(0);
    if constexpr (!ALIGN_EPI) { if (wr == 0) PG8_BAR; }
    PG8_BAR;
    if constexpr (Epi::AFTER_DRAIN) { E.fused(acc, cur, wr, wc, fr, fq, lds, wid, lane); S.done(cur); }
#undef PG8_SA
#undef PG8_SB
#undef PG8_STAGE
#undef PG8_LDA
#undef PG8_LDB
#undef PG8_MMA
#undef PG8_WAIT_V
#undef PG8_WAIT_L
#undef PG8_BAR
#undef PG8_SCHED
}
}
namespace pg8 {
constexpr int XD = 2048;
#define EPI_FENCE() asm volatile("" ::: "memory")
__device__ __forceinline__ float add_xor_lane(float s, int lane, int mask) { return s + __builtin_bit_cast(float, __builtin_amdgcn_ds_bpermute((lane ^ mask) << 2, __builtin_bit_cast(int, s))); }
__device__ __forceinline__ float sigmoidf_(float x) { return __builtin_amdgcn_rcpf(1.0f + __expf(-x)); }
__device__ __forceinline__ u32x4 pack8(const f32x4 v0, const f32x4 v1) {
    u32x4 w; w.x = cvt_pk_bf16(v0[0], v0[1]); w.y = cvt_pk_bf16(v0[2], v0[3]); w.z = cvt_pk_bf16(v1[0], v1[1]); w.w = cvt_pk_bf16(v1[2], v1[3]); return w;
}
__device__ __forceinline__ void unpack8(const u32x4 w, f32x4& v0, f32x4& v1) {
    v0[0] = __uint_as_float(w.x << 16); v0[1] = __uint_as_float(w.x & 0xffff0000u); v0[2] = __uint_as_float(w.y << 16); v0[3] = __uint_as_float(w.y & 0xffff0000u);
    v1[0] = __uint_as_float(w.z << 16); v1[1] = __uint_as_float(w.z & 0xffff0000u); v1[2] = __uint_as_float(w.w << 16); v1[3] = __uint_as_float(w.w & 0xffff0000u);
}
constexpr float SS_SCALE = 1048576.0f, SS_INV_SCALE = 1.0f / 1048576.0f;
typedef unsigned long long ss_t;
typedef _Float16 f16x2 __attribute__((ext_vector_type(2)));
__device__ __forceinline__ unsigned pkh2(float lo, float hi) { return __builtin_bit_cast(unsigned, (f16x2){(_Float16)lo, (_Float16)hi}); }
__device__ __forceinline__ u32x4 packh8(const f32x4 v0, const f32x4 v1) { u32x4 w; w.x = pkh2(v0[0], v0[1]); w.y = pkh2(v0[2], v0[3]); w.z = pkh2(v1[0], v1[1]); w.w = pkh2(v1[2], v1[3]); return w; }
__device__ __forceinline__ void unpackh2(unsigned w, float& lo, float& hi) { const f16x2 h = __builtin_bit_cast(f16x2, w); lo = (float)h[0]; hi = (float)h[1]; }
__device__ __forceinline__ void unpackh8(const u32x4 w, f32x4& v0, f32x4& v1) { float a, b, c, d, e, f, g, h; unpackh2(w.x, a, b); unpackh2(w.y, c, d); unpackh2(w.z, e, f); unpackh2(w.w, g, h); v0 = (f32x4){a, b, c, d}; v1 = (f32x4){e, f, g, h}; }
__device__ __forceinline__ void row_invs(const PG8_GAS ss_t* ss, int row0, float (&inv)[2][4]) {
    ss_t raw[2][4];
#pragma unroll
    for (int ai = 0; ai < 2; ++ai)
#pragma unroll
        for (int m = 0; m < 4; ++m) raw[ai][m] = ss[row0 + ai * HALF + m * 16];
#pragma unroll
    for (int ai = 0; ai < 2; ++ai)
#pragma unroll
        for (int m = 0; m < 4; ++m) inv[ai][m] = rsqrtf((float)(long long)raw[ai][m] * (SS_INV_SCALE / (float)XD) + 1e-6f);
}

__device__ __forceinline__ void row_invs_lds(const PG8_LAS float* tab, int pm, int r0, float (&inv)[2][4]) {
#pragma unroll
    for (int ai = 0; ai < 2; ++ai)
#pragma unroll
        for (int m = 0; m < 4; ++m) inv[ai][m] = tab[(pm & 7) * BM + r0 + ai * HALF + m * 16];
}
struct EpiSwiglu {
    static constexpr bool PERM = true, AFTER_DRAIN = false;
    const PG8_GAS ss_t* ss; PG8_GAS bf16_t* act; int ldc; const PG8_LAS float* tab;
    __device__ __forceinline__ void operator()(const f32x4 (&acc)[2][2][4][2], const Unit& u, int wr, int wc, int fr, int fq) const {
        const int row0 = u.pm * BM + wr * 64 + fr, col0 = u.pn * HALF + wc * 32 + 8 * fq;
        float inv[2][4]; if (tab) row_invs_lds(tab, u.pm, wr * 64 + fr, inv); else row_invs(ss, row0, inv);
#pragma unroll
        for (int ai = 0; ai < 2; ++ai)
#pragma unroll
            for (int m = 0; m < 4; ++m) {
                const int row = row0 + ai * HALF + m * 16;
                f32x4 h[2];
#pragma unroll
                for (int n = 0; n < 2; ++n) {
                    const f32x4 g = acc[ai][0][m][n] * inv[ai][m], up = acc[ai][1][m][n] * inv[ai][m];
#pragma unroll
                    for (int j = 0; j < 4; ++j) h[n][j] = g[j] * sigmoidf_(g[j]) * up[j];
                }
                *(PG8_GAS u32x4*)(act + (size_t)row * ldc + col0) = pack8(h[0], h[1]);
            }
    }
    static constexpr bool THIN_PAIRED = true;
    __device__ __forceinline__ void thin(int row, int pn, int w, int fq, const f32x4 v0, const f32x4 v1) const {
        typedef unsigned u32x2v __attribute__((ext_vector_type(2)));
        const float inv = rsqrtf((float)(long long)ss[row] * (SS_INV_SCALE / (float)XD) + 1e-6f);
        f32x4 h;
#pragma unroll
        for (int j = 0; j < 4; ++j) { const float g = v0[j] * inv; h[j] = g * sigmoidf_(g) * (v1[j] * inv); }
        u32x2v o; o.x = cvt_pk_bf16(h[0], h[1]); o.y = cvt_pk_bf16(h[2], h[3]);
        *(PG8_GAS u32x2v*)(act + (size_t)row * ldc + pn * HALF + 16 * w + 4 * fq) = o;
    }
};

struct EpiResid {
    static constexpr bool PERM = true, AFTER_DRAIN = false;
    PG8_GAS bf16_t* X16; PG8_GAS bf16_t* XB; PG8_GAS ss_t* ss; float scale; int noss;
    __device__ __forceinline__ void operator()(const f32x4 (&acc)[2][2][4][2], const Unit& u, int wr, int wc, int fr, int fq) const {
        const int row0 = u.pm * BM + wr * 64 + fr, col0 = u.pn * BM + wc * 32 + 8 * fq;
#pragma unroll
        for (int ai = 0; ai < 2; ++ai)
#pragma unroll
            for (int m = 0; m < 4; ++m) {
                const int row = row0 + ai * HALF + m * 16; float s = 0.f;
                u32x4 xo[2];
#pragma unroll
                for (int bj = 0; bj < 2; ++bj) xo[bj] = *(const PG8_GAS u32x4*)(X16 + (size_t)row * XD + col0 + bj * HALF);
#pragma unroll
                for (int bj = 0; bj < 2; ++bj) {
                    f32x4 x0, x1; unpackh8(xo[bj], x0, x1);
                    x0 += acc[ai][bj][m][0] * scale; x1 += acc[ai][bj][m][1] * scale;
                    *(PG8_GAS u32x4*)(X16 + (size_t)row * XD + col0 + bj * HALF) = packh8(x0, x1);
                    *(PG8_GAS u32x4*)(XB + (size_t)row * XD + col0 + bj * HALF) = pack8(x0, x1);
                    s += ((x0[0] * x0[0] + x0[1] * x0[1]) + (x0[2] * x0[2] + x0[3] * x0[3])) + ((x1[0] * x1[0] + x1[1] * x1[1]) + (x1[2] * x1[2] + x1[3] * x1[3]));
                }
                s = add_xor_lane(s, fr + 16 * fq, 16); s = add_xor_lane(s, fr + 16 * fq, 32);
                if (fq == 0 && !noss) __hip_atomic_fetch_add(ss + row, (ss_t)(long long)(s * SS_SCALE + 0.5f), __ATOMIC_RELAXED, __HIP_MEMORY_SCOPE_AGENT);
                if (m & 1) EPI_FENCE();
            }
    }
    static constexpr bool THIN_PAIRED = false;
    __device__ __forceinline__ void thin(int row, int pn, int w, int fq, const f32x4 v0, const f32x4 v1) const {
        typedef unsigned u32x2v __attribute__((ext_vector_type(2)));
        float s = 0.f;
#pragma unroll
        for (int t = 0; t < 2; ++t) { const size_t off = (size_t)row * XD + pn * BM + 32 * w + 16 * t + 4 * fq;
            const u32x2v xo = *(const PG8_GAS u32x2v*)(X16 + off); const f32x4 d = (t ? v1 : v0) * scale;
            float x0, x1, x2, x3; unpackh2(xo.x, x0, x1); unpackh2(xo.y, x2, x3); x0 += d[0]; x1 += d[1]; x2 += d[2]; x3 += d[3];
            u32x2v o; o.x = pkh2(x0, x1); o.y = pkh2(x2, x3); *(PG8_GAS u32x2v*)(X16 + off) = o;
            o.x = cvt_pk_bf16(x0, x1); o.y = cvt_pk_bf16(x2, x3); *(PG8_GAS u32x2v*)(XB + off) = o;
            s += (x0 * x0 + x1 * x1) + (x2 * x2 + x3 * x3); }
        if (!noss) __hip_atomic_fetch_add(ss + row, (ss_t)(long long)(s * SS_SCALE + 0.5f), __ATOMIC_RELAXED, __HIP_MEMORY_SCOPE_AGENT);
    }
};

template <size_t O_U2, size_t O_RKV, size_t O_GA, size_t O_GB, size_t O_LIN, int mp> struct EpiWin {
    static constexpr bool PERM = true, AFTER_DRAIN = false;
    const PG8_GAS ss_t* ss; PG8_GAS unsigned char* ov; const PG8_LAS float* tab;
    __device__ __forceinline__ void operator()(const f32x4 (&acc)[2][2][4][2], const Unit& u, int wr, int wc, int fr, int fq) const {
        PG8_GAS bf16_t* U2 = (PG8_GAS bf16_t*)(ov + O_U2); PG8_GAS bf16_t* RKV = (PG8_GAS bf16_t*)(ov + O_RKV); PG8_GAS bf16_t* GA = (PG8_GAS bf16_t*)(ov + O_GA); PG8_GAS bf16_t* GB = (PG8_GAS bf16_t*)(ov + O_GB); PG8_GAS bf16_t* LIN = (PG8_GAS bf16_t*)(ov + O_LIN);
        const int row0 = u.pm * BM + wr * 64 + fr, cl = wc * 32 + 8 * fq; const int pn = u.pn;
        float inv[2][4]; if (tab) row_invs_lds(tab, u.pm, wr * 64 + fr, inv); else row_invs(ss, row0, inv);
#pragma unroll
        for (int ai = 0; ai < 2; ++ai)
#pragma unroll
            for (int m = 0; m < 4; ++m) {
                const int row = row0 + ai * HALF + m * 16;
#pragma unroll
                for (int bj = 0; bj < 2; ++bj) {
                    f32x4 v0 = acc[ai][bj][m][0] * inv[ai][m], v1 = acc[ai][bj][m][1] * inv[ai][m];
                    const int c = bj * HALF + cl;
                    PG8_GAS bf16_t* dst;
                    if (pn < 4) { const int ch = pn * BM + c, g = ch >> 4; dst = U2 + ((size_t)g * 1040 + (row >> 4)) * 256 + (row & 15) * 16 + (ch & 15); }
                    else if (pn < 16) { const int t = (pn - 4) >> 2; dst = RKV + ((size_t)t * mp + row) * 1024 + ((pn - 4) & 3) * BM + c; }
                    else if (pn < 32) {
#pragma unroll
                        for (int j = 0; j < 4; ++j) { v0[j] = sigmoidf_(v0[j]); v1[j] = sigmoidf_(v1[j]); }
                        dst = (pn < 24 ? GA + (size_t)row * XD + (pn - 16) * BM : GB + (size_t)row * XD + (pn - 24) * BM) + c;
                    } else dst = LIN + (size_t)row * 512 + (pn - 32) * BM + c;
                    __builtin_nontemporal_store(pack8(v0, v1), (PG8_GAS u32x4*)dst);
                }
            }
    }
    static constexpr bool THIN_PAIRED = false;
    __device__ __forceinline__ void thin(int row, int pn, int w, int fq, const f32x4 a0, const f32x4 a1) const {
        typedef unsigned u32x2v __attribute__((ext_vector_type(2)));
        PG8_GAS bf16_t* U2 = (PG8_GAS bf16_t*)(ov + O_U2); PG8_GAS bf16_t* RKV = (PG8_GAS bf16_t*)(ov + O_RKV); PG8_GAS bf16_t* GA = (PG8_GAS bf16_t*)(ov + O_GA); PG8_GAS bf16_t* GB = (PG8_GAS bf16_t*)(ov + O_GB); PG8_GAS bf16_t* LIN = (PG8_GAS bf16_t*)(ov + O_LIN);
        const float inv = rsqrtf((float)(long long)ss[row] * (SS_INV_SCALE / (float)XD) + 1e-6f);
#pragma unroll
        for (int t = 0; t < 2; ++t) { f32x4 v = (t ? a1 : a0) * inv; const int c = 32 * w + 16 * t + 4 * fq;
            PG8_GAS bf16_t* dst;
            if (pn < 4) { const int ch = pn * BM + c, g = ch >> 4; dst = U2 + ((size_t)g * 1040 + (row >> 4)) * 256 + (row & 15) * 16 + (ch & 15); }
            else if (pn < 16) { const int tt = (pn - 4) >> 2; dst = RKV + ((size_t)tt * mp + row) * 1024 + ((pn - 4) & 3) * BM + c; }
            else if (pn < 32) {
#pragma unroll
                for (int j = 0; j < 4; ++j) v[j] = sigmoidf_(v[j]);
                dst = (pn < 24 ? GA + (size_t)row * XD + (pn - 16) * BM : GB + (size_t)row * XD + (pn - 24) * BM) + c;
            } else dst = LIN + (size_t)row * 512 + (pn - 32) * BM + c;
            u32x2v o; o.x = cvt_pk_bf16(v[0], v[1]); o.y = cvt_pk_bf16(v[2], v[3]); *(PG8_GAS u32x2v*)dst = o; }
    }
};

struct EpiGlu {
    static constexpr bool PERM = true, AFTER_DRAIN = false;
    const PG8_GAS bf16_t* aux; PG8_GAS bf16_t* out; int ldc;
    __device__ __forceinline__ void operator()(const f32x4 (&acc)[2][2][4][2], const Unit& u, int wr, int wc, int fr, int fq) const {
        const int row0 = u.pm * BM + wr * 64 + fr, col0 = u.pn * BM + wc * 32 + 8 * fq;
#pragma unroll
        for (int ai = 0; ai < 2; ++ai)
#pragma unroll
            for (int m = 0; m < 4; ++m) {
#pragma unroll
                for (int bj = 0; bj < 2; ++bj) {
                    const size_t off = (size_t)(row0 + ai * HALF + m * 16) * ldc + col0 + bj * HALF;
                    f32x4 a0, a1; unpack8(*(const PG8_GAS u32x4*)(aux + off), a0, a1);
                    f32x4 v0 = acc[ai][bj][m][0], v1 = acc[ai][bj][m][1];
#pragma unroll
                    for (int j = 0; j < 4; ++j) { v0[j] = a0[j] * sigmoidf_(v0[j]); v1[j] = a1[j] * sigmoidf_(v1[j]); }
                    *(PG8_GAS u32x4*)(out + off) = pack8(v0, v1);
                }
                if (m & 1) EPI_FENCE();
            }
    }
    static constexpr bool THIN_PAIRED = false;
    __device__ __forceinline__ void thin(int row, int pn, int w, int fq, const f32x4 a0, const f32x4 a1) const {
        typedef unsigned u32x2v __attribute__((ext_vector_type(2)));
#pragma unroll
        for (int t = 0; t < 2; ++t) { const size_t off = (size_t)row * ldc + pn * BM + 32 * w + 16 * t + 4 * fq; const f32x4 v = t ? a1 : a0;
            const u32x2v x = *(const PG8_GAS u32x2v*)(aux + off);
            const float x0 = __uint_as_float(x.x << 16), x1 = __uint_as_float(x.x & 0xffff0000u), x2 = __uint_as_float(x.y << 16), x3 = __uint_as_float(x.y & 0xffff0000u);
            u32x2v o; o.x = cvt_pk_bf16(x0 * sigmoidf_(v[0]), x1 * sigmoidf_(v[1])); o.y = cvt_pk_bf16(x2 * sigmoidf_(v[2]), x3 * sigmoidf_(v[3])); *(PG8_GAS u32x2v*)(out + off) = o; }
    }
};

template <bool ACCUM> struct EpiGateMul {
    static constexpr bool PERM = true, AFTER_DRAIN = false;
    const PG8_GAS bf16_t* gate; PG8_GAS bf16_t* out;
    __device__ __forceinline__ void operator()(const f32x4 (&acc)[2][2][4][2], const Unit& u, int wr, int wc, int fr, int fq) const {
        const int row0 = u.pm * BM + wr * 64 + fr, col0 = u.pn * BM + wc * 32 + 8 * fq;
#pragma unroll
        for (int ai = 0; ai < 2; ++ai)
#pragma unroll
            for (int m = 0; m < 4; ++m) {
#pragma unroll
                for (int bj = 0; bj < 2; ++bj) {
                    const size_t off = (size_t)(row0 + ai * HALF + m * 16) * XD + col0 + bj * HALF;
                    f32x4 g0, g1; unpack8(__builtin_nontemporal_load((const PG8_GAS u32x4*)(gate + off)), g0, g1);
                    f32x4 v0 = acc[ai][bj][m][0] * g0, v1 = acc[ai][bj][m][1] * g1;
                    if (ACCUM) { f32x4 p0, p1; unpack8(__builtin_nontemporal_load((const PG8_GAS u32x4*)(out + off)), p0, p1); v0 += p0; v1 += p1; }
                    *(PG8_GAS u32x4*)(out + off) = pack8(v0, v1);
                }
                if (m & 1) EPI_FENCE();
            }
    }
    static constexpr bool THIN_PAIRED = false;
    __device__ __forceinline__ void thin(int row, int pn, int w, int fq, const f32x4 a0, const f32x4 a1) const {
        typedef unsigned u32x2v __attribute__((ext_vector_type(2)));
#pragma unroll
        for (int t = 0; t < 2; ++t) { const size_t off = (size_t)row * XD + pn * BM + 32 * w + 16 * t + 4 * fq; const f32x4 v = t ? a1 : a0;
            const u32x2v x = *(const PG8_GAS u32x2v*)(gate + off);
            float r0 = v[0] * __uint_as_float(x.x << 16), r1 = v[1] * __uint_as_float(x.x & 0xffff0000u), r2 = v[2] * __uint_as_float(x.y << 16), r3 = v[3] * __uint_as_float(x.y & 0xffff0000u);
            if (ACCUM) { const u32x2v p = *(const PG8_GAS u32x2v*)(out + off); r0 += __uint_as_float(p.x << 16); r1 += __uint_as_float(p.x & 0xffff0000u); r2 += __uint_as_float(p.y << 16); r3 += __uint_as_float(p.y & 0xffff0000u); }
            u32x2v o; o.x = cvt_pk_bf16(r0, r1); o.y = cvt_pk_bf16(r2, r3); *(PG8_GAS u32x2v*)(out + off) = o; }
    }
};

template <size_t o_a, size_t o_b, size_t o_c, size_t o_d> struct EpiLora {
    static constexpr bool PERM = true, AFTER_DRAIN = false;
    PG8_GAS unsigned char* ov;
    __device__ __forceinline__ void operator()(const f32x4 (&acc)[2][2][4][2], const Unit& u, int wr, int wc, int fr, int fq) const {
        const int row0 = u.pm * BM + wr * 64 + fr, kind = u.pn >> 2, col0 = (u.pn & 3) * BM + wc * 32 + 8 * fq;
        PG8_GAS bf16_t* ob = (PG8_GAS bf16_t*)(ov + (kind == 0 ? o_a : kind == 1 ? o_b : kind == 2 ? o_c : o_d));
#pragma unroll
        for (int ai = 0; ai < 2; ++ai)
#pragma unroll
            for (int m = 0; m < 4; ++m)
#pragma unroll
                for (int bj = 0; bj < 2; ++bj)
                    *(PG8_GAS u32x4*)(ob + (size_t)(row0 + ai * HALF + m * 16) * 1024 + col0 + bj * HALF) = pack8(acc[ai][bj][m][0], acc[ai][bj][m][1]);
    }
    static constexpr bool THIN_PAIRED = false;
    __device__ __forceinline__ void thin(int row, int pn, int w, int fq, const f32x4 a0, const f32x4 a1) const {
        typedef unsigned u32x2v __attribute__((ext_vector_type(2)));
        const int kind = pn >> 2;
        PG8_GAS bf16_t* ob = (PG8_GAS bf16_t*)(ov + (kind == 0 ? o_a : kind == 1 ? o_b : kind == 2 ? o_c : o_d));
#pragma unroll
        for (int t = 0; t < 2; ++t) { const size_t off = (size_t)row * 1024 + (pn & 3) * BM + 32 * w + 16 * t + 4 * fq; const f32x4 v = t ? a1 : a0;
            u32x2v o; o.x = cvt_pk_bf16(v[0], v[1]); o.y = cvt_pk_bf16(v[2], v[3]); *(PG8_GAS u32x2v*)(ob + off) = o; }
    }
};

template <class Epi, bool F16 = false> __device__ __forceinline__ void thin_gemm(PG8_LAS unsigned char* lds, const Gemm g, const Epi& E, int G, int c, int row_base, const int tid) {
    const int w = __builtin_amdgcn_readfirstlane(tid >> 6), lane = tid & 63, fr = lane & 15, fq = lane >> 4, K = g.K, nks = K / 32, nU = g.N / 32;
    PG8_LAS f32x4* P = (PG8_LAS f32x4*)lds;
    for (int u = G - 1 - c; u < nU; u += G) {
        const int pn = u >> 3, wq = u & 7;
        const int r0 = Epi::THIN_PAIRED ? 16 * wq : 32 * wq, r1 = Epi::THIN_PAIRED ? HALF + 16 * wq : 32 * wq + 16;
        const PG8_GAS bf16_t* ap = g.A + (size_t)(row_base + fr) * K + 8 * fq;
        const PG8_GAS bf16_t* b0 = g.Bt + (size_t)(pn * BM + r0 + fr) * K + 8 * fq;
        const PG8_GAS bf16_t* b1 = g.Bt + (size_t)(pn * BM + r1 + fr) * K + 8 * fq;
        f32x4 acc0 = {0.f, 0.f, 0.f, 0.f}, acc1 = {0.f, 0.f, 0.f, 0.f};
        for (int ks = w; ks < nks; ks += 64) {
            bf16x8 av[8], bv0[8], bv1[8];
#pragma unroll
            for (int s = 0; s < 8; ++s) { const int kk = ks + 8 * s; const bool ok = kk < nks; const int ko = ok ? 32 * kk : 0;
                av[s] = *(const PG8_GAS bf16x8*)(ap + ko); bv0[s] = *(const PG8_GAS bf16x8*)(b0 + ko); bv1[s] = *(const PG8_GAS bf16x8*)(b1 + ko);
                if (!ok) av[s] = (bf16x8){0, 0, 0, 0, 0, 0, 0, 0}; }
#pragma unroll
            for (int s = 0; s < 8; ++s) {
                if (F16) { acc0 = __builtin_amdgcn_mfma_f32_16x16x32_f16(__builtin_bit_cast(f16x8, bv0[s]), __builtin_bit_cast(f16x8, av[s]), acc0, 0, 0, 0); acc1 = __builtin_amdgcn_mfma_f32_16x16x32_f16(__builtin_bit_cast(f16x8, bv1[s]), __builtin_bit_cast(f16x8, av[s]), acc1, 0, 0, 0); }
                else { acc0 = __builtin_amdgcn_mfma_f32_16x16x32_bf16(bv0[s], av[s], acc0, 0, 0, 0); acc1 = __builtin_amdgcn_mfma_f32_16x16x32_bf16(bv1[s], av[s], acc1, 0, 0, 0); } }
        }
        P[(w * 2 + 0) * 64 + lane] = acc0; P[(w * 2 + 1) * 64 + lane] = acc1;
        __syncthreads();
        if (w == 0) {
            f32x4 s0 = P[lane], s1 = P[64 + lane];
#pragma unroll
            for (int ww = 1; ww < 8; ++ww) { s0 += P[(ww * 2 + 0) * 64 + lane]; s1 += P[(ww * 2 + 1) * 64 + lane]; }
            E.thin(row_base + fr, pn, wq, fq, s0, s1);
        }
        __syncthreads();
    }
}
}
constexpr int NWAVES = 8;
constexpr int DM = 2048, BATCH = 4, SEQ = 4096, DEPTH = 4, NMETA = 16, DFF = 5632;
constexpr int MR = BATCH * SEQ;
constexpr int MROWS = MR + NMETA;
constexpr int MP = 16640;
constexpr int TSEQ = SEQ + NMETA;
constexpr int SW = 1024, NG = 64, NS = 64, SGC = 16;
constexpr int RW_W = 1024, NH = 16, HD = 64;
constexpr int P_FIRST = 8480, P_REST = 8512, NIN = 8704;
constexpr int U2_CR = 1040;
constexpr float NORM_EPS = 1e-6f;
#ifndef MK_MULTI
#define MK_MULTI 0
#endif
enum In { I_X = 0, I_META, I_F1N, I_F1G, I_F1U, I_F1D, I_MIXN, I_WIN0, I_WINR, I_MUSH, I_MUVR, I_LRE, I_LIM, I_LDT, I_BRE, I_BIM, I_CRE, I_CIM, I_SD, I_WGLU,
          I_W0, I_W2, I_A0, I_A2, I_V0, I_V2, I_G2, I_KK, I_KA, I_RK, I_LNW, I_LNB, I_WUA, I_WUB, I_WO, I_F2N, I_F2G, I_F2U, I_F2D, I_FINN, N_IN };

constexpr size_t MiB = 1u << 20;
constexpr size_t WS_CTL = 0, CTL_ZERO_BYTES = 1 * MiB;
constexpr size_t WS_LPAR = 1 * MiB;
constexpr size_t WS_X = 2 * MiB;
constexpr size_t WS_XB = 132 * MiB;
constexpr size_t WS_SSP = 197 * MiB, SS_STRIDE = 256 * 1024;
constexpr size_t WS_VF = 200 * MiB;
constexpr size_t WS_W = 233 * MiB, W_SLOT = 204 * MiB;
constexpr size_t WO_GU1 = 0, WO_D1 = 44 * MiB, WO_IN = 66 * MiB, WO_GLU = 100 * MiB, WO_UA = 102 * MiB, WO_UB = 106 * MiB, WO_O = 110 * MiB, WO_GU2 = 118 * MiB, WO_D2 = 162 * MiB, WO_S5 = 184 * MiB, WO_LORA = 200 * MiB;
constexpr size_t WS_OV = WS_W + 2 * W_SLOT;
constexpr size_t OV_ACT = 0;
constexpr size_t OV_U2 = 0, OV_RKV = 33 * MiB, OV_LIN = 131 * MiB, OV_GA = 148 * MiB, OV_GB = 213 * MiB, OV_YPRE = 278 * MiB, OV_YA = 311 * MiB, OV_RW = 344 * MiB,
                 OV_O = 729 * MiB, OV_YB = 794 * MiB, OV_GT = 827 * MiB, OV_RKS = 860 * MiB, OV_MG = 862 * MiB, OV_BK = 927 * MiB, OV_END = 930 * MiB;
constexpr size_t OV_LA = OV_RW + 128 * MiB, OV_DEC = OV_RW + 128 * MiB, OV_ICLR = OV_MG, OV_VG = OV_YB;
constexpr int LKP = 384;
constexpr size_t WS_END = WS_OV + OV_END;
static_assert((size_t)MP * DM * 4 == 130 * MiB && (size_t)MP * DFF * 2 <= 179 * MiB && (size_t)MROWS * NH * 6 * HD * 4 <= 385 * MiB, "d_ws map");
constexpr int CW_TMO = 0, CW_CODE = 1, CW_BAR = 4096;

constexpr int RING_OFF = 0, RING_BYTES = 131072;
constexpr int LDSCTL_OFF = RING_BYTES, MISC_OFF = LDSCTL_OFF + 320;
constexpr int LDS_BYTES = 147456;
static_assert(MISC_OFF + 128 <= LDS_BYTES, "LDS map");

#define GAS __attribute__((address_space(1)))
#define LAS __attribute__((address_space(3)))
typedef unsigned short bf16;
typedef unsigned v4u __attribute__((ext_vector_type(4)));
typedef unsigned v2u __attribute__((ext_vector_type(2)));
typedef float f32x4 __attribute__((ext_vector_type(4)));
typedef float f32x2 __attribute__((ext_vector_type(2)));
typedef GAS unsigned gu32;
#define RLX_AGENT __ATOMIC_RELAXED, __HIP_MEMORY_SCOPE_AGENT
#define LDS_WAIT() asm volatile("s_waitcnt lgkmcnt(0)" ::: "memory")
#define VM_WAIT() asm volatile("s_waitcnt vmcnt(0)" ::: "memory")
__device__ __forceinline__ unsigned f2bf(float f) { unsigned u = __builtin_bit_cast(unsigned, f); return (u + 0x7fffu + ((u >> 16) & 1u)) >> 16; }
__device__ __forceinline__ unsigned pk2(float lo, float hi) { return f2bf(lo) | (f2bf(hi) << 16); }
__device__ __forceinline__ float bf2f(bf16 h) { return __uint_as_float((unsigned)h << 16); }
__device__ __forceinline__ float sigm(float x) { return 1.0f / (1.0f + __expf(-x)); }
#define XB_TMO      128
#define XB_XCNT(j)  (256  + 64 * (j))
#define XB_XSUB(j)  (1280 + 64 * (j))
#define XB_XGEN(j)  (2304 + 64 * (j))
#define XB_TOP      3328
#define XB_TOPGEN   3392
#define XCD_BAR_WORDS 3456
#define XB_SPIN_CAP (1u << 18)

__device__ __forceinline__ unsigned xb_ld(unsigned* p)              { return __hip_atomic_load(p, __ATOMIC_RELAXED, __HIP_MEMORY_SCOPE_AGENT); }
__device__ __forceinline__ unsigned xb_add(unsigned* p, unsigned v) { return __hip_atomic_fetch_add(p, v, __ATOMIC_RELAXED, __HIP_MEMORY_SCOPE_AGENT); }
__device__ __forceinline__ unsigned xb_xcc_id() { return (unsigned)__builtin_amdgcn_s_getreg((3 << 11) | 20) & 0xFu; }
#define XB_SPIN(cond, bar) do { unsigned _sp = 0; while (cond) { __builtin_amdgcn_s_sleep(1); \
    if ((++_sp & 255u) == 0u) { if (xb_ld(&(bar)[XB_TMO])) break; if (_sp > XB_SPIN_CAP) { atomicAdd(&(bar)[XB_TMO], 1u); break; } } } } while (0)

struct XcdBarrier {
    unsigned* bar; unsigned x;
    volatile LAS unsigned* st;
};

__device__ __forceinline__ XcdBarrier xcd_barrier_post(unsigned* bar, volatile LAS unsigned* st) {
    XcdBarrier b; b.bar = bar; b.x = xb_xcc_id(); b.st = st;
    if (threadIdx.x == 0) (void)xb_add(&bar[XB_XCNT(b.x)], 1u);
    return b;
}
__device__ __forceinline__ void xcd_barrier_complete(unsigned* bar, unsigned x, unsigned& nloc, unsigned& nx) {
    const unsigned G = gridDim.x * gridDim.y * gridDim.z;
    unsigned sum, cnt, mine, sp = 0u;
    for (;;) {
        sum = 0u; cnt = 0u; mine = 0u;
#pragma unroll
        for (unsigned j = 0; j < 16; ++j) { const unsigned c = xb_ld(&bar[XB_XCNT(j)]); sum += c; cnt += (c > 0u) ? 1u : 0u; mine = (j == x) ? c : mine; }
        if (sum == G) break;
        __builtin_amdgcn_s_sleep(1);
        if ((++sp & 255u) == 0u) { if (xb_ld(&bar[XB_TMO])) break; if (sp > XB_SPIN_CAP) { atomicAdd(&bar[XB_TMO], 1u); break; } }
    }
    nloc = mine > 0u ? mine : 1u; nx = cnt > 0u ? cnt : 1u;
}

__device__ __forceinline__ void xcd_barrier(const XcdBarrier& b) {
    asm volatile("s_waitcnt vmcnt(0)" ::: "memory");
    __syncthreads();
    if (threadIdx.x == 0) {
        unsigned* bar = b.bar;
        __builtin_amdgcn_s_waitcnt(0);
        unsigned nloc = b.st[0], nx = b.st[1];
        if (nloc == 0u) { xcd_barrier_complete(bar, b.x, nloc, nx); b.st[0] = nloc; b.st[1] = nx; }
        const unsigned old = xb_add(&bar[XB_XSUB(b.x)], 1u);
        const unsigned gen = old / nloc;
        if (old + 1u == (gen + 1u) * nloc) {
            __builtin_amdgcn_fence(__ATOMIC_RELEASE, "agent");
            asm volatile("s_waitcnt vmcnt(0)" ::: "memory");
            const unsigned og = xb_add(&bar[XB_TOP], 1u);
            const unsigned tg = og / nx;
            if (og + 1u == (tg + 1u) * nx) xb_add(&bar[XB_TOPGEN], 1u);
            else XB_SPIN(xb_ld(&bar[XB_TOPGEN]) == tg, bar);
            __builtin_amdgcn_fence(__ATOMIC_ACQUIRE, "agent");
            xb_add(&bar[XB_XGEN(b.x)], 1u);
            asm volatile("s_waitcnt vmcnt(0)" ::: "memory");
        } else {
            XB_SPIN(xb_ld(&bar[XB_XGEN(b.x)]) == gen, bar);
            __builtin_amdgcn_fence(__ATOMIC_ACQUIRE, "agent");
            asm volatile("s_waitcnt vmcnt(0)" ::: "memory");
        }
    }
    __syncthreads();
}
struct Frame {
    LAS unsigned char* lds;
    volatile LAS unsigned* MISC;
    gu32* ctl;
    int tid, lane, wave, vcu, G;
    GAS unsigned char* ws;
};
#define FX16(F) ((GAS bf16*)((F).ws + WS_X))
#define FXB(F)  ((GAS bf16*)((F).ws + WS_XB))
#define FVF(F)  ((GAS bf16*)((F).ws + WS_VF))
#define FSSA(F) ((GAS unsigned long long*)((F).ws + WS_SSP))
#define FSSB(F) ((GAS unsigned long long*)((F).ws + WS_SSP + SS_STRIDE))
#define FSSC(F) ((GAS unsigned long long*)((F).ws + WS_SSP + 2 * SS_STRIDE))
__device__ __forceinline__ const GAS float* inp(const Frame& F, int k) {
    const LAS unsigned* t = (const LAS unsigned*)(F.lds + LDSCTL_OFF) + 2 * k;
    const unsigned lo = __builtin_amdgcn_readfirstlane(t[0]), hi = __builtin_amdgcn_readfirstlane(t[1]);
    return (const GAS float*)(((unsigned long long)hi << 32) | lo);
}
__device__ __forceinline__ float row16_sum(float x) {
    x += __builtin_bit_cast(float, __builtin_amdgcn_update_dpp(0, __builtin_bit_cast(int, x), 0xB1, 0xF, 0xF, false));
    x += __builtin_bit_cast(float, __builtin_amdgcn_update_dpp(0, __builtin_bit_cast(int, x), 0x4E, 0xF, 0xF, false));
    x += __builtin_bit_cast(float, __builtin_amdgcn_update_dpp(0, __builtin_bit_cast(int, x), 0x124, 0xF, 0xF, false));
    x += __builtin_bit_cast(float, __builtin_amdgcn_update_dpp(0, __builtin_bit_cast(int, x), 0x128, 0xF, 0xF, false));
    return x;
}
__device__ __forceinline__ float lane_bcast(float x, int j) { return __builtin_bit_cast(float, __builtin_amdgcn_readlane(__builtin_bit_cast(int, x), j)); }
__device__ __forceinline__ float wave_sum(float v) {
    v = row16_sum(v);
    return (lane_bcast(v, 0) + lane_bcast(v, 16)) + (lane_bcast(v, 32) + lane_bcast(v, 48));
}
__device__ __forceinline__ int seq_row(int b, int s) { return s < NMETA ? MR + s : b * SEQ + (s - NMETA); }
__device__ __forceinline__ int prev_row(int row) { if (row >= MR) return row > MR ? row - 1 : -1; return (row & (SEQ - 1)) ? row - 1 : MR + NMETA - 1; }

__device__ __forceinline__ void px_init(Frame& F) {
    const int gw = F.vcu * NWAVES + F.wave, NGW = F.G * NWAVES;
    const GAS float* xin = inp(F, I_X); const GAS float* meta = inp(F, I_META);
    for (int m = gw; m < MP; m += NGW) {
        const GAS float* src = m < MR ? xin + (size_t)m * DM : (m < MROWS ? meta + (size_t)(m - MR) * DM : nullptr);
        f32x4 v[8]; float s = 0.f;
#pragma unroll
        for (int j = 0; j < 8; ++j) { v[j] = src ? __builtin_nontemporal_load((const GAS f32x4*)src + F.lane + 64 * j) : (f32x4){0.f, 0.f, 0.f, 0.f}; s += (v[j][0] * v[j][0] + v[j][1] * v[j][1]) + (v[j][2] * v[j][2] + v[j][3] * v[j][3]); }
        s = wave_sum(s);
#pragma unroll
        for (int j = 0; j < 8; ++j) {
            v2u w; w.x = pg8::pkh2(v[j][0], v[j][1]); w.y = pg8::pkh2(v[j][2], v[j][3]);
            ((GAS v2u*)(FX16(F) + (size_t)m * DM))[F.lane + 64 * j] = w;
            w.x = pk2(v[j][0], v[j][1]); w.y = pk2(v[j][2], v[j][3]);
            ((GAS v2u*)(FXB(F) + (size_t)m * DM))[F.lane + 64 * j] = w;
        }
        if (F.lane == 0) { unsigned zlo = 0u; asm volatile("" : "+v"(zlo));
            FSSC(F)[m] = (unsigned long long)(long long)(s * pg8::SS_SCALE + 0.5f); FSSA(F)[m] = (unsigned long long)zlo; }
    }
}
__device__ __forceinline__ int tr_drow(int map, int c0) {
    if (map == 1) return (c0 >> 7) * 256 + (c0 & 127);
    if (map == 2) return (c0 >> 7) * 256 + 128 + (c0 & 127);
    if (map == 3) {
        if (c0 < 4096) return c0; if (c0 < 4384) return 8192 + (c0 - 4096); if (c0 < 8480) return 4096 + (c0 - 4384); return 8192 + 288 + (c0 - 8480); }
    return c0;
}
struct TrDesc { const GAS float* W; GAS bf16* WT; const GAS float* gain; int K, N, map, f16; };
__device__ __forceinline__ int tr_items(const TrDesc& d) { return (d.K / 64) * ((d.N + 63) / 64); }
__device__ __forceinline__ void tr_tile_load(const TrDesc& d, int it, int lane, f32x4 (&v)[16]) {
    const int nbn = (d.N + 63) / 64, kb = it / nbn, nb = it - kb * nbn, k0 = 64 * kb, n0 = 64 * nb, rg = lane >> 4, j = lane & 15;
    const bool nok = n0 + 4 * j < d.N;
#pragma unroll
    for (int i = 0; i < 16; ++i) { const int kk = 8 * (i >> 1) + 2 * rg + (i & 1);
        v[i] = nok ? __builtin_nontemporal_load((const GAS f32x4*)(d.W + (size_t)(k0 + kk) * d.N + n0 + 4 * j)) : (f32x4){0.f, 0.f, 0.f, 0.f}; }
}
__device__ __forceinline__ void tr_tile_finish(const TrDesc& d, int it, int lane, const f32x4 (&v)[16], LAS unsigned* scr) {
    const int nbn = (d.N + 63) / 64, kb = it / nbn, nb = it - kb * nbn, k0 = 64 * kb, n0 = 64 * nb, rg = lane >> 4, j = lane & 15;
#pragma unroll
    for (int i = 0; i < 8; ++i) { const int kk = 8 * i + 2 * rg; float g0 = 1.f, g1 = 1.f; if (d.gain) { g0 = d.gain[k0 + kk]; g1 = d.gain[k0 + kk + 1]; }
#pragma unroll
        for (int e = 0; e < 4; ++e) scr[(4 * j + e) * 36 + (kk >> 1)] = d.f16 ? pg8::pkh2(v[2 * i][e] * g0, v[2 * i + 1][e] * g1) : pk2(v[2 * i][e] * g0, v[2 * i + 1][e] * g1); }
    LDS_WAIT(); asm volatile("" ::: "memory");
    const int c = lane & 7;
#pragma unroll
    for (int i = 0; i < 8; ++i) { const int n = (lane >> 3) + 8 * i;
        const v4u o = *(const LAS v4u*)(scr + n * 36 + 4 * c);
        const int col = n0 + n;
        if (col < d.N) *(GAS v4u*)(d.WT + (size_t)(tr_drow(d.map, col & ~31) + (col & 31)) * d.K + k0 + 8 * c) = o; }
    LDS_WAIT(); asm volatile("" ::: "memory");
}
constexpr int TR_NMAT = 11;
__device__ __forceinline__ TrDesc tr_desc(Frame& F, int L, int m) {
    GAS unsigned char* wb = F.ws + WS_W + (size_t)(L & 1) * W_SLOT; const int P = L == 0 ? P_FIRST : P_REST; TrDesc d;
    switch (m) {
    case 0:  d = TrDesc{inp(F, I_F1G) + (size_t)L * DM * DFF, (GAS bf16*)(wb + WO_GU1), inp(F, I_F1N) + (size_t)L * DM, DM, DFF, 1, 0}; break;
    case 1:  d = TrDesc{inp(F, I_F1U) + (size_t)L * DM * DFF, (GAS bf16*)(wb + WO_GU1), inp(F, I_F1N) + (size_t)L * DM, DM, DFF, 2, 0}; break;
    case 2:  d = TrDesc{inp(F, I_F1D) + (size_t)L * DFF * DM, (GAS bf16*)(wb + WO_D1), nullptr, DFF, DM, 0, 0}; break;
    case 3:  d = TrDesc{L == 0 ? inp(F, I_WIN0) : inp(F, I_WINR) + (size_t)(L - 1) * DM * P_REST, (GAS bf16*)(wb + WO_IN), inp(F, I_MIXN) + (size_t)L * DM, DM, P, 3, 0}; break;
    case 4:  d = TrDesc{inp(F, I_WGLU) + (size_t)L * SW * SW, (GAS bf16*)(wb + WO_GLU), nullptr, SW, SW, 0, 0}; break;
    case 5:  d = TrDesc{inp(F, I_WUA) + (size_t)L * SW * DM, (GAS bf16*)(wb + WO_UA), nullptr, SW, DM, 0, 0}; break;
    case 6:  d = TrDesc{inp(F, I_WUB) + (size_t)L * RW_W * DM, (GAS bf16*)(wb + WO_UB), nullptr, RW_W, DM, 0, 0}; break;
    case 7:  d = TrDesc{inp(F, I_WO) + (size_t)L * DM * DM, (GAS bf16*)(wb + WO_O), nullptr, DM, DM, 0, 0}; break;
    case 8:  d = TrDesc{inp(F, I_F2G) + (size_t)L * DM * DFF, (GAS bf16*)(wb + WO_GU2), inp(F, I_F2N) + (size_t)L * DM, DM, DFF, 1, 0}; break;
    case 9:  d = TrDesc{inp(F, I_F2U) + (size_t)L * DM * DFF, (GAS bf16*)(wb + WO_GU2), inp(F, I_F2N) + (size_t)L * DM, DM, DFF, 2, 0}; break;
    default: d = TrDesc{inp(F, I_F2D) + (size_t)L * DFF * DM, (GAS bf16*)(wb + WO_D2), nullptr, DFF, DM, 0, 0}; break;
    }
    return d;
}
__device__ __forceinline__ bool tr_decode(int L, int t, int& m, int& it) {
    const int P = L == 0 ? P_FIRST : P_REST;
    constexpr int n_gu = (DM / 64) * (DFF / 64), n_dn = (DFF / 64) * (DM / 64), n_gl = (SW / 64) * (SW / 64), n_up = (SW / 64) * (DM / 64), n_wo = (DM / 64) * (DM / 64);
    const int n_in = (DM / 64) * ((P + 63) / 64);
    const int cnt[TR_NMAT] = {n_gu, n_gu, n_dn, n_in, n_gl, n_up, n_up, n_wo, n_gu, n_gu, n_dn};
    int r = t;
#pragma unroll
    for (int i = 0; i < TR_NMAT; ++i) { if (r < cnt[i]) { m = i; it = r; return true; } r -= cnt[i]; }
    return false;
}
__device__ __forceinline__ void tr_matrix(Frame& F, const TrDesc& d) {
    LAS unsigned* scr = (LAS unsigned*)(F.lds + RING_OFF + F.wave * 16384);
    const int gw = F.vcu * NWAVES + F.wave, NGW = F.G * NWAVES, nitems = tr_items(d);
    for (int it = gw; it < nitems; it += NGW) { f32x4 v[16]; tr_tile_load(d, it, F.lane, v); tr_tile_finish(d, it, F.lane, v, scr); }
}
__device__ __forceinline__ void pw_zero_rows(Frame& F, int L) {
    GAS unsigned char* wb = F.ws + WS_W + (size_t)(L & 1) * W_SLOT; const int P = L == 0 ? P_FIRST : P_REST;
    const int gw = F.vcu * NWAVES + F.wave, NGW = F.G * NWAVES;
    for (int r = P + gw; r < NIN; r += NGW) { GAS v4u* z = (GAS v4u*)((GAS bf16*)(wb + WO_IN) + (size_t)r * DM);
#pragma unroll
        for (int j = 0; j < 4; ++j) z[F.lane + 64 * j] = (v4u){0u, 0u, 0u, 0u}; }
}
__device__ __forceinline__ void pw_weights(Frame& F, int L) {
    for (int m = 0; m < TR_NMAT; ++m) { const TrDesc d = tr_desc(F, L, m); tr_matrix(F, d); }
}

constexpr size_t S5_KC_BYTES = (size_t)NG * 256 * 384 * 2;
__device__ __forceinline__ float gelu_tanh(float y) { const float t2 = 1.5957691216057308f * (y + 0.044715f * y * y * y); return y * __builtin_amdgcn_rcpf(1.0f + __expf(-t2)); }
__device__ __forceinline__ void abar_pow(float lr, float li, float dt, int p, float& re, float& im) {
    const double ang = (double)p * (double)li * (double)dt;
    const double k = __builtin_rint(ang * 0.15915494309189535);
    const float r = (float)(ang - k * 6.283185307179586);
    const float mag = expf((float)((double)p * (double)lr * (double)dt));
    re = mag * cosf(r); im = mag * sinf(r);
}
__device__ __forceinline__ void s5_build(Frame& F, int L) {
    LAS float* APR = (LAS float*)(F.lds + RING_OFF);
    LAS float* API = APR + 17 * 64;
    LAS float* BBR = API + 17 * 64;
    LAS float* BBI = BBR + 1024;
    LAS float* CR = BBI + 1024;
    LAS float* CI = CR + 1024;
    LAS float* KT = CI + 1024;
    GAS unsigned char* wb = F.ws + WS_W + (size_t)(L & 1) * W_SLOT;
    for (int g = F.vcu; g < NG; g += F.G) {
        const size_t lg = (size_t)L * NG + g;
        const float dt = expf(inp(F, I_LDT)[lg]);
        for (int i = F.tid; i < 17 * 64; i += NWAVES * 64) { const int p = i >> 6, n = i & 63; float pr, pi;
            abar_pow(inp(F, I_LRE)[lg * NS + n], inp(F, I_LIM)[lg * NS + n], dt, p, pr, pi);
            APR[i] = pr; API[i] = pi; }
        for (int i = F.tid; i < 1024; i += NWAVES * 64) { const int n = i >> 4;
            const float lr = inp(F, I_LRE)[lg * NS + n], li = inp(F, I_LIM)[lg * NS + n]; float are, aim;
            abar_pow(lr, li, dt, 1, are, aim);
            const float den = lr * lr + li * li, nr = are - 1.0f, ni = aim;
            const float qre = (nr * lr + ni * li) / den, qim = (ni * lr - nr * li) / den;
            const float br = inp(F, I_BRE)[lg * 1024 + i], bi = inp(F, I_BIM)[lg * 1024 + i];
            BBR[i] = qre * br - qim * bi; BBI[i] = qre * bi + qim * br;
            CR[i] = inp(F, I_CRE)[lg * 1024 + i]; CI[i] = inp(F, I_CIM)[lg * 1024 + i]; }
        __syncthreads();
        for (int i = F.tid; i < 4096; i += NWAVES * 64) { const int tau = i >> 8, c = (i >> 4) & 15, cp = i & 15; float acc = 0.f;
            for (int n = 0; n < 64; ++n) { const float cr = CR[c * 64 + n], ci = CI[c * 64 + n], ar = APR[tau * 64 + n], ai = API[tau * 64 + n], br = BBR[n * 16 + cp], bi = BBI[n * 16 + cp];
                const float mr = cr * ar - ci * ai, mi = cr * ai + ci * ar; acc += mr * br - mi * bi; }
            KT[i] = acc; }
        __syncthreads();
        GAS unsigned* KC = (GAS unsigned*)(wb + WO_S5) + (size_t)g * 256 * 192;
        GAS unsigned* BE = (GAS unsigned*)(wb + WO_S5 + S5_KC_BYTES) + (size_t)g * 128 * 128;
        for (int i = F.tid; i < 256 * 192; i += NWAVES * 64) { const int row = i / 192, cp2 = i - row * 192, t = row >> 4, c = row & 15; float v[2];
#pragma unroll
            for (int e = 0; e < 2; ++e) { const int col = 2 * cp2 + e;
                if (col < 256) { const int j = col >> 4, cq = col & 15; v[e] = j <= t ? KT[((t - j) * 16 + c) * 16 + cq] : 0.f; }
                else { const int n = (col - 256) & 63; const float cr = CR[c * 64 + n], ci = CI[c * 64 + n], ar = APR[(t + 1) * 64 + n], ai = API[(t + 1) * 64 + n];
                    v[e] = col < 320 ? cr * ar - ci * ai : -(cr * ai + ci * ar); } }
            KC[i] = pk2(v[0], v[1]); }
        for (int i = F.tid; i < 128 * 128; i += NWAVES * 64) { const int n2 = i >> 7, cp2 = i & 127, n = n2 & 63; float v[2];
#pragma unroll
            for (int e = 0; e < 2; ++e) { const int col = 2 * cp2 + e, j = col >> 4, cq = col & 15; const float ar = APR[(15 - j) * 64 + n], ai = API[(15 - j) * 64 + n], br = BBR[n * 16 + cq], bi = BBI[n * 16 + cq];
                v[e] = n2 < 64 ? ar * br - ai * bi : ar * bi + ai * br; }
            BE[i] = pk2(v[0], v[1]); }
        __syncthreads();
    }
}
typedef short bfx8 __attribute__((ext_vector_type(8)));
typedef __bf16 bf2v __attribute__((ext_vector_type(2)));
__device__ __forceinline__ unsigned cvt2(float a, float b) { const f32x2 v = {a, b}; const bf2v r = __builtin_convertvector(v, bf2v); return __builtin_bit_cast(unsigned, r); }
__device__ __forceinline__ float bfu(unsigned short u) { return __uint_as_float((unsigned)u << 16); }
__device__ __forceinline__ void wait_vm(int n) {
    switch (n) {
    case 0: asm volatile("s_waitcnt vmcnt(0)" ::: "memory"); break; case 1: asm volatile("s_waitcnt vmcnt(1)" ::: "memory"); break; case 2: asm volatile("s_waitcnt vmcnt(2)" ::: "memory"); break;
    case 3: asm volatile("s_waitcnt vmcnt(3)" ::: "memory"); break; case 4: asm volatile("s_waitcnt vmcnt(4)" ::: "memory"); break; case 5: asm volatile("s_waitcnt vmcnt(5)" ::: "memory"); break;
    case 6: asm volatile("s_waitcnt vmcnt(6)" ::: "memory"); break; case 7: asm volatile("s_waitcnt vmcnt(7)" ::: "memory"); break; case 8: asm volatile("s_waitcnt vmcnt(8)" ::: "memory"); break;
    case 9: asm volatile("s_waitcnt vmcnt(9)" ::: "memory"); break; case 10: asm volatile("s_waitcnt vmcnt(10)" ::: "memory"); break; case 11: asm volatile("s_waitcnt vmcnt(11)" ::: "memory"); break;
    case 12: asm volatile("s_waitcnt vmcnt(12)" ::: "memory"); break; default: asm volatile("s_waitcnt vmcnt(0)" ::: "memory"); break; }
}
__device__ __forceinline__ void s5_unit(Frame& F, int L, int b, int g) {
    const int lane = F.lane, w = F.wave, fr = lane & 15, fq = lane >> 4;
    GAS unsigned char* wb = F.ws + WS_W + (size_t)(L & 1) * W_SLOT;
    const GAS unsigned char* U2b = F.ws + WS_OV + OV_U2 + (size_t)g * U2_CR * 512;
    const GAS bf16* KC = (const GAS bf16*)(wb + WO_S5) + (size_t)g * 256 * 384;
    const GAS bf16* BE = (const GAS bf16*)(wb + WO_S5 + S5_KC_BYTES) + (size_t)g * 128 * 256;
    GAS bf16* YPRE = (GAS bf16*)(F.ws + WS_OV + OV_YPRE);
    constexpr int SLP = 136, UD = 5, UNS = 7;
    LAS bf16* SLh = (LAS bf16*)(F.lds + RING_OFF);
    LAS unsigned char* UR = F.lds + RING_OFF + 256 * SLP * 2;
    static_assert(256 * SLP * 2 + UNS * 8192 <= RING_BYTES, "S5 LDS map");
    const int ur = 2 * w + (lane >> 5), upc = ((lane & 31) ^ ur) * 16;
#define S5_ISSUE(ct_) do { const int c_ = (ct_) * 16 + ur; const int row_ = c_ == 0 ? 1024 : (c_ > 256 ? b * 256 + 255 : b * 256 + c_ - 1); \
        __builtin_amdgcn_global_load_lds((const GAS unsigned*)(U2b + (size_t)row_ * 512 + upc), (LAS unsigned*)(UR + ((ct_) % UNS) * 8192 + w * 1024), 16, 0, 0); } while (0)
#define S5_FRAG(sl_, p_) (*(const LAS bfx8*)((sl_) + ((((p_)) ^ fr) << 4)))
    {
        bfx8 wf[8];
#pragma unroll
        for (int ks = 0; ks < 8; ++ks) wf[ks] = *(const GAS bfx8*)(BE + (size_t)(16 * w + fr) * 256 + ks * 32 + 8 * fq);
        asm volatile("s_waitcnt vmcnt(0)" ::: "memory");
#pragma unroll
        for (int i = 0; i < UD; ++i) S5_ISSUE(i);
#pragma unroll
        for (int ct = 0; ct < 16; ++ct) {
            if (ct + UD < 16) S5_ISSUE(ct + UD);
            wait_vm(15 - ct < UD ? 15 - ct : UD);
            __builtin_amdgcn_s_barrier(); asm volatile("" ::: "memory");
            const LAS unsigned char* sl = UR + (ct % UNS) * 8192 + fr * 512;
            f32x4 acc = {0.f, 0.f, 0.f, 0.f};
#pragma unroll
            for (int ks = 0; ks < 8; ++ks) acc = __builtin_amdgcn_mfma_f32_16x16x32_bf16(wf[ks], S5_FRAG(sl, ks * 4 + fq), acc, 0, 0, 0);
            v2u o; o.x = cvt2(acc[0], acc[1]); o.y = cvt2(acc[2], acc[3]);
            *(LAS v2u*)(SLh + (ct * 16 + fr) * SLP + 16 * w + 4 * fq) = o;
        }
    }
    __syncthreads();
    {
        const int n = lane; const size_t lg = (size_t)L * NG + g;
        const float lr_ = inp(F, I_LRE)[lg * NS + n], li_ = inp(F, I_LIM)[lg * NS + n], dt_ = expf(inp(F, I_LDT)[lg]);
        float a_re, a_im, A_re, A_im; abar_pow(lr_, li_, dt_, 16, a_re, a_im); abar_pow(lr_, li_, dt_, 512, A_re, A_im);
        LAS float* TT = (LAS float*)UR;
        LAS bf16* seg = SLh + (size_t)(32 * w) * SLP;
        float pre[32], pim[32]; float sre = 0.f, sim = 0.f;
#pragma unroll
        for (int j = 0; j < 32; ++j) { const float cre = bfu(seg[j * SLP + n]), cim = bfu(seg[j * SLP + 64 + n]);
            const float nre = a_re * sre - a_im * sim + cre, nim = a_re * sim + a_im * sre + cim; sre = nre; sim = nim; pre[j] = sre; pim[j] = sim; }
        TT[w * 128 + n] = sre; TT[w * 128 + 64 + n] = sim;
        __syncthreads();
        float ire = 0.f, iim = 0.f;
        for (int k = 0; k < w; ++k) { const float tre = TT[k * 128 + n], tim = TT[k * 128 + 64 + n]; const float nre = A_re * ire - A_im * iim + tre, nim = A_re * iim + A_im * ire + tim; ire = nre; iim = nim; }
        float qre = a_re, qim = a_im;
#pragma unroll
        for (int j = 0; j < 32; ++j) { const float ore = pre[j] + qre * ire - qim * iim, oim = pim[j] + qre * iim + qim * ire;
            const unsigned o2 = cvt2(ore, oim); seg[j * SLP + n] = (bf16)o2; seg[j * SLP + 64 + n] = (bf16)(o2 >> 16);
            const float nq = qre * a_re - qim * a_im; qim = qre * a_im + qim * a_re; qre = nq; }
    }
    __syncthreads();
    {
        bfx8 wf[2][12];
#pragma unroll
        for (int tt = 0; tt < 2; ++tt)
#pragma unroll
            for (int ks = 0; ks < 12; ++ks) wf[tt][ks] = *(const GAS bfx8*)(KC + (size_t)(16 * (2 * w + tt) + fr) * 384 + ks * 32 + 8 * fq);
        const f32x4 d4 = *(const GAS f32x4*)(inp(F, I_SD) + (size_t)L * SW + g * SGC + 4 * fq);
        asm volatile("s_waitcnt vmcnt(0)" ::: "memory");
#pragma unroll
        for (int i = 0; i < UD; ++i) S5_ISSUE(i);
#pragma unroll
        for (int ct = 0; ct < 17; ++ct) {
            int nafter = 0;
            if (ct < UD) nafter = (UD - 1 - ct) + 3 * ct;
            else { nafter = 0;
#pragma unroll
                for (int j = ct - UD + 1; j < ct; ++j) nafter += 2 + (j + UD <= 16 ? 1 : 0); }
            wait_vm(nafter);
            __builtin_amdgcn_s_barrier(); asm volatile("" ::: "memory");
            const LAS unsigned char* sl = UR + (ct % UNS) * 8192 + fr * 512;
            const int c = ct * 16 + fr, cc = c <= 256 ? c : 256;
            f32x4 acc[2] = {{0.f, 0.f, 0.f, 0.f}, {0.f, 0.f, 0.f, 0.f}};
#pragma unroll
            for (int ks = 0; ks < 8; ++ks) { const bfx8 af = S5_FRAG(sl, ks * 4 + fq);
                acc[0] = __builtin_amdgcn_mfma_f32_16x16x32_bf16(wf[0][ks], af, acc[0], 0, 0, 0); acc[1] = __builtin_amdgcn_mfma_f32_16x16x32_bf16(wf[1][ks], af, acc[1], 0, 0, 0); }
#pragma unroll
            for (int ks = 0; ks < 4; ++ks) {
                bfx8 sf = {0, 0, 0, 0, 0, 0, 0, 0};
                if (cc >= 1) sf = *(const LAS bfx8*)(SLh + (cc - 1) * SLP + ks * 32 + 8 * fq);
                acc[0] = __builtin_amdgcn_mfma_f32_16x16x32_bf16(wf[0][8 + ks], sf, acc[0], 0, 0, 0); acc[1] = __builtin_amdgcn_mfma_f32_16x16x32_bf16(wf[1][8 + ks], sf, acc[1], 0, 0, 0);
            }
#pragma unroll
            for (int tt = 0; tt < 2; ++tt) { const int t = 2 * w + tt; const int row = cc == 0 ? MR + t : b * SEQ + (cc - 1) * 16 + t;
                const v2u uu = *(const LAS v2u*)(sl + (((2 * t + (fq >> 1)) ^ fr) << 4) + (fq & 1) * 8);
                const float u0 = __uint_as_float(uu.x << 16), u1 = __uint_as_float(uu.x & 0xffff0000u), u2 = __uint_as_float(uu.y << 16), u3 = __uint_as_float(uu.y & 0xffff0000u);
                v2u o; o.x = pk2(gelu_tanh(acc[tt][0] + d4[0] * u0), gelu_tanh(acc[tt][1] + d4[1] * u1)); o.y = pk2(gelu_tanh(acc[tt][2] + d4[2] * u2), gelu_tanh(acc[tt][3] + d4[3] * u3));
                *(GAS v2u*)(YPRE + (size_t)row * SW + g * SGC + 4 * fq) = o; }
            asm volatile("" ::: "memory");
            if (ct + UD < 17) S5_ISSUE(ct + UD);
        }
    }
#undef S5_ISSUE
#undef S5_FRAG
    __syncthreads();
}

__device__ __forceinline__ void lora_weights(Frame& F, int L) {
    GAS unsigned char* wb = F.ws + WS_W + (size_t)(L & 1) * W_SLOT;
    GAS v4u* WL = (GAS v4u*)(wb + WO_LORA);
    const GAS float* w2 = inp(F, I_W2) + (size_t)L * 64 * RW_W; const GAS float* a2 = inp(F, I_A2) + (size_t)L * 64 * RW_W; const GAS float* g2 = inp(F, I_G2) + (size_t)L * 160 * RW_W;
    const GAS float* v2 = inp(F, I_V2) + (size_t)(L > 0 ? L - 1 : 0) * 32 * RW_W;
    for (int i = (int)(F.vcu * (NWAVES * 64) + F.tid); i < 4096 * (LKP / 8); i += F.G * NWAVES * 64) {
        const int row = i / (LKP / 8), k0 = (i - row * (LKP / 8)) * 8, kind = row >> 10, ch = row & 1023; float v[8];
#pragma unroll
        for (int e = 0; e < 8; ++e) { const int k = k0 + e; float x = 0.f;
            if (kind == 0) { if (k < 64) x = w2[(size_t)k * RW_W + ch]; }
            else if (kind == 1) { if (k >= 64 && k < 128) x = a2[(size_t)(k - 64) * RW_W + ch]; }
            else if (kind == 2) { if (k >= 128 && k < 288) x = g2[(size_t)(k - 128) * RW_W + ch]; }
            else { if (L > 0 && k >= 288 && k < 320) x = v2[(size_t)(k - 288) * RW_W + ch]; }
            v[e] = x; }
        v4u o; o.x = pk2(v[0], v[1]); o.y = pk2(v[2], v[3]); o.z = pk2(v[4], v[5]); o.w = pk2(v[6], v[7]); WL[i] = o;
    }
}
__device__ __forceinline__ void lora_inputs(Frame& F, int L) {
    const int gw = F.vcu * NWAVES + F.wave, NGW = F.G * NWAVES, k0 = 8 * F.lane;
    const GAS bf16* LIN = (const GAS bf16*)(F.ws + WS_OV + OV_LIN); GAS bf16* LA = (GAS bf16*)(F.ws + WS_OV + OV_LA);
    if (k0 >= LKP) return;
    f32x4 m0 = {0.f, 0.f, 0.f, 0.f}, m1 = m0;
    if (k0 < 288) { const GAS float* ms = inp(F, I_MUSH) + (size_t)L * 3360 + 3072 + k0; m0 = *(const GAS f32x4*)ms; m1 = *(const GAS f32x4*)(ms + 4); }
    else if (k0 < 320 && L > 0) { const GAS float* mv = inp(F, I_MUVR) + (size_t)(L - 1) * 32 + (k0 - 288); m0 = *(const GAS f32x4*)mv; m1 = *(const GAS f32x4*)(mv + 4); }
    const bool live = k0 < 288 || (k0 < 320 && L > 0);
    for (int row = gw; row < MROWS; row += NGW) {
        v4u o = {0u, 0u, 0u, 0u};
        if (live) { const int prow = prev_row(row);
            f32x4 x0, x1, p0 = {0.f, 0.f, 0.f, 0.f}, p1 = p0;
            pg8::unpack8(*(const GAS v4u*)(LIN + (size_t)row * 512 + k0), x0, x1);
            if (prow >= 0) pg8::unpack8(*(const GAS v4u*)(LIN + (size_t)prow * 512 + k0), p0, p1);
            x0 = x0 + m0 * (p0 - x0); x1 = x1 + m1 * (p1 - x1);
            if (k0 < 64) {
#pragma unroll
                for (int e = 0; e < 4; ++e) { x0[e] = 1.0f - 2.0f * __builtin_amdgcn_rcpf(1.0f + __expf(2.0f * x0[e])); x1[e] = 1.0f - 2.0f * __builtin_amdgcn_rcpf(1.0f + __expf(2.0f * x1[e])); }
            } else if (k0 >= 128 && k0 < 288) {
#pragma unroll
                for (int e = 0; e < 4; ++e) { x0[e] = __builtin_amdgcn_rcpf(1.0f + __expf(-x0[e])); x1[e] = __builtin_amdgcn_rcpf(1.0f + __expf(-x1[e])); }
            }
            o.x = pk2(x0[0], x0[1]); o.y = pk2(x0[2], x0[3]); o.z = pk2(x1[0], x1[1]); o.w = pk2(x1[2], x1[3]); }
        *(GAS v4u*)(LA + (size_t)row * LKP + k0) = o;
    }
}
__device__ __forceinline__ f32x4 ld_bf4(const GAS bf16* p) { const v2u u = *(const GAS v2u*)p; return (f32x4){__uint_as_float(u.x << 16), __uint_as_float(u.x & 0xffff0000u), __uint_as_float(u.y << 16), __uint_as_float(u.y & 0xffff0000u)}; }
constexpr int REC_TB = 32, REC_F = 6 * HD, REC_LF = REC_F + 4, REC_NBLK = (TSEQ + REC_TB - 1) / REC_TB, REC_OBUF = 2 * REC_TB * REC_LF;
__device__ __forceinline__ void rwkv_rec_unit(Frame& F, int L, int b, int h, int q) {
    GAS float* O = (GAS float*)(F.ws + WS_OV + OV_O);
    LAS float* buf = (LAS float*)(F.lds + RING_OFF);
    const bool loader = F.wave >= 4;
    const int lt = F.tid - 256;
    const int rg = F.lane >> 4, j = F.lane & 15, lrow = (F.wave & 3) * 4 + rg, vrow = q * 16 + lrow;
    f32x4 S = {0.f, 0.f, 0.f, 0.f};
    const int ltk = lt >> 4, lj = lt & 15, C = h * HD + 4 * lj;
    const GAS bf16* RKVp = (const GAS bf16*)(F.ws + WS_OV + OV_RKV); const GAS bf16* DECp = (const GAS bf16*)(F.ws + WS_OV + OV_DEC); const GAS bf16* ICLp = (const GAS bf16*)(F.ws + WS_OV + OV_ICLR);
    const GAS bf16* VGp = (const GAS bf16*)(F.ws + WS_OV + OV_VG);
    LAS float* PL = (LAS float*)(F.lds + LDSCTL_OFF + 1024);
    for (int pi = F.wave; pi < 9; pi += NWAVES) {
        const GAS float* src = pi < 3 ? inp(F, I_MUSH) + (size_t)L * 3360 + pi * 1024 : pi == 3 ? inp(F, I_W0) + (size_t)L * RW_W : pi == 4 ? inp(F, I_A0) + (size_t)L * RW_W : pi == 5 ? inp(F, I_V0) + (size_t)(L > 0 ? L - 1 : 0) * RW_W
                             : pi == 6 ? inp(F, I_KK) + (size_t)L * RW_W : pi == 7 ? inp(F, I_KA) + (size_t)L * RW_W : inp(F, I_RK) + (size_t)L * RW_W;
        const float x = src[h * HD + F.lane];
        PL[pi * 64 + F.lane] = (pi == 5 && L == 0) ? 0.f : x; }
    __syncthreads();
    v2u rr[2][2], rk_[2][2], rv[2][2], rvg[2], rvf[2], rdc[2], ric[2];
#define REC_LOAD(blk) do { \
        _Pragma("unroll") for (int p_ = 0; p_ < 2; ++p_) { int s_ = (blk) * REC_TB + ltk + 16 * p_; s_ = s_ > TSEQ - 1 ? TSEQ - 1 : s_; const int sp_ = s_ > 0 ? s_ - 1 : 0; \
            const size_t ro_ = (size_t)seq_row(b, s_) * RW_W + C, rp_ = (size_t)seq_row(b, sp_) * RW_W + C; \
            rr[p_][0] = *(const GAS v2u*)(RKVp + ro_); rr[p_][1] = *(const GAS v2u*)(RKVp + rp_); \
            rk_[p_][0] = *(const GAS v2u*)(RKVp + (size_t)MP * 1024 + ro_); rk_[p_][1] = *(const GAS v2u*)(RKVp + (size_t)MP * 1024 + rp_); \
            rv[p_][0] = *(const GAS v2u*)(RKVp + (size_t)2 * MP * 1024 + ro_); rv[p_][1] = *(const GAS v2u*)(RKVp + (size_t)2 * MP * 1024 + rp_); \
            rdc[p_] = *(const GAS v2u*)(DECp + ro_); ric[p_] = *(const GAS v2u*)(ICLp + ro_); \
            if (L > 0) { rvg[p_] = *(const GAS v2u*)(VGp + ro_); rvf[p_] = *(const GAS v2u*)(FVF(F) + ro_); } } } while (0)
#define UB4(u) ((f32x4){__uint_as_float((u).x << 16), __uint_as_float((u).x & 0xffff0000u), __uint_as_float((u).y << 16), __uint_as_float((u).y & 0xffff0000u)})
#define REC_STORE(bi, blk) do { int lj2_ = lt & 15; asm volatile("" : "+v"(lj2_)); const LAS float* plj = PL + 4 * lj2_;     \
        _Pragma("unroll") for (int p_ = 0; p_ < 2; ++p_) { const int tk_ = ltk + 16 * p_, s_ = (blk) * REC_TB + tk_; const float pm_ = s_ > 0 ? 1.f : 0.f; \
            f32x4 xr_, xk_, xv_, dec_, icl_, vv_; \
            { const f32x4 mu_r = *(const LAS f32x4*)(plj), mu_k = *(const LAS f32x4*)(plj + 64), mu_v = *(const LAS f32x4*)(plj + 128); \
              const f32x4 r1_ = UB4(rr[p_][0]), k1_ = UB4(rk_[p_][0]), v1_ = UB4(rv[p_][0]); \
              xr_ = r1_ + mu_r * (UB4(rr[p_][1]) * pm_ - r1_); xk_ = k1_ + mu_k * (UB4(rk_[p_][1]) * pm_ - k1_); xv_ = v1_ + mu_v * (UB4(rv[p_][1]) * pm_ - v1_); } \
            asm volatile("" ::: "memory"); \
            { const f32x4 wl_ = UB4(rdc[p_]) + *(const LAS f32x4*)(plj + 192), al_ = UB4(ric[p_]) + *(const LAS f32x4*)(plj + 256); vv_ = xv_; \
              if (L > 0) { const f32x4 vf_ = UB4(rvf[p_]), vg_ = UB4(rvg[p_]) + *(const LAS f32x4*)(plj + 320); \
                  _Pragma("unroll") for (int e_ = 0; e_ < 4; ++e_) vv_[e_] = xv_[e_] + (vf_[e_] - xv_[e_]) * __builtin_amdgcn_rcpf(1.0f + __expf(-vg_[e_])); } \
              _Pragma("unroll") for (int e_ = 0; e_ < 4; ++e_) {        \
                  dec_[e_] = __expf(-0.60653066f * __builtin_amdgcn_rcpf(1.0f + __expf(-wl_[e_]))); icl_[e_] = __builtin_amdgcn_rcpf(1.0f + __expf(-al_[e_])); } } \
            asm volatile("" ::: "memory"); \
            const f32x4 kkc = *(const LAS f32x4*)(plj + 384), kac = *(const LAS f32x4*)(plj + 448), rkc = *(const LAS f32x4*)(plj + 512); \
            f32x4 kk_, k2_, bb_, wr_; float skk_ = 0.f, srk_ = 0.f, sbr_ = 0.f, skr_ = 0.f; \
            _Pragma("unroll") for (int e_ = 0; e_ < 4; ++e_) { \
                kk_[e_] = xk_[e_] * kkc[e_]; skk_ += kk_[e_] * kk_[e_]; k2_[e_] = xk_[e_] * (1.0f + (icl_[e_] - 1.0f) * kac[e_]); \
                srk_ += xr_[e_] * k2_[e_] * rkc[e_]; skr_ += k2_[e_] * xr_[e_]; } \
            const float inv_ = rsqrtf(row16_sum(skk_) + 1e-12f); \
            _Pragma("unroll") for (int e_ = 0; e_ < 4; ++e_) { kk_[e_] *= inv_; bb_[e_] = kk_[e_] * icl_[e_]; sbr_ += bb_[e_] * xr_[e_]; wr_[e_] = dec_[e_] * xr_[e_]; } \
            const float br_ = row16_sum(sbr_), kr_ = row16_sum(skr_); \
            LAS float* rec_ = buf + (bi) * (REC_TB * REC_LF) + tk_ * REC_LF + 4 * lj; \
            *(LAS f32x4*)(rec_) = dec_; *(LAS f32x4*)(rec_ + HD) = k2_; *(LAS f32x4*)(rec_ + 2 * HD) = -kk_; *(LAS f32x4*)(rec_ + 3 * HD) = bb_; *(LAS f32x4*)(rec_ + 4 * HD) = wr_; *(LAS f32x4*)(rec_ + 5 * HD) = vv_; \
            if (lj == 0) *(LAS f32x2*)(rec_ + REC_F) = (f32x2){br_, kr_}; \
            if (q == 0 && s_ < TSEQ) { const size_t ro_ = (size_t)seq_row(b, s_) * RW_W + C; const float rks_ = row16_sum(srk_); \
                *(GAS f32x4*)((GAS float*)(F.ws + WS_OV + OV_RW) + ro_) = vv_; if (lj == 0) ((GAS float*)(F.ws + WS_OV + OV_RKS))[(size_t)seq_row(b, s_) * NH + h] = rks_; \
                if (L == 0) { v2u o_; o_.x = pk2(xv_[0], xv_[1]); o_.y = pk2(xv_[2], xv_[3]); *(GAS v2u*)(FVF(F) + ro_) = o_; } } \
            asm volatile("" ::: "memory"); } } while (0)
#define REC_LD(X, tk) do { const LAS float* q_ = rp + (tk) * REC_LF; w##X = *(const LAS f32x4*)(q_); k##X = *(const LAS f32x4*)(q_ + HD); a##X = *(const LAS f32x4*)(q_ + 2 * HD); b##X = *(const LAS f32x4*)(q_ + 3 * HD); r##X = *(const LAS f32x4*)(q_ + 4 * HD); \
        v##X = q_[5 * HD - 4 * j + vrow]; s##X = *(const LAS f32x2*)(q_ + REC_F - 4 * j); } while (0)
#define REC_STEP(X, tk) do { float t0_, t1_, u0_, u1_, q0_, q1_, q2_, q3_, o_; \
        asm("v_mul_f32 %4, %0, %12\n\tv_mul_f32 %5, %0, %16\n\tv_fmac_f32 %4, %1, %13\n\tv_fmac_f32 %5, %1, %17\n\t" \
            "v_mul_f32 %6, %2, %14\n\tv_mul_f32 %7, %2, %18\n\tv_fmac_f32 %6, %3, %15\n\tv_fmac_f32 %7, %3, %19\n\t" \
            "v_add_f32 %4, %4, %6\n\tv_add_f32 %5, %5, %7\n\t" \
            "v_mul_f32 %8, %28, %24\n\t" \
            "v_add_f32_dpp %4, %4, %4 quad_perm:[1,0,3,2] row_mask:0xf bank_mask:0xf bound_ctrl:1\n\tv_add_f32_dpp %5, %5, %5 quad_perm:[1,0,3,2] row_mask:0xf bank_mask:0xf bound_ctrl:1\n\t" \
            "v_mul_f32 %9, %28, %25\n\t" \
            "v_add_f32_dpp %4, %4, %4 quad_perm:[2,3,0,1] row_mask:0xf bank_mask:0xf bound_ctrl:1\n\tv_add_f32_dpp %5, %5, %5 quad_perm:[2,3,0,1] row_mask:0xf bank_mask:0xf bound_ctrl:1\n\t" \
            "v_mul_f32 %10, %28, %26\n\t" \
            "v_add_f32_dpp %4, %4, %4 row_ror:4 row_mask:0xf bank_mask:0xf bound_ctrl:1\n\tv_add_f32_dpp %5, %5, %5 row_ror:4 row_mask:0xf bank_mask:0xf bound_ctrl:1\n\t" \
            "v_mul_f32 %11, %28, %27\n\t" \
            "v_add_f32_dpp %4, %4, %4 row_ror:8 row_mask:0xf bank_mask:0xf bound_ctrl:1\n\tv_add_f32_dpp %5, %5, %5 row_ror:8 row_mask:0xf bank_mask:0xf bound_ctrl:1\n\t" \
            "v_fma_f32 %0, %0, %20, %8\n\tv_fma_f32 %1, %1, %21, %9\n\tv_fma_f32 %2, %2, %22, %10\n\tv_fma_f32 %3, %3, %23, %11" \
            : "+v"(S[0]), "+v"(S[1]), "+v"(S[2]), "+v"(S[3]), "=&v"(t0_), "=&v"(u0_), "=&v"(t1_), "=&v"(u1_), "=&v"(q0_), "=&v"(q1_), "=&v"(q2_), "=&v"(q3_) \
            : "v"(a##X[0]), "v"(a##X[1]), "v"(a##X[2]), "v"(a##X[3]), "v"(r##X[0]), "v"(r##X[1]), "v"(r##X[2]), "v"(r##X[3]), "v"(w##X[0]), "v"(w##X[1]), "v"(w##X[2]), "v"(w##X[3]), \
              "v"(k##X[0]), "v"(k##X[1]), "v"(k##X[2]), "v"(k##X[3]), "v"(v##X)); \
        asm("v_fmac_f32 %0, %5, %7\n\tv_fmac_f32 %1, %5, %8\n\tv_fmac_f32 %2, %5, %9\n\tv_fmac_f32 %3, %5, %10\n\tv_fma_f32 %4, %5, %11, %6\n\tv_fmac_f32 %4, %13, %12" \
            : "+v"(S[0]), "+v"(S[1]), "+v"(S[2]), "+v"(S[3]), "=&v"(o_) \
            : "v"(t0_), "v"(u0_), "v"(b##X[0]), "v"(b##X[1]), "v"(b##X[2]), "v"(b##X[3]), "v"(s##X[0]), "v"(s##X[1]), "v"(v##X)); \
        ob[(tk) * 16 + lrow] = o_; } while (0)
    const bool conv = F.wave >= 5 && L + 1 < DEPTH;
    LAS unsigned* cscr = (LAS unsigned*)(buf + REC_OBUF + 2 * REC_TB * 16) + (F.wave - 5) * (64 * 36);
    int ct = F.vcu * 3 + (F.wave - 5);
    if (loader) { REC_LOAD(0); REC_STORE(0, 0); REC_LOAD(1); }
    __syncthreads();
    for (int blk = 0; blk < REC_NBLK; ++blk) {
        const int s0 = blk * REC_TB, nt = TSEQ - s0 < REC_TB ? TSEQ - s0 : REC_TB;
        LAS float* ob = buf + REC_OBUF + (blk & 1) * (REC_TB * 16);
        if (loader) {
            if (blk + 1 < REC_NBLK) REC_STORE((blk + 1) & 1, blk + 1);
            if (blk > 0) { const LAS float* pb = buf + REC_OBUF + ((blk - 1) & 1) * (REC_TB * 16); const int ps0 = s0 - REC_TB;
#pragma unroll
                for (int i = 0; i < 2; ++i) { const int idx = lt + 256 * i, tk = idx >> 4, r = idx & 15; O[(size_t)seq_row(b, ps0 + tk) * RW_W + h * HD + q * 16 + r] = pb[idx]; } }
            if (conv) { int m_, it_;
                if (tr_decode(L + 1, ct, m_, it_)) { const TrDesc d = tr_desc(F, L + 1, m_); f32x4 cv[16]; tr_tile_load(d, it_, F.lane, cv); tr_tile_finish(d, it_, F.lane, cv, cscr); ct += 3 * F.G; } }
            if (blk + 2 < REC_NBLK) REC_LOAD(blk + 2);
        } else {
            const LAS float* rp = buf + (blk & 1) * (REC_TB * REC_LF) + 4 * j;
            f32x4 wA, kA, aA, bA, rA, wB, kB, aB, bB, rB; float vA, vB; f32x2 sA, sB;
            REC_LD(A, 0);
            if (nt == REC_TB) {
#pragma unroll
                for (int tk = 0; tk < REC_TB; tk += 2) {
                    REC_LD(B, tk + 1);
                    REC_STEP(A, tk);
                    if (tk + 2 < REC_TB) REC_LD(A, tk + 2);
                    REC_STEP(B, tk + 1);
                }
            } else {
                for (int tk = 0; tk < nt; tk += 2) {
                    REC_LD(B, tk + 1);
                    REC_STEP(A, tk);
                    if (tk + 2 < nt) REC_LD(A, tk + 2);
                    REC_STEP(B, tk + 1);
                }
            }
        }
        __syncthreads();
    }
    if (loader) { const int lb = REC_NBLK - 1, ps0 = lb * REC_TB, nt = TSEQ - ps0; const LAS float* pb = buf + REC_OBUF + (lb & 1) * (REC_TB * 16);
        int b2 = b; asm volatile("" : "+s"(b2));
#pragma unroll
        for (int i = 0; i < 2; ++i) { const int idx = lt + 256 * i, tk = idx >> 4, r = idx & 15; if (tk < nt) O[(size_t)seq_row(b2, ps0 + tk) * RW_W + h * HD + q * 16 + r] = pb[idx]; } }
    if (conv) {
        for (;;) { int m_, it_; if (!tr_decode(L + 1, ct, m_, it_)) break;
            const TrDesc d = tr_desc(F, L + 1, m_); f32x4 cv[16]; tr_tile_load(d, it_, F.lane, cv); tr_tile_finish(d, it_, F.lane, cv, cscr); ct += 3 * F.G; }
    }
    __syncthreads();
#undef REC_LOAD
#undef UB4
#undef REC_STORE
#undef REC_LD
#undef REC_STEP
}
constexpr int CH_T = 16, CH_N = TSEQ / CH_T;
constexpr int CR_BYTES = 12288, CR_AT = 0, CR_RT = 2048, CR_BK = 4096, CR_ARK = 8192, CR_VT = 9216, CR_GT = 11264, CR_W15 = 11776;
constexpr size_t OV_CR = OV_RW + 192 * MiB;
static_assert(TSEQ % CH_T == 0, "chunks"); static_assert(OV_CR + (size_t)BATCH * NH * CH_N * CR_BYTES <= OV_O, "chunk records");
typedef short bfx4 __attribute__((ext_vector_type(4)));
__device__ __forceinline__ float sigm_(float x) { return __builtin_amdgcn_rcpf(1.0f + __expf(-x)); }
template <int CTRL, int RMASK> __device__ __forceinline__ float dppf(float x) { return __builtin_bit_cast(float, __builtin_amdgcn_update_dpp(0, __builtin_bit_cast(int, x), CTRL, RMASK, 0xF, false)); }
__device__ __forceinline__ void wave_sum2(float& x, float& y) {
    asm("s_nop 1\n\t"
        "v_add_f32_dpp %0, %0, %0 quad_perm:[1,0,3,2] row_mask:0xf bank_mask:0xf bound_ctrl:1\n\tv_add_f32_dpp %1, %1, %1 quad_perm:[1,0,3,2] row_mask:0xf bank_mask:0xf bound_ctrl:1\n\ts_nop 0\n\t"
        "v_add_f32_dpp %0, %0, %0 quad_perm:[2,3,0,1] row_mask:0xf bank_mask:0xf bound_ctrl:1\n\tv_add_f32_dpp %1, %1, %1 quad_perm:[2,3,0,1] row_mask:0xf bank_mask:0xf bound_ctrl:1\n\ts_nop 0\n\t"
        "v_add_f32_dpp %0, %0, %0 row_ror:4 row_mask:0xf bank_mask:0xf bound_ctrl:1\n\tv_add_f32_dpp %1, %1, %1 row_ror:4 row_mask:0xf bank_mask:0xf bound_ctrl:1\n\ts_nop 0\n\t"
        "v_add_f32_dpp %0, %0, %0 row_ror:8 row_mask:0xf bank_mask:0xf bound_ctrl:1\n\tv_add_f32_dpp %1, %1, %1 row_ror:8 row_mask:0xf bank_mask:0xf bound_ctrl:1\n\ts_nop 0\n\t"
        "v_add_f32_dpp %0, %0, %0 row_bcast:15 row_mask:0xa bank_mask:0xf\n\tv_add_f32_dpp %1, %1, %1 row_bcast:15 row_mask:0xa bank_mask:0xf\n\ts_nop 0\n\t"
        "v_add_f32_dpp %0, %0, %0 row_bcast:31 row_mask:0xc bank_mask:0xf\n\tv_add_f32_dpp %1, %1, %1 row_bcast:31 row_mask:0xc bank_mask:0xf\n\ts_nop 1"
        : "+v"(x), "+v"(y));
    x = lane_bcast(x, 63); y = lane_bcast(y, 63);
}
__device__ __forceinline__ LAS float* rwkv_prep_par(Frame& F, int L, int h) {
    constexpr float LOG2E = 1.4426950408889634f; const int lane = F.lane; const size_t lc = (size_t)L * RW_W + h * HD;
    LAS float* pp = (LAS float*)(F.lds + RING_OFF + 8 * 12288 + F.wave * 2304);
    const GAS float* mu = inp(F, I_MUSH) + (size_t)L * 3360 + h * HD;
    pp[lane] = mu[lane]; pp[64 + lane] = mu[1024 + lane]; pp[128 + lane] = mu[2048 + lane];
    pp[192 + lane] = -LOG2E * (inp(F, I_W0) + lc)[lane]; pp[256 + lane] = -LOG2E * (inp(F, I_A0) + lc)[lane];
    float v0 = 0.f; if (L > 0) v0 = -LOG2E * (inp(F, I_V0) + (lc - RW_W))[lane];
    pp[320 + lane] = v0; pp[384 + lane] = (inp(F, I_KK) + lc)[lane]; pp[448 + lane] = (inp(F, I_KA) + lc)[lane]; pp[512 + lane] = (inp(F, I_RK) + lc)[lane];
    return pp;
}
__device__ __forceinline__ void rwkv_prep_item(Frame& F, int L, int b, int h, int c, const LAS float* pp) {
    const int lane = F.lane, c16 = lane & 15, g = lane >> 4;
    LAS unsigned char* pl = F.lds + RING_OFF + F.wave * 12288;
    LAS bf16* M = (LAS bf16*)pl; LAS float* NT = (LAS float*)(pl + 9216); LAS float* AKT = NT + 256; LAS float* XGT = AKT + 256;
    GAS unsigned char* rec = F.ws + WS_OV + OV_CR + ((size_t)(b * NH + h) * CH_N + c) * CR_BYTES;
    const int rb = c == 0 ? MR : b * SEQ + (c - 1) * CH_T;
    const int rprev = c == 0 ? MR : (c == 1 ? MR + NMETA - 1 : rb - 1); const float pm0 = c == 0 ? 0.f : 1.f;
    constexpr float LOG2E = 1.4426950408889634f;
    const float mu_r = pp[lane], mu_k = pp[64 + lane], mu_v = pp[128 + lane], w0 = pp[192 + lane], a0 = pp[256 + lane], v0 = pp[320 + lane], k_k = pp[384 + lane], k_a = pp[448 + lane], r_k = pp[512 + lane];
    constexpr size_t PL = (size_t)MP * 1024;
    const GAS bf16* Rg = (const GAS bf16*)(F.ws + WS_OV + OV_RKV) + h * HD; GAS bf16* VFg = FVF(F) + h * HD;
    const int wrow = lane >> 3, wpc = lane & 7; v4u wr_[2], wk_[2], wv_[2], wf_[2];
#pragma unroll
    for (int i = 0; i < 2; ++i) { const size_t ro = (size_t)(rb + 8 * i + wrow) * 1024 + wpc * 8;
        wr_[i] = __builtin_nontemporal_load((const GAS v4u*)(Rg + ro)); wk_[i] = __builtin_nontemporal_load((const GAS v4u*)(Rg + PL + ro)); wv_[i] = __builtin_nontemporal_load((const GAS v4u*)(Rg + 2 * PL + ro));
        wf_[i] = (v4u){0u, 0u, 0u, 0u}; if (L > 0) wf_[i] = *(const GAS v4u*)(VFg + ro); }
    unsigned dl[8], il[8], gl[8];
    {
        const GAS bf16* LAg = (const GAS bf16*)(F.ws + WS_OV + OV_LA) + (size_t)(rb + c16) * LKP + 8 * g;
        const GAS bf16* WLg = (const GAS bf16*)(F.ws + WS_W + (size_t)(L & 1) * W_SLOT + WO_LORA) + (size_t)(h * HD + c16) * LKP + 8 * g;
        LAS float* TS = (LAS float*)pl;
#pragma unroll
        for (int kd = 0; kd < 3; ++kd) { const int kind = kd == 2 ? 3 : kd, kb = kd == 0 ? 0 : kd == 1 ? 64 : 288, nks = kd == 2 ? 1 : 2;
            if (kd == 2 && L == 0) break;
            bfx8 lb[2];
#pragma unroll
            for (int sk = 0; sk < nks; ++sk) lb[sk] = *(const GAS bfx8*)(LAg + kb + 32 * sk);
#pragma unroll
            for (int tile = 0; tile < 4; ++tile) { f32x4 acc = {0.f, 0.f, 0.f, 0.f};
#pragma unroll
                for (int sk = 0; sk < nks; ++sk) acc = __builtin_amdgcn_mfma_f32_16x16x32_bf16(*(const GAS bfx8*)(WLg + (size_t)(kind * 1024 + 16 * tile) * LKP + kb + 32 * sk), lb[sk], acc, 0, 0, 0);
#pragma unroll
                for (int e = 0; e < 4; ++e) TS[(16 * tile + 4 * g + e) * 20 + c16] = acc[e]; }
#pragma unroll
            for (int q = 0; q < 4; ++q) { const f32x4 v = *(const LAS f32x4*)(TS + lane * 20 + 4 * q);
#pragma unroll
                for (int e = 0; e < 2; ++e) { const unsigned u2 = cvt2(v[2 * e], v[2 * e + 1]); if (kd == 0) dl[2 * q + e] = u2; else if (kd == 1) il[2 * q + e] = u2; else gl[2 * q + e] = u2; } }
            asm volatile("" ::: "memory");
        }
    }
#pragma unroll
    for (int i = 0; i < 2; ++i) { LAS bf16* wp = M + (8 * i + wrow) * 72 + wpc * 8;
        *(LAS bfx8*)(wp) = __builtin_bit_cast(bfx8, wr_[i]); *(LAS bfx8*)(wp + 1152) = __builtin_bit_cast(bfx8, wk_[i]); *(LAS bfx8*)(wp + 2304) = __builtin_bit_cast(bfx8, wv_[i]); *(LAS bfx8*)(wp + 3456) = __builtin_bit_cast(bfx8, wf_[i]); }
    GAS bf16* Vout = (GAS bf16*)(F.ws + WS_OV + OV_RW) + h * HD; GAS float* RKS = (GAS float*)(F.ws + WS_OV + OV_RKS);
    float pr = bfu((Rg + (size_t)rprev * 1024)[lane]) * pm0, pk = bfu((Rg + PL + (size_t)rprev * 1024)[lane]) * pm0, pv = bfu((Rg + 2 * PL + (size_t)rprev * 1024)[lane]) * pm0;
    float cum = 0.f, wex = 1.f, Ah[16], rksv = 0.f; unsigned Bp[8], Kq[8], Vq[8], bkl = 0u; float vlo = 0.f;
    LAS bf16* VO = (LAS bf16*)NT;
#pragma unroll
    for (int hf = 0; hf < 2; ++hf) {
#pragma unroll
        for (int e = 0; e < 8; ++e) { const int t = 8 * hf + e; const size_t ro = (size_t)(rb + t) * 1024;
            const float r1 = bfu(M[t * 72 + lane]), k1 = bfu(M[1152 + t * 72 + lane]), v1 = bfu(M[2304 + t * 72 + lane]), vf1 = bfu(M[3456 + t * 72 + lane]);
            const float xr = r1 + mu_r * (pr - r1), xk = k1 + mu_k * (pk - k1), xv = v1 + mu_v * (pv - v1); pr = r1; pk = k1; pv = v1;
#define PKF(a_) ((t & 1) ? __uint_as_float((a_)[t >> 1] & 0xffff0000u) : __uint_as_float((a_)[t >> 1] << 16))
            const float sg = __builtin_amdgcn_rcpf(1.0f + __builtin_amdgcn_exp2f(__builtin_fmaf(PKF(dl), -LOG2E, w0))), icl = __builtin_amdgcn_rcpf(1.0f + __builtin_amdgcn_exp2f(__builtin_fmaf(PKF(il), -LOG2E, a0)));
            float vv = xv; if (L > 0) vv = xv + (vf1 - xv) * __builtin_amdgcn_rcpf(1.0f + __builtin_amdgcn_exp2f(__builtin_fmaf(PKF(gl), -LOG2E, v0)));
#undef PKF
            float kk = xk * k_k; const float k2 = xk * (1.0f + (icl - 1.0f) * k_a);
            float skk = kk * kk, rks = xr * k2 * r_k; wave_sum2(skk, rks);
            kk *= __builtin_amdgcn_rsqf(skk + 1e-12f);
            rksv = lane == t ? rks : rksv;
            cum = __builtin_fmaf(sg, -0.60653066f * LOG2E, cum); const float win = __builtin_amdgcn_exp2f(cum), iwin = __builtin_amdgcn_exp2f(-cum);
            const float ah = -kk * wex, rh = xr * win, bh = kk * icl * iwin, kh = k2 * iwin; wex = win; Ah[t] = ah;
            const unsigned ar = cvt2(ah, rh), bk = cvt2(bh, kh);
            M[t * 72 + lane] = (bf16)ar; M[1152 + t * 72 + lane] = (bf16)(ar >> 16); M[2304 + t * 72 + lane] = (bf16)bk; M[3456 + t * 72 + lane] = (bf16)(bk >> 16);
            if (t & 1) { Bp[t >> 1] = (bkl & 0xffffu) | (bk << 16); Kq[t >> 1] = (bkl >> 16) | (bk & 0xffff0000u); Vq[t >> 1] = cvt2(vlo, vv); VO[(t - 1) * 72 + lane] = (bf16)Vq[t >> 1]; VO[t * 72 + lane] = (bf16)(Vq[t >> 1] >> 16); } else { bkl = bk; vlo = vv; } }
    }
    int l2_ = lane; asm volatile("" : "+v"(l2_));
    if (l2_ < 16) RKS[(size_t)(rb + l2_) * NH + h] = rksv; const int wrow2 = l2_ >> 3, wpc2 = l2_ & 7;
#pragma unroll
    for (int i = 0; i < 2; ++i) __builtin_nontemporal_store(__builtin_bit_cast(v4u, *(const LAS bfx8*)(VO + (8 * i + wrow2) * 72 + wpc2 * 8)), (GAS v4u*)(Vout + (size_t)(rb + 8 * i + wrow2) * 1024 + wpc2 * 8));
    if (L == 0) {
#pragma unroll
        for (int i = 0; i < 2; ++i) *(GAS v4u*)(VFg + (size_t)(rb + 8 * i + wrow2) * 1024 + wpc2 * 8) = __builtin_bit_cast(v4u, *(const LAS bfx8*)(VO + (8 * i + wrow2) * 72 + wpc2 * 8)); }
    f32x4 Nm = {0.f, 0.f, 0.f, 0.f}, AK = Nm, RB = Nm, RK = Nm;
#pragma unroll
    for (int s = 0; s < 2; ++s) { const int o = c16 * 72 + 32 * s + 8 * g;
        const bfx8 at = *(const LAS bfx8*)(M + o), rt = *(const LAS bfx8*)(M + 1152 + o), bt = *(const LAS bfx8*)(M + 2304 + o), kt = *(const LAS bfx8*)(M + 3456 + o);
        Nm = __builtin_amdgcn_mfma_f32_16x16x32_bf16(bt, at, Nm, 0, 0, 0); AK = __builtin_amdgcn_mfma_f32_16x16x32_bf16(kt, at, AK, 0, 0, 0);
        RB = __builtin_amdgcn_mfma_f32_16x16x32_bf16(bt, rt, RB, 0, 0, 0); RK = __builtin_amdgcn_mfma_f32_16x16x32_bf16(kt, rt, RK, 0, 0, 0); }
#pragma unroll
    for (int e = 0; e < 4; ++e) { const int s = 4 * g + e; if (!(s < c16)) { Nm[e] = 0.f; AK[e] = 0.f; } if (!(s <= c16)) { RB[e] = 0.f; RK[e] = 0.f; } }
    *(LAS f32x4*)(NT + c16 * 16 + 4 * g) = Nm; *(LAS f32x4*)(AKT + c16 * 16 + 4 * g) = AK;
    { v4u o; o.x = cvt2(RB[0], RB[1]); o.y = cvt2(RB[2], RB[3]); o.z = cvt2(RK[0], RK[1]); o.w = cvt2(RK[2], RK[3]); __builtin_nontemporal_store(o, (GAS v4u*)(rec + CR_ARK + lane * 16)); }
    float X[16], Gx[16];
#pragma unroll
    for (int t = 0; t < 16; ++t) { float xa = Ah[t], xg = AKT[t * 16 + c16];
#pragma unroll
        for (int q = 0; q < (t + 3) / 4; ++q) { const f32x4 n4 = *(const LAS f32x4*)(NT + t * 16 + 4 * q);
#pragma unroll
            for (int e = 0; e < 4; ++e) if (4 * q + e < t) { xa += n4[e] * X[4 * q + e]; xg += n4[e] * Gx[4 * q + e]; } }
        X[t] = xa; Gx[t] = xg; }
#pragma unroll
    for (int t = 0; t < 16; t += 2) { const unsigned x2 = cvt2(X[t], X[t + 1]); M[t * 72 + lane] = (bf16)x2; M[(t + 1) * 72 + lane] = (bf16)(x2 >> 16); }
#pragma unroll
    for (int t = 0; t < 16; ++t) XGT[t * 16 + c16] = Gx[t];
#pragma unroll
    for (int s = 0; s < 2; ++s) { const int o = c16 * 72 + 32 * s + 4 * g;
        const v2u a0_ = __builtin_bit_cast(v2u, *(const LAS bfx4*)(M + o)), a1_ = __builtin_bit_cast(v2u, *(const LAS bfx4*)(M + o + 16)), r0_ = __builtin_bit_cast(v2u, *(const LAS bfx4*)(M + 1152 + o)), r1_ = __builtin_bit_cast(v2u, *(const LAS bfx4*)(M + 1152 + o + 16));
        __builtin_nontemporal_store((v4u){a0_.x, a0_.y, a1_.x, a1_.y}, (GAS v4u*)(rec + CR_AT + s * 1024 + lane * 16)); __builtin_nontemporal_store((v4u){r0_.x, r0_.y, r1_.x, r1_.y}, (GAS v4u*)(rec + CR_RT + s * 1024 + lane * 16)); }
    { const f32x4 xg = *(const LAS f32x4*)(XGT + c16 * 16 + 4 * g); v2u o; o.x = cvt2(xg[0], xg[1]); o.y = cvt2(xg[2], xg[3]); __builtin_nontemporal_store(o, (GAS v2u*)(rec + CR_GT + lane * 8)); }
    *(GAS float*)(rec + CR_W15 + lane * 4) = wex;
#pragma unroll
    for (int q = 0; q < 4; ++q) {
        __builtin_nontemporal_store((v4u){Bp[2 * q], Bp[2 * q + 1], Kq[2 * q], Kq[2 * q + 1]}, (GAS v4u*)(rec + CR_BK + g * 1024 + (c16 + 16 * q) * 16));
        __builtin_nontemporal_store((v2u){Vq[2 * q], Vq[2 * q + 1]}, (GAS v2u*)(rec + CR_VT + g * 512 + (c16 + 16 * q) * 8)); }
}
__device__ __forceinline__ void rwkv_chunk_rec(Frame& F, int L, int b, int h) {
    const int lane = F.lane, c16 = lane & 15, g = lane >> 4, w = F.wave;
    const GAS unsigned char* recs = F.ws + WS_OV + OV_CR + (size_t)(b * NH + h) * CH_N * CR_BYTES;
    LAS unsigned char* ring = F.lds + RING_OFF;
    constexpr int DIST = 6, NSLOT = 8;
    __syncthreads();
    if (w >= 4) {
        const int p0 = (w - 4) * 3;
#define CR_ISSUE(cc) do { const GAS unsigned char* gs_ = recs + (size_t)(cc) * CR_BYTES + p0 * 1024 + lane * 16; LAS unsigned char* ld_ = ring + ((cc) % NSLOT) * CR_BYTES + p0 * 1024; \
        _Pragma("unroll") for (int i_ = 0; i_ < 3; ++i_) __builtin_amdgcn_global_load_lds((const GAS unsigned*)(gs_ + i_ * 1024), (LAS unsigned*)(ld_ + i_ * 1024), 16, 0, 2); } while (0)
        for (int cc = 0; cc < DIST; ++cc) CR_ISSUE(cc);
        for (int c = 0; c < CH_N; ++c) {
            if (c + DIST < CH_N) { CR_ISSUE(c + DIST); asm volatile("s_waitcnt vmcnt(18)" ::: "memory"); } else asm volatile("s_waitcnt vmcnt(0)" ::: "memory");
            __builtin_amdgcn_s_barrier();
        }
#undef CR_ISSUE
    } else {
        f32x4 ST[4];
#pragma unroll
        for (int n = 0; n < 4; ++n) ST[n] = (f32x4){0.f, 0.f, 0.f, 0.f};
        v4u SB0 = {0u, 0u, 0u, 0u}, SB1 = SB0;
        GAS float* O = (GAS float*)(F.ws + WS_OV + OV_O) + h * HD + 16 * w + c16;
        for (int c = 0; c < CH_N; ++c) {
            __builtin_amdgcn_s_barrier(); asm volatile("" ::: "memory");
            const LAS unsigned char* sl = ring + (c % NSLOT) * CR_BYTES;
            const bfx8 AT0 = *(const LAS bfx8*)(sl + CR_AT + lane * 16), AT1 = *(const LAS bfx8*)(sl + CR_AT + 1024 + lane * 16), RT0 = *(const LAS bfx8*)(sl + CR_RT + lane * 16), RT1 = *(const LAS bfx8*)(sl + CR_RT + 1024 + lane * 16);
            const bfx8 ARK = *(const LAS bfx8*)(sl + CR_ARK + lane * 16);
            bfx8 BK[4]; f32x4 W15[4];
#pragma unroll
            for (int n = 0; n < 4; ++n) { BK[n] = *(const LAS bfx8*)(sl + CR_BK + n * 1024 + lane * 16); W15[n] = *(const LAS f32x4*)(sl + CR_W15 + (16 * n + 4 * g) * 4); }
            const v2u VT = *(const LAS v2u*)(sl + CR_VT + w * 512 + lane * 8), GT = *(const LAS v2u*)(sl + CR_GT + lane * 8);
            const bfx8 sb0 = __builtin_bit_cast(bfx8, SB0), sb1 = __builtin_bit_cast(bfx8, SB1);
            f32x4 Z = {0.f, 0.f, 0.f, 0.f}, OT = Z;
            Z = __builtin_amdgcn_mfma_f32_16x16x32_bf16(AT0, sb0, Z, 0, 0, 0); Z = __builtin_amdgcn_mfma_f32_16x16x32_bf16(AT1, sb1, Z, 0, 0, 0);
            Z = __builtin_amdgcn_mfma_f32_16x16x16bf16_1k(__builtin_bit_cast(bfx4, GT), __builtin_bit_cast(bfx4, VT), Z, 0, 0, 0);
            OT = __builtin_amdgcn_mfma_f32_16x16x32_bf16(RT0, sb0, OT, 0, 0, 0); OT = __builtin_amdgcn_mfma_f32_16x16x32_bf16(RT1, sb1, OT, 0, 0, 0);
            v4u zv; zv.x = cvt2(Z[0], Z[1]); zv.y = cvt2(Z[2], Z[3]); zv.z = VT.x; zv.w = VT.y;
            const bfx8 zvb = __builtin_bit_cast(bfx8, zv);
            OT = __builtin_amdgcn_mfma_f32_16x16x32_bf16(ARK, zvb, OT, 0, 0, 0);
#pragma unroll
            for (int n = 0; n < 4; ++n) ST[n] = __builtin_amdgcn_mfma_f32_16x16x32_bf16(BK[n], zvb, ST[n], 0, 0, 0) * W15[n];
            SB0.x = cvt2(ST[0][0], ST[0][1]); SB0.y = cvt2(ST[0][2], ST[0][3]); SB0.z = cvt2(ST[1][0], ST[1][1]); SB0.w = cvt2(ST[1][2], ST[1][3]);
            SB1.x = cvt2(ST[2][0], ST[2][1]); SB1.y = cvt2(ST[2][2], ST[2][3]); SB1.z = cvt2(ST[3][0], ST[3][1]); SB1.w = cvt2(ST[3][2], ST[3][3]);
            const int rb = c == 0 ? MR : b * SEQ + (c - 1) * CH_T;
#pragma unroll
            for (int e = 0; e < 4; ++e) __builtin_nontemporal_store(OT[e], O + (size_t)(rb + 4 * g + e) * RW_W);
        }
    }
    __syncthreads();
}
constexpr int CONV_EARLY = 4096;
__device__ __forceinline__ void conv_share(Frame& F, int L, int wg, int nwg, int lo, int hi) {
    LAS unsigned* cscr = (LAS unsigned*)(F.lds + RING_OFF + F.wave * 16384);
    for (int ct = lo + wg * NWAVES + F.wave; ct < hi; ct += nwg * NWAVES) { int m_, it_; if (!tr_decode(L, ct, m_, it_)) break;
        const TrDesc d = tr_desc(F, L, m_); f32x4 cv[16]; tr_tile_load(d, it_, F.lane, cv); tr_tile_finish(d, it_, F.lane, cv, cscr); }
}
struct PostIn { f32x4 o; v2u v, g; float rk; };
__device__ __forceinline__ PostIn rwkv_post_load(Frame& F, int row, int hq) {
    const int hl = F.lane >> 4, j = F.lane & 15, h = 4 * hq + hl, C = h * HD + 4 * j; const size_t RC = (size_t)row * RW_W + C;
    PostIn p; p.o = __builtin_nontemporal_load((const GAS f32x4*)((const GAS float*)(F.ws + WS_OV + OV_O) + RC));
    p.v = __builtin_nontemporal_load((const GAS v2u*)((const GAS bf16*)(F.ws + WS_OV + OV_RW) + RC));
    p.g = __builtin_nontemporal_load((const GAS v2u*)((const GAS bf16*)(F.ws + WS_OV + OV_GT) + RC));
    p.rk = ((const GAS float*)(F.ws + WS_OV + OV_RKS))[(size_t)row * NH + h];
    return p;
}
__device__ __forceinline__ f32x4 ub4(const v2u u) { return (f32x4){__uint_as_float(u.x << 16), __uint_as_float(u.x & 0xffff0000u), __uint_as_float(u.y << 16), __uint_as_float(u.y & 0xffff0000u)}; }
__device__ __forceinline__ void rwkv_post_finish(Frame& F, const PostIn& p, int row, int hq, const f32x4 lw, const f32x4 lb) {
    const int hl = F.lane >> 4, j = F.lane & 15, h = 4 * hq + hl, C = h * HD + 4 * j; const size_t RC = (size_t)row * RW_W + C;
    const f32x4 o = p.o;
    const float mean = row16_sum((o[0] + o[1]) + (o[2] + o[3])) * (1.0f / HD); const f32x4 d = o - mean;
    const float var = row16_sum((d[0] * d[0] + d[1] * d[1]) + (d[2] * d[2] + d[3] * d[3])) * (1.0f / HD);
    const float rs = rsqrtf(var + HD * 1e-5f);
    const f32x4 y = (d * rs * lw + lb + p.rk * ub4(p.v)) * ub4(p.g);
    v2u w; w.x = pk2(y[0], y[1]); w.y = pk2(y[2], y[3]);
    *(GAS v2u*)((GAS bf16*)(F.ws + WS_OV + OV_YB) + RC) = w;
}
__device__ __forceinline__ void rwkv_post_all(Frame& F, int L, int gw, int NGW) {
    const int hq = gw & 3;
    const int hl = F.lane >> 4, j = F.lane & 15, C = (4 * hq + hl) * HD + 4 * j; const size_t LC = (size_t)L * RW_W + C;
    const f32x4 lw = *(const GAS f32x4*)(inp(F, I_LNW) + LC), lb = *(const GAS f32x4*)(inp(F, I_LNB) + LC);
    constexpr int NT = MROWS * 4;
    for (int t = gw; t < NT; t += 4 * NGW) {
        PostIn p[4];
#pragma unroll
        for (int i = 0; i < 4; ++i) { const int ti = t + i * NGW; p[i] = rwkv_post_load(F, (ti < NT ? ti : t) >> 2, hq); }
#pragma unroll
        for (int i = 0; i < 4; ++i) { const int ti = t + i * NGW; if (ti < NT) rwkv_post_finish(F, p[i], ti >> 2, hq, lw, lb); }
    }
}
__device__ __forceinline__ void final_norm(Frame& F, GAS float* out) {
    const int gw = F.vcu * NWAVES + F.wave, NGW = F.G * NWAVES; const GAS float* gn = inp(F, I_FINN);
    for (int m = gw; m < MR; m += NGW) {
        f32x4 v[8]; float s = 0.f;
#pragma unroll
        for (int j = 0; j < 4; ++j) { pg8::unpackh8(((const GAS v4u*)(FX16(F) + (size_t)m * DM))[F.lane + 64 * j], v[2 * j], v[2 * j + 1]);
            s += ((v[2 * j][0] * v[2 * j][0] + v[2 * j][1] * v[2 * j][1]) + (v[2 * j][2] * v[2 * j][2] + v[2 * j][3] * v[2 * j][3])) + ((v[2 * j + 1][0] * v[2 * j + 1][0] + v[2 * j + 1][1] * v[2 * j + 1][1]) + (v[2 * j + 1][2] * v[2 * j + 1][2] + v[2 * j + 1][3] * v[2 * j + 1][3])); }
        const float inv = rsqrtf(wave_sum(s) * (1.0f / DM) + NORM_EPS);
#pragma unroll
        for (int j = 0; j < 4; ++j) { const int c8 = 8 * (F.lane + 64 * j);
            ((GAS f32x4*)(out + (size_t)m * DM + c8))[0] = v[2 * j] * inv * ((const GAS f32x4*)(gn + c8))[0]; ((GAS f32x4*)(out + (size_t)m * DM + c8))[1] = v[2 * j + 1] * inv * ((const GAS f32x4*)(gn + c8))[1]; }
    }
}
constexpr int INVTAB_OFF = LDSCTL_OFF + 4096;
__device__ __forceinline__ const LAS float* fill_inv_table(Frame& F, const GAS unsigned long long* ss, int G, int c) {
    if (G != 256) return nullptr;
    LAS float* tab = (LAS float*)(F.lds + INVTAB_OFF); const int base = 8 * (c & 7) * 256;
#pragma unroll
    for (int i = 0; i < 4; ++i) { const int r = F.tid + 512 * i; tab[r] = rsqrtf((float)(long long)ss[base + r] * (pg8::SS_INV_SCALE / (float)DM) + 1e-6f); }
    __syncthreads();
    return tab;
}
constexpr int NPH = 14;
struct Args { const float* in[N_IN]; float* out; unsigned char* ws; int l_lo, l_hi, ph_lo, ph_hi; };
__global__ void __launch_bounds__(NWAVES * 64, 2) mk_fwd(Args args) {
    extern __shared__ __attribute__((aligned(16))) unsigned char lds[];
    Frame F;
    F.lds = (LAS unsigned char*)lds;
    F.MISC = (volatile LAS unsigned*)(F.lds + MISC_OFF);
    F.tid = threadIdx.x; F.lane = F.tid & 63; F.wave = __builtin_amdgcn_readfirstlane(F.tid >> 6);
    F.G = gridDim.x; { const int bx = blockIdx.x; F.vcu = (F.G % 8 == 0) ? (bx % 8) * (F.G / 8) + bx / 8 : bx; }
    F.ws = (GAS unsigned char*)args.ws;
    F.ctl = (gu32*)(args.ws + WS_CTL);
    for (int u = F.tid; u < (LDS_BYTES - LDSCTL_OFF) / 4; u += NWAVES * 64) ((LAS unsigned*)(F.lds + LDSCTL_OFF))[u] = 0u;
    __syncthreads();
    if (F.tid < N_IN) ((LAS unsigned long long*)(F.lds + LDSCTL_OFF))[F.tid] = (unsigned long long)args.in[F.tid];
    __syncthreads();
    XcdBarrier bar; bar.bar = (unsigned*)(F.ctl + CW_BAR); bar.x = 0; bar.st = nullptr;
    if (!MK_MULTI) bar = xcd_barrier_post((unsigned*)(F.ctl + CW_BAR), F.MISC + 8);
#define GRID_BAR() do { if (MK_MULTI) { if (F.tid == 0) __hip_atomic_store(F.ctl + CW_TMO, 0xBADBA0u, RLX_AGENT); } else { xcd_barrier(bar); } } while (0)
    const int lo = args.ph_lo, hi = args.ph_hi;
#ifndef PH_MASK
#define PH_MASK 0x3FFF
#endif
#define IN(k) ((((PH_MASK) >> (k)) & 1) && lo <= (k) && (k) < hi)
#define BOTH(k) (IN(k) && IN((k) + 1))
#ifndef REPEAT_MASK
#define REPEAT_MASK 0
#endif
#define PHASE(k) for (int rep_ = (IN(k) ? 1 + (((REPEAT_MASK) >> (k)) & 1) : 0); rep_ > 0; --rep_)
    const int wave0_ = __builtin_amdgcn_readfirstlane((int)threadIdx.x >> 6);
#define PH_ENV() int lane_; asm volatile("v_mbcnt_lo_u32_b32 %0, -1, 0\n\tv_mbcnt_hi_u32_b32 %0, -1, %0" : "=v"(lane_));     \
    unsigned char* wsl_ = args.ws; int bx_ = (int)blockIdx.x, tid_ = (wave0_ << 6) | lane_, G_ = (int)gridDim.x, Lp = L; asm volatile("" : "+s"(wsl_), "+s"(bx_), "+s"(G_), "+s"(Lp), "+v"(tid_)); GAS unsigned char* wsl = (GAS unsigned char*)wsl_; \
    F.ws = wsl; F.tid = tid_; F.lane = tid_ & 63; F.wave = __builtin_amdgcn_readfirstlane(tid_ >> 6); F.G = G_; F.vcu = (G_ % 8 == 0) ? (bx_ % 8) * (G_ / 8) + bx_ / 8 : bx_; \
    GAS unsigned char* ov = wsl + WS_OV; GAS unsigned char* wb = wsl + WS_W + (size_t)(Lp & 1) * W_SLOT; (void)ov; (void)wb; \
    const int gw = F.vcu * NWAVES + F.wave, NGW = F.G * NWAVES; (void)gw; (void)NGW;

    for (int L = args.l_lo; L < args.l_hi; ++L) {
        PHASE(0) { PH_ENV();
            if (Lp == 0 || G_ != 256) {
                if (Lp == 0) px_init(F);
                s5_build(F, Lp); lora_weights(F, Lp); pw_zero_rows(F, Lp);
                if (Lp == 0) { __syncthreads(); conv_share(F, 0, bx_, G_, 0, 1 << 30); }
                if (BOTH(0)) GRID_BAR(); } }
        PHASE(1) { PH_ENV();
            pg8::Gemm g{FXB(F), (const GAS bf16*)(wb + WO_GU1), MR, 2 * DFF, DM}; pg8::StaticOrder S; S.init(MR, 2 * DFF, G_, bx_);
            pg8::EpiSwiglu E{FSSC(F), (GAS bf16*)(ov + OV_ACT), DFF, fill_inv_table(F, FSSC(F), G_, bx_)};
            pg8::gemm_phase<pg8::EpiSwiglu, pg8::StaticOrder, true, true>(F.lds + RING_OFF, g, S, E, tid_); pg8::thin_gemm(F.lds + RING_OFF, g, E, G_, bx_, MR, tid_);
            if (BOTH(1)) GRID_BAR();
        }
        PHASE(2) { PH_ENV();
            pg8::Gemm g{(const GAS bf16*)(ov + OV_ACT), (const GAS bf16*)(wb + WO_D1), MR, DM, DFF}; pg8::StaticOrder S; S.init(MR, DM, G_, bx_);
            pg8::EpiResid E{FX16(F), FXB(F), FSSA(F), ((REPEAT_MASK & 4) && rep_ == 2) ? 0.0f : 0.5f, ((REPEAT_MASK & 4) && rep_ == 2) ? 1 : 0};
            pg8::gemm_phase<pg8::EpiResid, pg8::StaticOrder, true, true>(F.lds + RING_OFF, g, S, E, tid_); pg8::thin_gemm(F.lds + RING_OFF, g, E, G_, bx_, MR, tid_);
            if (BOTH(2)) GRID_BAR();
        }
        PHASE(3) { PH_ENV();
            pg8::Gemm g{FXB(F), (const GAS bf16*)(wb + WO_IN), MR, NIN, DM}; pg8::StaticOrder S; S.init(MR, NIN, G_, bx_);
            typedef pg8::EpiWin<OV_U2, OV_RKV, OV_GA, OV_GB, OV_LIN, MP> EpiW; EpiW E{FSSA(F), ov, fill_inv_table(F, FSSA(F), G_, bx_)};
            pg8::gemm_phase<EpiW, pg8::StaticOrder, true, true>(F.lds + RING_OFF, g, S, E, tid_); pg8::thin_gemm(F.lds + RING_OFF, g, E, G_, bx_, MR, tid_);
            if (Lp + 1 < DEPTH && G_ == 256 && bx_ >= 128) { const int vs = F.vcu, gs = F.G; F.vcu = bx_ - 128; F.G = 128; s5_build(F, Lp + 1); lora_weights(F, Lp + 1); pw_zero_rows(F, Lp + 1); F.vcu = vs; F.G = gs;
                __syncthreads(); conv_share(F, Lp + 1, bx_ - 128, 128, 0, CONV_EARLY); }
            if (BOTH(3)) GRID_BAR();
        }
        PHASE(4) { PH_ENV();
            { unsigned zlo = 0u; asm volatile("" : "+v"(zlo)); const unsigned long long z64 = zlo;
              for (int i = bx_ * (NWAVES * 64) + F.tid; i < MP; i += F.G * NWAVES * 64) { FSSA(F)[i] = z64; FSSB(F)[i] = z64; FSSC(F)[i] = z64; } }
            for (int u = F.vcu; u < BATCH * NG; u += F.G) s5_unit(F, Lp, u >> 6, u & 63);
            lora_inputs(F, Lp);
            if (BOTH(4)) GRID_BAR();
        }
        PHASE(5) { PH_ENV();
            { int KL = LKP; asm volatile("" : "+s"(KL));
              pg8::Gemm g{(const GAS bf16*)(ov + OV_LA), (const GAS bf16*)(wb + WO_LORA) + (size_t)2048 * LKP, MR, 1024, KL}; pg8::StaticOrder S; S.init(MR, 1024, G_, bx_);
              typedef pg8::EpiLora<OV_GT, OV_GT, OV_GT, OV_GT> EpiL; EpiL E{ov};
              pg8::gemm_phase<EpiL, pg8::StaticOrder, true, true>(F.lds + RING_OFF, g, S, E, tid_); pg8::thin_gemm(F.lds + RING_OFF, g, E, G_, bx_, MR, tid_); }
        }
        PHASE(6) { PH_ENV();
            { pg8::Gemm g{(const GAS bf16*)(ov + OV_YPRE), (const GAS bf16*)(wb + WO_GLU), MR, SW, SW}; pg8::StaticOrder S; S.init(MR, SW, G_, bx_);
              pg8::EpiGlu E{(const GAS bf16*)(ov + OV_YPRE), (GAS bf16*)(ov + OV_YA), SW};
              pg8::gemm_phase<pg8::EpiGlu, pg8::StaticOrder, true, true>(F.lds + RING_OFF, g, S, E, tid_); pg8::thin_gemm(F.lds + RING_OFF, g, E, G_, bx_, MR, tid_); }
            __syncthreads();
            { const int bh = gw & 63; const LAS float* pp = rwkv_prep_par(F, Lp, bh & 15);
              for (int it = gw; it < BATCH * NH * CH_N; it += NGW) { int bb = bh >> 4, hh = bh & 15; asm volatile("" : "+s"(bb), "+s"(hh));
                  rwkv_prep_item(F, Lp, bb, hh, it >> 6, pp); } }
            if (IN(6) && IN(7)) GRID_BAR();
        }
        PHASE(7) { PH_ENV();
            const int nrec = G_ > 64 ? 64 : G_;
            for (int u = bx_; u < BATCH * NH; u += nrec) { if (bx_ < nrec) rwkv_chunk_rec(F, Lp, u >> 4, u & 15); else break; }
            if (Lp + 1 < DEPTH) { const int lo = G_ == 256 ? CONV_EARLY : 0; if (G_ > 64) { if (bx_ >= 64) conv_share(F, Lp + 1, bx_ - 64, G_ - 64, lo, 1 << 30); } else conv_share(F, Lp + 1, bx_, G_, lo, 1 << 30); }
            else if (G_ > 64 && bx_ >= 64) {
                pg8::Gemm g{(const GAS bf16*)(ov + OV_YA), (const GAS bf16*)(wb + WO_UA), MR, DM, SW}; pg8::StaticOrder S; S.init(MR, DM, G_ - 64, bx_ - 64);
                pg8::EpiGateMul<false> E{(const GAS bf16*)(ov + OV_GA), (GAS bf16*)(ov + OV_MG)};
                pg8::gemm_phase<pg8::EpiGateMul<false>, pg8::StaticOrder, true, true>(F.lds + RING_OFF, g, S, E, tid_); pg8::thin_gemm(F.lds + RING_OFF, g, E, G_ - 64, bx_ - 64, MR, tid_); }
            if (BOTH(7)) GRID_BAR();
        }
        PHASE(8) { PH_ENV();
            rwkv_post_all(F, Lp, gw, NGW);
            if (!(Lp + 1 == DEPTH && G_ > 64))
            { pg8::Gemm g{(const GAS bf16*)(ov + OV_YA), (const GAS bf16*)(wb + WO_UA), MR, DM, SW}; pg8::StaticOrder S; S.init(MR, DM, G_, bx_);
              pg8::EpiGateMul<false> E{(const GAS bf16*)(ov + OV_GA), (GAS bf16*)(ov + OV_MG)};
              pg8::gemm_phase<pg8::EpiGateMul<false>, pg8::StaticOrder, true, true>(F.lds + RING_OFF, g, S, E, tid_); pg8::thin_gemm(F.lds + RING_OFF, g, E, G_, bx_, MR, tid_); }
            if (BOTH(8)) GRID_BAR();
        }
        PHASE(9) { PH_ENV();
            pg8::Gemm g{(const GAS bf16*)(ov + OV_YB), (const GAS bf16*)(wb + WO_UB), MR, DM, RW_W}; pg8::StaticOrder S; S.init(MR, DM, G_, bx_);
            pg8::EpiGateMul<true> E{(const GAS bf16*)(ov + OV_GB), (GAS bf16*)(ov + OV_MG)};
            pg8::gemm_phase<pg8::EpiGateMul<true>, pg8::StaticOrder, true, true>(F.lds + RING_OFF, g, S, E, tid_); pg8::thin_gemm(F.lds + RING_OFF, g, E, G_, bx_, MR, tid_);
            if (BOTH(9)) GRID_BAR();
        }
        PHASE(10) { PH_ENV();
            pg8::Gemm g{(const GAS bf16*)(ov + OV_MG), (const GAS bf16*)(wb + WO_O), MR, DM, DM}; pg8::StaticOrder S; S.init(MR, DM, G_, bx_);
            pg8::EpiResid E{FX16(F), FXB(F), FSSB(F), 1.0f};
            pg8::gemm_phase<pg8::EpiResid, pg8::StaticOrder, true, true>(F.lds + RING_OFF, g, S, E, tid_); pg8::thin_gemm(F.lds + RING_OFF, g, E, G_, bx_, MR, tid_);
            if (BOTH(10)) GRID_BAR();
        }
        PHASE(11) { PH_ENV();
            pg8::Gemm g{FXB(F), (const GAS bf16*)(wb + WO_GU2), MR, 2 * DFF, DM}; pg8::StaticOrder S; S.init(MR, 2 * DFF, G_, bx_);
            pg8::EpiSwiglu E{FSSB(F), (GAS bf16*)(ov + OV_ACT), DFF, fill_inv_table(F, FSSB(F), G_, bx_)};
            pg8::gemm_phase<pg8::EpiSwiglu, pg8::StaticOrder, true, true>(F.lds + RING_OFF, g, S, E, tid_); pg8::thin_gemm(F.lds + RING_OFF, g, E, G_, bx_, MR, tid_);
            if (BOTH(11)) GRID_BAR();
        }
        PHASE(12) { PH_ENV();
            pg8::Gemm g{(const GAS bf16*)(ov + OV_ACT), (const GAS bf16*)(wb + WO_D2), MR, DM, DFF}; pg8::StaticOrder S; S.init(MR, DM, G_, bx_);
            pg8::EpiResid E{FX16(F), FXB(F), FSSC(F), 0.5f};
            pg8::gemm_phase<pg8::EpiResid, pg8::StaticOrder, true, true>(F.lds + RING_OFF, g, S, E, tid_); pg8::thin_gemm(F.lds + RING_OFF, g, E, G_, bx_, MR, tid_);
            if (IN(13) || L + 1 < args.l_hi) GRID_BAR();
        }
        if (IN(13) && L == DEPTH - 1) { PH_ENV(); final_norm(F, (GAS float*)args.out); }
    }
#undef IN
#undef BOTH
}

extern "C" void kernel_launch(void* const* d_in, const int* in_sizes, int n_in, void* d_out, int out_size, void* d_ws, size_t ws_size, hipStream_t stream) {
    static int grid = 0;
    if (grid == 0) {
        if (n_in != N_IN || in_sizes[0] != MR * DM || out_size != MR * DM || ws_size < WS_END) {
            fprintf(stderr, "kernel_launch: built for %d inputs, x/out of %d floats, >= %zu bytes of workspace; got n_in %d, in0 %d, out %d, ws %zu; nothing launched\n", (int)N_IN, MR * DM, (size_t)WS_END, n_in, n_in > 0 ? in_sizes[0] : -1, out_size, ws_size);
            grid = -1; return; }
        int dev = 0, cus = 0, per_cu = 0;
        if (hipGetDevice(&dev) != hipSuccess || hipDeviceGetAttribute(&cus, hipDeviceAttributeMultiprocessorCount, dev) != hipSuccess) { fprintf(stderr, "kernel_launch: device query failed\n"); grid = -1; return; }
        if (hipFuncSetAttribute((const void*)mk_fwd, hipFuncAttributeMaxDynamicSharedMemorySize, LDS_BYTES) != hipSuccess) { fprintf(stderr, "kernel_launch: hipFuncSetAttribute failed\n"); grid = -1; return; }
        if (hipOccupancyMaxActiveBlocksPerMultiprocessor(&per_cu, (const void*)mk_fwd, NWAVES * 64, LDS_BYTES) != hipSuccess || per_cu < 1)
            fprintf(stderr, "kernel_launch: note: occupancy query reports %d workgroups per CU\n", per_cu);
        (void)hipGetLastError();
        grid = cus;
    }
    if (grid < 0) return;
    if (hipMemsetAsync((char*)d_ws + WS_CTL, 0, CTL_ZERO_BYTES, stream) != hipSuccess) { fprintf(stderr, "kernel_launch: memset failed\n"); return; }
    Args a{};
    for (int i = 0; i < N_IN; ++i) a.in[i] = (const float*)d_in[i];
    a.out = (float*)d_out; a.ws = (unsigned char*)d_ws;
#if MK_MULTI
    for (int L = 0; L < DEPTH; ++L) for (int p = 0; p < NPH; ++p) { if (p == NPH - 1 && L != DEPTH - 1) continue; a.l_lo = L; a.l_hi = L + 1; a.ph_lo = p; a.ph_hi = p + 1;
        hipLaunchKernelGGL(mk_fwd, dim3(grid), dim3(NWAVES * 64), LDS_BYTES, stream, a); }
#else
    a.l_lo = 0; a.l_hi = DEPTH; a.ph_lo = 0; a.ph_hi = NPH;
    hipLaunchKernelGGL(mk_fwd, dim3(grid), dim3(NWAVES * 64), LDS_BYTES, stream, a);
#endif
    const hipError_t le = hipPeekAtLastError();
    if (le != hipSuccess) fprintf(stderr, "kernel_launch: launch failed: %s\n", hipGetErrorName(le));
}
```

```cpp
#include <hip/hip_runtime.h>
#include <cstdio>
#include <cstdint>
namespace pg8 {
#define PG8_LAS __attribute__((address_space(3)))
#define PG8_GAS __attribute__((address_space(1)))
typedef unsigned short bf16_t;
typedef short bf16x8 __attribute__((ext_vector_type(8)));
typedef _Float16 f16x8 __attribute__((ext_vector_type(8)));
typedef float f32x4 __attribute__((ext_vector_type(4)));
typedef unsigned u32x4 __attribute__((ext_vector_type(4)));
constexpr int BM = 256, BK = 64, HALF = 128, HTB = HALF * BK * 2  , STAGE_BYTES = 8 * HTB, NXCD = 8, WGM = 8;

__host__ __device__ __forceinline__ int lds_byte(int r, int c) { const int st = (r >> 4) * 2 + (c >> 5), rr = r & 15, cc = c & 31, ob = rr * 64 + cc * 2; return st * 1024 + (ob ^ (((ob >> 9) & 1) << 5)); }
__host__ __device__ __forceinline__ void stage_rc(int b, int& R, int& C) { const int st = b / 1024, sb = b % 1024, swz = sb ^ (((sb >> 9) & 1) << 5); R = (st >> 1) * 16 + swz / 64; C = (st & 1) * 32 + (swz % 64) / 2; }
__host__ __device__ __forceinline__ int perm32(int rho) { const int n = rho >> 4, i = rho & 15; return 8 * (i >> 2) + 4 * n + (i & 3); }

struct Unit { int pm, pn; };
struct Gemm { const PG8_GAS bf16_t* A; const PG8_GAS bf16_t* Bt; int M, N, K; };

struct StaticOrder {
    int nM, nN, nwg, G, c;
    __host__ __device__ void init(int M, int N, int G_, int c_) { nM = M / BM; nN = N / BM; nwg = nM * nN; G = G_; c = c_; }
    __host__ __device__ bool next(int i, Unit& u) const {
        const long L = (long)i * G + c; if (L >= nwg) return false;
        int wgid = (int)L; { const int q = nwg / NXCD, r = nwg % NXCD, xcd = wgid % NXCD, off = wgid / NXCD; wgid = (xcd < r ? xcd * (q + 1) : r * (q + 1) + (xcd - r) * q) + off; }
        const int nig = WGM * nN, gid = wgid / nig, fm = gid * WGM, gsz = (nM - fm) < WGM ? (nM - fm) : WGM;
        u.pm = fm + ((wgid % nig) % gsz); u.pn = (wgid % nig) / gsz;
#if defined(__HIP_DEVICE_COMPILE__)
        u.pm = __builtin_amdgcn_readfirstlane(u.pm); u.pn = __builtin_amdgcn_readfirstlane(u.pn);
#endif
        return true;
    }
    __device__ __forceinline__ void a_ready(const Unit&) const {}
    __device__ __forceinline__ void done(const Unit&) const {}
};

__device__ __forceinline__ unsigned cvt_pk_bf16(float lo, float hi) { unsigned r; asm volatile("v_cvt_pk_bf16_f32 %0, %1, %2" : "=v"(r) : "v"(lo), "v"(hi)); return r; }
typedef float f32x2 __attribute__((ext_vector_type(2)));
__device__ __forceinline__ f32x2 gelu_pk(f32x2 v) {
    const f32x2 av = __builtin_elementwise_abs(v), d = av * 0.2316418882f + 1.0f;
    f32x2 t; t.x = __builtin_amdgcn_rcpf(d.x); t.y = __builtin_amdgcn_rcpf(d.y);
    f32x2 q = t * 0.5307027145f + (-0.7265760135f); q = q * t + 0.7107068705f; q = q * t + (-0.142248368f); q = q * t + 0.127414796f; q = q * t;
    const f32x2 s = (v * v) * (-0.72134752044f);
    f32x2 e; e.x = __builtin_amdgcn_exp2f(s.x); e.y = __builtin_amdgcn_exp2f(s.y);
    const f32x2 m = v * (q * e), r = v - m;
    f32x2 o; o.x = v.x < 0.f ? m.x : r.x; o.y = v.y < 0.f ? m.y : r.y; return o;
}

template <int ACT  > struct EpiBf16 {
    static constexpr bool PERM = true, AFTER_DRAIN = false; static_assert(ACT == 0 || ACT == 1, "EpiBf16: ACT is 0 (none) or 1 (gelu_pk)");
    bf16_t* O; int ldc; const float* bias; int split_cols; size_t split_stride; float scale0;
    __device__ __forceinline__ void operator()(const f32x4 (&acc)[2][2][4][2], const Unit& u, int wr, int wc, int fr, int fq) const {
        const int row0 = u.pm * BM + wr * 64 + fr; int colt = u.pn * BM; bf16_t* base = O;
        float sc = 1.f; if (split_cols) { const int t = colt / split_cols; base += (size_t)t * split_stride; colt -= t * split_cols; if (t == 0) sc = scale0; }
        const int col0 = colt + wc * 32 + 8 * fq, bcol0 = u.pn * BM + wc * 32 + 8 * fq;
        f32x4 bv[2][2];
#pragma unroll
        for (int bj = 0; bj < 2; ++bj)
#pragma unroll
            for (int n = 0; n < 2; ++n) bv[bj][n] = bias ? *(const f32x4*)(bias + bcol0 + bj * HALF + 4 * n) : (f32x4){0.f, 0.f, 0.f, 0.f};
#pragma unroll
        for (int ai = 0; ai < 2; ++ai)
#pragma unroll
            for (int m = 0; m < 4; ++m) { bf16_t* rowp = base + (size_t)(row0 + ai * HALF + m * 16) * ldc + col0;
#pragma unroll
                for (int bj = 0; bj < 2; ++bj) { f32x4 v0 = acc[ai][bj][m][0] + bv[bj][0], v1 = acc[ai][bj][m][1] + bv[bj][1];
                    if (ACT == 1) { f32x2 a = gelu_pk((f32x2){v0[0], v0[1]}), b = gelu_pk((f32x2){v0[2], v0[3]}), c = gelu_pk((f32x2){v1[0], v1[1]}), d = gelu_pk((f32x2){v1[2], v1[3]});
                        v0 = (f32x4){a.x, a.y, b.x, b.y}; v1 = (f32x4){c.x, c.y, d.x, d.y}; }
                    v0 = v0 * sc; v1 = v1 * sc; u32x4 w; w.x = cvt_pk_bf16(v0[0], v0[1]); w.y = cvt_pk_bf16(v0[2], v0[3]); w.z = cvt_pk_bf16(v1[0], v1[1]); w.w = cvt_pk_bf16(v1[2], v1[3]);
                    *(u32x4*)(rowp + bj * HALF) = w; } }
    }
};


template <class Epi, class Sched, bool ALIGN_EPI = false, bool SP2 = false, bool F16 = false>
__device__ __forceinline__ void gemm_phase(PG8_LAS unsigned char* lds, const Gemm g, const Sched& S, const Epi& E, const int tid) {
    const int wid = __builtin_amdgcn_readfirstlane(tid >> 6), lane = tid & 63, wr = wid >> 2, wc = wid & 3, fr = lane & 15, fq = lane >> 4;
    const int K = g.K, nt = K / BK;
    unsigned voffA[2], voffB[2];
#pragma unroll
    for (int i = 0; i < 2; ++i) { int R, C; stage_rc(tid * 16 + i * 8192, R, C); const int Rb = Epi::PERM ? ((R & ~31) + perm32(R & 31)) : R;
        voffA[i] = (unsigned)(R * K + C) * 2u; voffB[i] = (unsigned)(Rb * K + C) * 2u; }
    const size_t kstep = (size_t)(BK * 2);
    const size_t hstep = (size_t)HALF * K * 2;
    const size_t tstep = 2 * hstep;
    const unsigned ldsw = (unsigned)wid * 1024u;
    const int aoff = lds_byte(wr * 64 + fr, fq * 8), boff = lds_byte(wc * 32 + fr, fq * 8);
#define PG8_SA(b, h) (((b) * 2 + (h)) * HTB)
#define PG8_SB(b, h) ((4 + (b) * 2 + (h)) * HTB)
#define PG8_STAGE(bufoff, gbase, voff) do { _Pragma("unroll") for (int _i = 0; _i < 2; ++_i) \
        __builtin_amdgcn_global_load_lds((const PG8_GAS unsigned*)((const PG8_GAS char*)(gbase) + (voff)[_i]), (PG8_LAS unsigned*)(lds + (bufoff) + ldsw + _i * 8192), 16, 0, 0); } while (0)
#define PG8_LDA(dst, b, h) do { _Pragma("unroll") for (int m = 0; m < 4; ++m) _Pragma("unroll") for (int k = 0; k < 2; ++k) dst[m][k] = *(const PG8_LAS bf16x8*)(lds + PG8_SA(b, h) + aoff + m * 2048 + k * 1024); } while (0)
#define PG8_LDB(dst, b, h) do { _Pragma("unroll") for (int n = 0; n < 2; ++n) _Pragma("unroll") for (int k = 0; k < 2; ++k) dst[n][k] = *(const PG8_LAS bf16x8*)(lds + PG8_SB(b, h) + boff + n * 2048 + k * 1024); } while (0)
#define PG8_MMA(ai, bj, At, Bt) do { __builtin_amdgcn_s_setprio(1); _Pragma("unroll") for (int m = 0; m < 4; ++m) _Pragma("unroll") for (int n = 0; n < 2; ++n) _Pragma("unroll") for (int k = 0; k < 2; ++k) \
        acc[ai][bj][m][n] = F16 ? __builtin_amdgcn_mfma_f32_16x16x32_f16(__builtin_bit_cast(f16x8, Bt[n][k]), __builtin_bit_cast(f16x8, At[m][k]), acc[ai][bj][m][n], 0, 0, 0) \
                                : __builtin_amdgcn_mfma_f32_16x16x32_bf16(Bt[n][k], At[m][k], acc[ai][bj][m][n], 0, 0, 0); __builtin_amdgcn_s_setprio(0); } while (0)
#define PG8_WAIT_V(n) asm volatile("s_waitcnt vmcnt(" #n ")" ::: "memory")
#define PG8_WAIT_L(n) asm volatile("s_waitcnt lgkmcnt(" #n ")" ::: "memory")
#define PG8_BAR __builtin_amdgcn_s_barrier()
#define PG8_SCHED __builtin_amdgcn_sched_barrier(0)
    Unit cur, nxt; int ui = 0;
    if (!S.next(0, cur)) return;
    f32x4 acc[2][2][4][2];
#pragma unroll
    for (int a = 0; a < 2; ++a)
#pragma unroll
        for (int b = 0; b < 2; ++b)
#pragma unroll
            for (int m = 0; m < 4; ++m)
#pragma unroll
                for (int n = 0; n < 2; ++n) acc[a][b][m][n] = (f32x4){0.f, 0.f, 0.f, 0.f};
    bf16x8 At[4][2], B0[2][2], B1[2][2];
    const PG8_GAS char* cA = (const PG8_GAS char*)g.A + (size_t)cur.pm * tstep; const PG8_GAS char* cB = (const PG8_GAS char*)g.Bt + (size_t)cur.pn * tstep;
    S.a_ready(cur);
    if constexpr (SP2) {
        PG8_STAGE(PG8_SB(0, 0), cB, voffB); PG8_STAGE(PG8_SB(0, 1), cB + hstep, voffB); PG8_STAGE(PG8_SA(0, 0), cA, voffA); PG8_STAGE(PG8_SA(0, 1), cA + hstep, voffA);
        if (wr == 1) PG8_BAR;
        PG8_WAIT_V(2); PG8_BAR;
        PG8_STAGE(PG8_SB(1, 0), cB + kstep, voffB); PG8_STAGE(PG8_SA(1, 0), cA + kstep, voffA); PG8_STAGE(PG8_SB(1, 1), cB + hstep + kstep, voffB);
        PG8_WAIT_V(6); PG8_BAR;
    } else {
        PG8_STAGE(PG8_SB(0, 0), cB, voffB); PG8_STAGE(PG8_SA(0, 0), cA, voffA); PG8_STAGE(PG8_SB(0, 1), cB + hstep, voffB); PG8_STAGE(PG8_SA(0, 1), cA + hstep, voffA);
        if (wr == 1) PG8_BAR;
        PG8_WAIT_V(4); PG8_BAR;
        PG8_STAGE(PG8_SB(1, 0), cB + kstep, voffB); PG8_STAGE(PG8_SA(1, 0), cA + kstep, voffA); PG8_STAGE(PG8_SB(1, 1), cB + hstep + kstep, voffB);
        PG8_WAIT_V(6); PG8_BAR;
    }
    for (;;) {
        const bool has_next = S.next(ui + 1, nxt);
        const PG8_GAS char* nA = has_next ? (const PG8_GAS char*)g.A + (size_t)nxt.pm * tstep : cA; const PG8_GAS char* nB = has_next ? (const PG8_GAS char*)g.Bt + (size_t)nxt.pn * tstep : cB;
        for (int t = 0; t < nt; t += 2) {
            const bool last = (t == nt - 2);
            const PG8_GAS char* a1 = cA + (size_t)(t + 1) * kstep;
            const PG8_GAS char* a2 = last ? nA : cA + (size_t)(t + 2) * kstep; const PG8_GAS char* b2 = last ? nB : cB + (size_t)(t + 2) * kstep;
            const PG8_GAS char* a3 = a2 + kstep; const PG8_GAS char* b3 = b2 + kstep;
            if (last && has_next) S.a_ready(nxt);
            if constexpr (SP2) {
            PG8_LDB(B0, 0, 0); PG8_LDB(B1, 0, 1); PG8_SCHED; PG8_LDA(At, 0, 0); PG8_STAGE(PG8_SA(1, 1), a1 + hstep, voffA);
            PG8_WAIT_V(8); PG8_WAIT_L(0); PG8_BAR; PG8_MMA(0, 0, At, B0); PG8_MMA(0, 1, At, B1); PG8_BAR; PG8_SCHED;
            PG8_LDA(At, 0, 1); PG8_STAGE(PG8_SB(0, 0), b2, voffB); PG8_STAGE(PG8_SB(0, 1), b2 + hstep, voffB); PG8_STAGE(PG8_SA(0, 0), a2, voffA);
            PG8_WAIT_V(8); PG8_WAIT_L(0); PG8_BAR; PG8_MMA(1, 0, At, B0); PG8_MMA(1, 1, At, B1); PG8_BAR; PG8_SCHED;
            PG8_LDB(B0, 1, 0); PG8_LDB(B1, 1, 1); PG8_SCHED; PG8_LDA(At, 1, 0); PG8_STAGE(PG8_SA(0, 1), a2 + hstep, voffA);
            PG8_WAIT_V(8); PG8_WAIT_L(0); PG8_BAR; PG8_MMA(0, 0, At, B0); PG8_MMA(0, 1, At, B1); PG8_BAR; PG8_SCHED;
            PG8_LDA(At, 1, 1); PG8_STAGE(PG8_SB(1, 0), b3, voffB); PG8_STAGE(PG8_SB(1, 1), b3 + hstep, voffB); PG8_STAGE(PG8_SA(1, 0), a3, voffA);
            PG8_WAIT_V(8); PG8_WAIT_L(0); PG8_BAR; PG8_MMA(1, 0, At, B0); PG8_MMA(1, 1, At, B1); PG8_BAR; PG8_SCHED;
            } else {
            PG8_LDB(B0, 0, 0); PG8_SCHED; PG8_LDA(At, 0, 0); PG8_STAGE(PG8_SA(1, 1), a1 + hstep, voffA);
            PG8_WAIT_L(8); PG8_BAR; PG8_WAIT_L(0); PG8_MMA(0, 0, At, B0); PG8_BAR; PG8_SCHED;
            PG8_LDB(B1, 0, 1); PG8_STAGE(PG8_SB(0, 0), b2, voffB);
            PG8_BAR; PG8_WAIT_L(0); PG8_MMA(0, 1, At, B1); PG8_BAR;
            PG8_LDA(At, 0, 1); PG8_STAGE(PG8_SA(0, 0), a2, voffA);
            PG8_BAR; PG8_WAIT_L(0); PG8_MMA(1, 0, At, B0); PG8_BAR; PG8_SCHED;
            PG8_STAGE(PG8_SB(0, 1), b2 + hstep, voffB);
            PG8_WAIT_V(6); PG8_BAR; PG8_MMA(1, 1, At, B1); PG8_BAR;
            PG8_LDB(B0, 1, 0); PG8_SCHED; PG8_LDA(At, 1, 0); PG8_STAGE(PG8_SA(0, 1), a2 + hstep, voffA);
            PG8_WAIT_L(8); PG8_BAR; PG8_WAIT_L(0); PG8_MMA(0, 0, At, B0); PG8_BAR; PG8_SCHED;
            PG8_LDB(B1, 1, 1); PG8_STAGE(PG8_SB(1, 0), b3, voffB);
            PG8_BAR; PG8_WAIT_L(0); PG8_MMA(0, 1, At, B1); PG8_BAR;
            PG8_LDA(At, 1, 1); PG8_STAGE(PG8_SA(1, 0), a3, voffA);
            PG8_BAR; PG8_WAIT_L(0); PG8_MMA(1, 0, At, B0); PG8_BAR; PG8_SCHED;
            PG8_STAGE(PG8_SB(1, 1), b3 + hstep, voffB);
            PG8_WAIT_V(6); PG8_BAR; PG8_MMA(1, 1, At, B1); PG8_BAR;
            }
        }
        if constexpr (ALIGN_EPI) { if (wr == 0) PG8_BAR; }
        if constexpr (!Epi::AFTER_DRAIN) { E(acc, cur, wr, wc, fr, fq); S.done(cur); }
        if (!has_next) break;
#pragma unroll
        for (int a = 0; a < 2; ++a)
#pragma unroll
            for (int b = 0; b < 2; ++b)
#pragma unroll
                for (int m = 0; m < 4; ++m)
#pragma unroll
                    for (int n = 0; n < 2; ++n) acc[a][b][m][n] = (f32x4){0.f, 0.f, 0.f, 0.f};
        cur = nxt; cA = nA; cB = nB; ++ui;
        if constexpr (ALIGN_EPI) { if (wr == 1) PG8_BAR; }
    }
    PG8_WAIT_V(0);
    if constexpr (!ALIGN_EPI) { if (wr == 0) PG8_BAR; }
    PG8_BAR;
    if constexpr (Epi::AFTER_DRAIN) { E.fused(acc, cur, wr, wc, fr, fq, lds, wid, lane); S.done(cur); }
#undef PG8_SA
#undef PG8_SB
#undef PG8_STAGE
#undef PG8_LDA
#undef PG8_LDB
#undef PG8_MMA
#undef PG8_WAIT_V
#undef PG8_WAIT_L
#undef PG8_BAR
#undef PG8_SCHED
}
}
namespace pg8 {
constexpr int XD = 2048;
#define EPI_FENCE() asm volatile("" ::: "memory")
__device__ __forceinline__ float add_xor_lane(float s, int lane, int mask) { return s + __builtin_bit_cast(float, __builtin_amdgcn_ds_bpermute((lane ^ mask) << 2, __builtin_bit_cast(int, s))); }
__device__ __forceinline__ float sigmoidf_(float x) { return __builtin_amdgcn_rcpf(1.0f + __expf(-x)); }
__device__ __forceinline__ u32x4 pack8(const f32x4 v0, const f32x4 v1) {
    u32x4 w; w.x = cvt_pk_bf16(v0[0], v0[1]); w.y = cvt_pk_bf16(v0[2], v0[3]); w.z = cvt_pk_bf16(v1[0], v1[1]); w.w = cvt_pk_bf16(v1[2], v1[3]); return w;
}
__device__ __forceinline__ void unpack8(const u32x4 w, f32x4& v0, f32x4& v1) {
    v0[0] = __uint_as_float(w.x << 16); v0[1] = __uint_as_float(w.x & 0xffff0000u); v0[2] = __uint_as_float(w.y << 16); v0[3] = __uint_as_float(w.y & 0xffff0000u);
    v1[0] = __uint_as_float(w.z << 16); v1[1] = __uint_as_float(w.z & 0xffff0000u); v1[2] = __uint_as_float(w.w << 16); v1[3] = __uint_as_float(w.w & 0xffff0000u);
}
constexpr float SS_SCALE = 1048576.0f, SS_INV_SCALE = 1.0f / 1048576.0f;
typedef unsigned long long ss_t;
typedef _Float16 f16x2 __attribute__((ext_vector_type(2)));
__device__ __forceinline__ unsigned pkh2(float lo, float hi) { return __builtin_bit_cast(unsigned, (f16x2){(_Float16)lo, (_Float16)hi}); }
__device__ __forceinline__ u32x4 packh8(const f32x4 v0, const f32x4 v1) { u32x4 w; w.x = pkh2(v0[0], v0[1]); w.y = pkh2(v0[2], v0[3]); w.z = pkh2(v1[0], v1[1]); w.w = pkh2(v1[2], v1[3]); return w; }
__device__ __forceinline__ void unpackh2(unsigned w, float& lo, float& hi) { const f16x2 h = __builtin_bit_cast(f16x2, w); lo = (float)h[0]; hi = (float)h[1]; }
__device__ __forceinline__ void unpackh8(const u32x4 w, f32x4& v0, f32x4& v1) { float a, b, c, d, e, f, g, h; unpackh2(w.x, a, b); unpackh2(w.y, c, d); unpackh2(w.z, e, f); unpackh2(w.w, g, h); v0 = (f32x4){a, b, c, d}; v1 = (f32x4){e, f, g, h}; }
__device__ __forceinline__ void row_invs(const PG8_GAS ss_t* ss, int row0, float (&inv)[2][4]) {
    ss_t raw[2][4];
#pragma unroll
    for (int ai = 0; ai < 2; ++ai)
#pragma unroll
        for (int m = 0; m < 4; ++m) raw[ai][m] = ss[row0 + ai * HALF + m * 16];
#pragma unroll
    for (int ai = 0; ai < 2; ++ai)
#pragma unroll
        for (int m = 0; m < 4; ++m) inv[ai][m] = rsqrtf((float)(long long)raw[ai][m] * (SS_INV_SCALE / (float)XD) + 1e-6f);
}

__device__ __forceinline__ void row_invs_lds(const PG8_LAS float* tab, int pm, int r0, float (&inv)[2][4]) {
#pragma unroll
    for (int ai = 0; ai < 2; ++ai)
#pragma unroll
        for (int m = 0; m < 4; ++m) inv[ai][m] = tab[(pm & 7) * BM + r0 + ai * HALF + m * 16];
}
struct EpiSwiglu {
    static constexpr bool PERM = true, AFTER_DRAIN = false;
    const PG8_GAS ss_t* ss; PG8_GAS bf16_t* act; int ldc; const PG8_LAS float* tab;
    __device__ __forceinline__ void operator()(const f32x4 (&acc)[2][2][4][2], const Unit& u, int wr, int wc, int fr, int fq) const {
        const int row0 = u.pm * BM + wr * 64 + fr, col0 = u.pn * HALF + wc * 32 + 8 * fq;
        float inv[2][4]; if (tab) row_invs_lds(tab, u.pm, wr * 64 + fr, inv); else row_invs(ss, row0, inv);
#pragma unroll
        for (int ai = 0; ai < 2; ++ai)
#pragma unroll
            for (int m = 0; m < 4; ++m) {
                const int row = row0 + ai * HALF + m * 16;
                f32x4 h[2];
#pragma unroll
                for (int n = 0; n < 2; ++n) {
                    const f32x4 g = acc[ai][0][m][n] * inv[ai][m], up = acc[ai][1][m][n] * inv[ai][m];
#pragma unroll
                    for (int j = 0; j < 4; ++j) h[n][j] = g[j] * sigmoidf_(g[j]) * up[j];
                }
                *(PG8_GAS u32x4*)(act + (size_t)row * ldc + col0) = pack8(h[0], h[1]);
            }
    }
    static constexpr bool THIN_PAIRED = true;
    __device__ __forceinline__ void thin(int row, int pn, int w, int fq, const f32x4 v0, const f32x4 v1) const {
        typedef unsigned u32x2v __attribute__((ext_vector_type(2)));
        const float inv = rsqrtf((float)(long long)ss[row] * (SS_INV_SCALE / (float)XD) + 1e-6f);
        f32x4 h;
#pragma unroll
        for (int j = 0; j < 4; ++j) { const float g = v0[j] * inv; h[j] = g * sigmoidf_(g) * (v1[j] * inv); }
        u32x2v o; o.x = cvt_pk_bf16(h[0], h[1]); o.y = cvt_pk_bf16(h[2], h[3]);
        *(PG8_GAS u32x2v*)(act + (size_t)row * ldc + pn * HALF + 16 * w + 4 * fq) = o;
    }
};

struct EpiResid {
    static constexpr bool PERM = true, AFTER_DRAIN = false;
    PG8_GAS bf16_t* X16; PG8_GAS bf16_t* XB; PG8_GAS ss_t* ss; float scale; int noss;
    __device__ __forceinline__ void operator()(const f32x4 (&acc)[2][2][4][2], const Unit& u, int wr, int wc, int fr, int fq) const {
        const int row0 = u.pm * BM + wr * 64 + fr, col0 = u.pn * BM + wc * 32 + 8 * fq;
#pragma unroll
        for (int ai = 0; ai < 2; ++ai)
#pragma unroll
            for (int m = 0; m < 4; ++m) {
                const int row = row0 + ai * HALF + m * 16; float s = 0.f;
                u32x4 xo[2];
#pragma unroll
                for (int bj = 0; bj < 2; ++bj) xo[bj] = *(const PG8_GAS u32x4*)(X16 + (size_t)row * XD + col0 + bj * HALF);
#pragma unroll
                for (int bj = 0; bj < 2; ++bj) {
                    f32x4 x0, x1; unpackh8(xo[bj], x0, x1);
                    x0 += acc[ai][bj][m][0] * scale; x1 += acc[ai][bj][m][1] * scale;
                    *(PG8_GAS u32x4*)(X16 + (size_t)row * XD + col0 + bj * HALF) = packh8(x0, x1);
                    *(PG8_GAS u32x4*)(XB + (size_t)row * XD + col0 + bj * HALF) = pack8(x0, x1);
                    s += ((x0[0] * x0[0] + x0[1] * x0[1]) + (x0[2] * x0[2] + x0[3] * x0[3])) + ((x1[0] * x1[0] + x1[1] * x1[1]) + (x1[2] * x1[2] + x1[3] * x1[3]));
                }
                s = add_xor_lane(s, fr + 16 * fq, 16); s = add_xor_lane(s, fr + 16 * fq, 32);
                if (fq == 0 && !noss) __hip_atomic_fetch_add(ss + row, (ss_t)(long long)(s * SS_SCALE + 0.5f), __ATOMIC_RELAXED, __HIP_MEMORY_SCOPE_AGENT);
                if (m & 1) EPI_FENCE();
            }
    }
    static constexpr bool THIN_PAIRED = false;
    __device__ __forceinline__ void thin(int row, int pn, int w, int fq, const f32x4 v0, const f32x4 v1) const {
        typedef unsigned u32x2v __attribute__((ext_vector_type(2)));
        float s = 0.f;
#pragma unroll
        for (int t = 0; t < 2; ++t) { const size_t off = (size_t)row * XD + pn * BM + 32 * w + 16 * t + 4 * fq;
            const u32x2v xo = *(const PG8_GAS u32x2v*)(X16 + off); const f32x4 d = (t ? v1 : v0) * scale;
            float x0, x1, x2, x3; unpackh2(xo.x, x0, x1); unpackh2(xo.y, x2, x3); x0 += d[0]; x1 += d[1]; x2 += d[2]; x3 += d[3];
            u32x2v o; o.x = pkh2(x0, x1); o.y = pkh2(x2, x3); *(PG8_GAS u32x2v*)(X16 + off) = o;
            o.x = cvt_pk_bf16(x0, x1); o.y = cvt_pk_bf16(x2, x3); *(PG8_GAS u32x2v*)(XB + off) = o;
            s += (x0 * x0 + x1 * x1) + (x2 * x2 + x3 * x3); }
        if (!noss) __hip_atomic_fetch_add(ss + row, (ss_t)(long long)(s * SS_SCALE + 0.5f), __ATOMIC_RELAXED, __HIP_MEMORY_SCOPE_AGENT);
    }
};

template <size_t O_U2, size_t O_RKV, size_t O_GA, size_t O_GB, size_t O_LIN, int mp> struct EpiWin {
    static constexpr bool PERM = true, AFTER_DRAIN = false;
    const PG8_GAS ss_t* ss; PG8_GAS unsigned char* ov; const PG8_LAS float* tab;
    __device__ __forceinline__ void operator()(const f32x4 (&acc)[2][2][4][2], const Unit& u, int wr, int wc, int fr, int fq) const {
        PG8_GAS bf16_t* U2 = (PG8_GAS bf16_t*)(ov + O_U2); PG8_GAS bf16_t* RKV = (PG8_GAS bf16_t*)(ov + O_RKV); PG8_GAS bf16_t* GA = (PG8_GAS bf16_t*)(ov + O_GA); PG8_GAS bf16_t* GB = (PG8_GAS bf16_t*)(ov + O_GB); PG8_GAS bf16_t* LIN = (PG8_GAS bf16_t*)(ov + O_LIN);
        const int row0 = u.pm * BM + wr * 64 + fr, cl = wc * 32 + 8 * fq; const int pn = u.pn;
        float inv[2][4]; if (tab) row_invs_lds(tab, u.pm, wr * 64 + fr, inv); else row_invs(ss, row0, inv);
#pragma unroll
        for (int ai = 0; ai < 2; ++ai)
#pragma unroll
            for (int m = 0; m < 4; ++m) {
                const int row = row0 + ai * HALF + m * 16;
#pragma unroll
                for (int bj = 0; bj < 2; ++bj) {
                    f32x4 v0 = acc[ai][bj][m][0] * inv[ai][m], v1 = acc[ai][bj][m][1] * inv[ai][m];
                    const int c = bj * HALF + cl;
                    PG8_GAS bf16_t* dst;
                    if (pn < 4) { const int ch = pn * BM + c, g = ch >> 4; dst = U2 + ((size_t)g * 1040 + (row >> 4)) * 256 + (row & 15) * 16 + (ch & 15); }
                    else if (pn < 16) { const int t = (pn - 4) >> 2; dst = RKV + ((size_t)t * mp + row) * 1024 + ((pn - 4) & 3) * BM + c; }
                    else if (pn < 32) {
#pragma unroll
                        for (int j = 0; j < 4; ++j) { v0[j] = sigmoidf_(v0[j]); v1[j] = sigmoidf_(v1[j]); }
                        dst = (pn < 24 ? GA + (size_t)row * XD + (pn - 16) * BM : GB + (size_t)row * XD + (pn - 24) * BM) + c;
                    } else dst = LIN + (size_t)row * 512 + (pn - 32) * BM + c;
                    __builtin_nontemporal_store(pack8(v0, v1), (PG8_GAS u32x4*)dst);
                }
            }
    }
    static constexpr bool THIN_PAIRED = false;
    __device__ __forceinline__ void thin(int row, int pn, int w, int fq, const f32x4 a0, const f32x4 a1) const {
        typedef unsigned u32x2v __attribute__((ext_vector_type(2)));
        PG8_GAS bf16_t* U2 = (PG8_GAS bf16_t*)(ov + O_U2); PG8_GAS bf16_t* RKV = (PG8_GAS bf16_t*)(ov + O_RKV); PG8_GAS bf16_t* GA = (PG8_GAS bf16_t*)(ov + O_GA); PG8_GAS bf16_t* GB = (PG8_GAS bf16_t*)(ov + O_GB); PG8_GAS bf16_t* LIN = (PG8_GAS bf16_t*)(ov + O_LIN);
        const float inv = rsqrtf((float)(long long)ss[row] * (SS_INV_SCALE / (float)XD) + 1e-6f);
#pragma unroll
        for (int t = 0; t < 2; ++t) { f32x4 v = (t ? a1 : a0) * inv; const int c = 32 * w + 16 * t + 4 * fq;
            PG8_GAS bf16_t* dst;
            if (pn < 4) { const int ch = pn * BM + c, g = ch >> 4; dst = U2 + ((size_t)g * 1040 + (row >> 4)) * 256 + (row & 15) * 16 + (ch & 15); }
            else if (pn < 16) { const int tt = (pn - 4) >> 2; dst = RKV + ((size_t)tt * mp + row) * 1024 + ((pn - 4) & 3) * BM + c; }
            else if (pn < 32) {
#pragma unroll
                for (int j = 0; j < 4; ++j) v[j] = sigmoidf_(v[j]);
                dst = (pn < 24 ? GA + (size_t)row * XD + (pn - 16) * BM : GB + (size_t)row * XD + (pn - 24) * BM) + c;
            } else dst = LIN + (size_t)row * 512 + (pn - 32) * BM + c;
            u32x2v o; o.x = cvt_pk_bf16(v[0], v[1]); o.y = cvt_pk_bf16(v[2], v[3]); *(PG8_GAS u32x2v*)dst = o; }
    }
};

struct EpiGlu {
    static constexpr bool PERM = true, AFTER_DRAIN = false;
    const PG8_GAS bf16_t* aux; PG8_GAS bf16_t* out; int ldc;
    __device__ __forceinline__ void operator()(const f32x4 (&acc)[2][2][4][2], const Unit& u, int wr, int wc, int fr, int fq) const {
        const int row0 = u.pm * BM + wr * 64 + fr, col0 = u.pn * BM + wc * 32 + 8 * fq;
#pragma unroll
        for (int ai = 0; ai < 2; ++ai)
#pragma unroll
            for (int m = 0; m < 4; ++m) {
#pragma unroll
                for (int bj = 0; bj < 2; ++bj) {
                    const size_t off = (size_t)(row0 + ai * HALF + m * 16) * ldc + col0 + bj * HALF;
                    f32x4 a0, a1; unpack8(*(const PG8_GAS u32x4*)(aux + off), a0, a1);
                    f32x4 v0 = acc[ai][bj][m][0], v1 = acc[ai][bj][m][1];
#pragma unroll
                    for (int j = 0; j < 4; ++j) { v0[j] = a0[j] * sigmoidf_(v0[j]); v1[j] = a1[j] * sigmoidf_(v1[j]); }
                    *(PG8_GAS u32x4*)(out + off) = pack8(v0, v1);
                }
                if (m & 1) EPI_FENCE();
            }
    }
    static constexpr bool THIN_PAIRED = false;
    __device__ __forceinline__ void thin(int row, int pn, int w, int fq, const f32x4 a0, const f32x4 a1) const {
        typedef unsigned u32x2v __attribute__((ext_vector_type(2)));
#pragma unroll
        for (int t = 0; t < 2; ++t) { const size_t off = (size_t)row * ldc + pn * BM + 32 * w + 16 * t + 4 * fq; const f32x4 v = t ? a1 : a0;
            const u32x2v x = *(const PG8_GAS u32x2v*)(aux + off);
            const float x0 = __uint_as_float(x.x << 16), x1 = __uint_as_float(x.x & 0xffff0000u), x2 = __uint_as_float(x.y << 16), x3 = __uint_as_float(x.y & 0xffff0000u);
            u32x2v o; o.x = cvt_pk_bf16(x0 * sigmoidf_(v[0]), x1 * sigmoidf_(v[1])); o.y = cvt_pk_bf16(x2 * sigmoidf_(v[2]), x3 * sigmoidf_(v[3])); *(PG8_GAS u32x2v*)(out + off) = o; }
    }
};

template <bool ACCUM> struct EpiGateMul {
    static constexpr bool PERM = true, AFTER_DRAIN = false;
    const PG8_GAS bf16_t* gate; PG8_GAS bf16_t* out;
    __device__ __forceinline__ void operator()(const f32x4 (&acc)[2][2][4][2], const Unit& u, int wr, int wc, int fr, int fq) const {
        const int row0 = u.pm * BM + wr * 64 + fr, col0 = u.pn * BM + wc * 32 + 8 * fq;
#pragma unroll
        for (int ai = 0; ai < 2; ++ai)
#pragma unroll
            for (int m = 0; m < 4; ++m) {
#pragma unroll
                for (int bj = 0; bj < 2; ++bj) {
                    const size_t off = (size_t)(row0 + ai * HALF + m * 16) * XD + col0 + bj * HALF;
                    f32x4 g0, g1; unpack8(__builtin_nontemporal_load((const PG8_GAS u32x4*)(gate + off)), g0, g1);
                    f32x4 v0 = acc[ai][bj][m][0] * g0, v1 = acc[ai][bj][m][1] * g1;
                    if (ACCUM) { f32x4 p0, p1; unpack8(__builtin_nontemporal_load((const PG8_GAS u32x4*)(out + off)), p0, p1); v0 += p0; v1 += p1; }
                    *(PG8_GAS u32x4*)(out + off) = pack8(v0, v1);
                }
                if (m & 1) EPI_FENCE();
            }
    }
    static constexpr bool THIN_PAIRED = false;
    __device__ __forceinline__ void thin(int row, int pn, int w, int fq, const f32x4 a0, const f32x4 a1) const {
        typedef unsigned u32x2v __attribute__((ext_vector_type(2)));
#pragma unroll
        for (int t = 0; t < 2; ++t) { const size_t off = (size_t)row * XD + pn * BM + 32 * w + 16 * t + 4 * fq; const f32x4 v = t ? a1 : a0;
            const u32x2v x = *(const PG8_GAS u32x2v*)(gate + off);
            float r0 = v[0] * __uint_as_float(x.x << 16), r1 = v[1] * __uint_as_float(x.x & 0xffff0000u), r2 = v[2] * __uint_as_float(x.y << 16), r3 = v[3] * __uint_as_float(x.y & 0xffff0000u);
            if (ACCUM) { const u32x2v p = *(const PG8_GAS u32x2v*)(out + off); r0 += __uint_as_float(p.x << 16); r1 += __uint_as_float(p.x & 0xffff0000u); r2 += __uint_as_float(p.y << 16); r3 += __uint_as_float(p.y & 0xffff0000u); }
            u32x2v o; o.x = cvt_pk_bf16(r0, r1); o.y = cvt_pk_bf16(r2, r3); *(PG8_GAS u32x2v*)(out + off) = o; }
    }
};

template <size_t o_a, size_t o_b, size_t o_c, size_t o_d> struct EpiLora {
    static constexpr bool PERM = true, AFTER_DRAIN = false;
    PG8_GAS unsigned char* ov;
    __device__ __forceinline__ void operator()(const f32x4 (&acc)[2][2][4][2], const Unit& u, int wr, int wc, int fr, int fq) const {
        const int row0 = u.pm * BM + wr * 64 + fr, kind = u.pn >> 2, col0 = (u.pn & 3) * BM + wc * 32 + 8 * fq;
        PG8_GAS bf16_t* ob = (PG8_GAS bf16_t*)(ov + (kind == 0 ? o_a : kind == 1 ? o_b : kind == 2 ? o_c : o_d));
#pragma unroll
        for (int ai = 0; ai < 2; ++ai)
#pragma unroll
            for (int m = 0; m < 4; ++m)
#pragma unroll
                for (int bj = 0; bj < 2; ++bj)
                    *(PG8_GAS u32x4*)(ob + (size_t)(row0 + ai * HALF + m * 16) * 1024 + col0 + bj * HALF) = pack8(acc[ai][bj][m][0], acc[ai][bj][m][1]);
    }
    static constexpr bool THIN_PAIRED = false;
    __device__ __forceinline__ void thin(int row, int pn, int w, int fq, const f32x4 a0, const f32x4 a1) const {
        typedef unsigned u32x2v __attribute__((ext_vector_type(2)));
        const int kind = pn >> 2;
        PG8_GAS bf16_t* ob = (PG8_GAS bf16_t*)(ov + (kind == 0 ? o_a : kind == 1 ? o_b : kind == 2 ? o_c : o_d));
#pragma unroll
        for (int t = 0; t < 2; ++t) { const size_t off = (size_t)row * 1024 + (pn & 3) * BM + 32 * w + 16 * t + 4 * fq; const f32x4 v = t ? a1 : a0;
            u32x2v o; o.x = cvt_pk_bf16(v[0], v[1]); o.y = cvt_pk_bf16(v[2], v[3]); *(PG8_GAS u32x2v*)(ob + off) = o; }
    }
};

template <class Epi, bool F16 = false> __device__ __forceinline__ void thin_gemm(PG8_LAS unsigned char* lds, const Gemm g, const Epi& E, int G, int c, int row_base, const int tid) {
    const int w = __builtin_amdgcn_readfirstlane(tid >> 6), lane = tid & 63, fr = lane & 15, fq = lane >> 4, K = g.K, nks = K / 32, nU = g.N / 32;
    PG8_LAS f32x4* P = (PG8_LAS f32x4*)lds;
    for (int u = G - 1 - c; u < nU; u += G) {
        const int pn = u >> 3, wq = u & 7;
        const int r0 = Epi::THIN_PAIRED ? 16 * wq : 32 * wq, r1 = Epi::THIN_PAIRED ? HALF + 16 * wq : 32 * wq + 16;
        const PG8_GAS bf16_t* ap = g.A + (size_t)(row_base + fr) * K + 8 * fq;
        const PG8_GAS bf16_t* b0 = g.Bt + (size_t)(pn * BM + r0 + fr) * K + 8 * fq;
        const PG8_GAS bf16_t* b1 = g.Bt + (size_t)(pn * BM + r1 + fr) * K + 8 * fq;
        f32x4 acc0 = {0.f, 0.f, 0.f, 0.f}, acc1 = {0.f, 0.f, 0.f, 0.f};
        for (int ks = w; ks < nks; ks += 64) {
            bf16x8 av[8], bv0[8], bv1[8];
#pragma unroll
            for (int s = 0; s < 8; ++s) { const int kk = ks + 8 * s; const bool ok = kk < nks; const int ko = ok ? 32 * kk : 0;
                av[s] = *(const PG8_GAS bf16x8*)(ap + ko); bv0[s] = *(const PG8_GAS bf16x8*)(b0 + ko); bv1[s] = *(const PG8_GAS bf16x8*)(b1 + ko);
                if (!ok) av[s] = (bf16x8){0, 0, 0, 0, 0, 0, 0, 0}; }
#pragma unroll
            for (int s = 0; s < 8; ++s) {
                if (F16) { acc0 = __builtin_amdgcn_mfma_f32_16x16x32_f16(__builtin_bit_cast(f16x8, bv0[s]), __builtin_bit_cast(f16x8, av[s]), acc0, 0, 0, 0); acc1 = __builtin_amdgcn_mfma_f32_16x16x32_f16(__builtin_bit_cast(f16x8, bv1[s]), __builtin_bit_cast(f16x8, av[s]), acc1, 0, 0, 0); }
                else { acc0 = __builtin_amdgcn_mfma_f32_16x16x32_bf16(bv0[s], av[s], acc0, 0, 0, 0); acc1 = __builtin_amdgcn_mfma_f32_16x16x32_bf16(bv1[s], av[s], acc1, 0, 0, 0); } }
        }
        P[(w * 2 + 0) * 64 + lane] = acc0; P[(w * 2 + 1) * 64 + lane] = acc1;
        __syncthreads();
        if (w == 0) {
            f32x4 s0 = P[lane], s1 = P[64 + lane];
#pragma unroll
            for (int ww = 1; ww < 8; ++ww) { s0 += P[(ww * 2 + 0) * 64 + lane]; s1 += P[(ww * 2 + 1) * 64 + lane]; }
            E.thin(row_base + fr, pn, wq, fq, s0, s1);
        }
        __syncthreads();
    }
}
}
constexpr int NWAVES = 8;
constexpr int DM = 2048, BATCH = 4, SEQ = 4096, DEPTH = 4, NMETA = 16, DFF = 5632;
constexpr int MR = BATCH * SEQ;
constexpr int MROWS = MR + NMETA;
constexpr int MP = 16640;
constexpr int TSEQ = SEQ + NMETA;
constexpr int SW = 1024, NG = 64, NS = 64, SGC = 16;
constexpr int RW_W = 1024, NH = 16, HD = 64;
constexpr int P_FIRST = 8480, P_REST = 8512, NIN = 8704;
constexpr int U2_CR = 1040;
constexpr float NORM_EPS = 1e-6f;
#ifndef MK_MULTI
#define MK_MULTI 0
#endif
enum In { I_X = 0, I_META, I_F1N, I_F1G, I_F1U, I_F1D, I_MIXN, I_WIN0, I_WINR, I_MUSH, I_MUVR, I_LRE, I_LIM, I_LDT, I_BRE, I_BIM, I_CRE, I_CIM, I_SD, I_WGLU,
          I_W0, I_W2, I_A0, I_A2, I_V0, I_V2, I_G2, I_KK, I_KA, I_RK, I_LNW, I_LNB, I_WUA, I_WUB, I_WO, I_F2N, I_F2G, I_F2U, I_F2D, I_FINN, N_IN };

constexpr size_t MiB = 1u << 20;
constexpr size_t WS_CTL = 0, CTL_ZERO_BYTES = 1 * MiB;
constexpr size_t WS_LPAR = 1 * MiB;
constexpr size_t WS_X = 2 * MiB;
constexpr size_t WS_XB = 132 * MiB;
constexpr size_t WS_SSP = 197 * MiB, SS_STRIDE = 256 * 1024;
constexpr size_t WS_VF = 200 * MiB;
constexpr size_t WS_W = 233 * MiB, W_SLOT = 204 * MiB;
constexpr size_t WO_GU1 = 0, WO_D1 = 44 * MiB, WO_IN = 66 * MiB, WO_GLU = 100 * MiB, WO_UA = 102 * MiB, WO_UB = 106 * MiB, WO_O = 110 * MiB, WO_GU2 = 118 * MiB, WO_D2 = 162 * MiB, WO_S5 = 184 * MiB, WO_LORA = 200 * MiB;
constexpr size_t WS_OV = WS_W + 2 * W_SLOT;
constexpr size_t OV_ACT = 0;
constexpr size_t OV_U2 = 0, OV_RKV = 33 * MiB, OV_LIN = 131 * MiB, OV_GA = 148 * MiB, OV_GB = 213 * MiB, OV_YPRE = 278 * MiB, OV_YA = 311 * MiB, OV_RW = 344 * MiB,
                 OV_O = 729 * MiB, OV_YB = 794 * MiB, OV_GT = 827 * MiB, OV_RKS = 860 * MiB, OV_MG = 862 * MiB, OV_BK = 927 * MiB, OV_END = 930 * MiB;
constexpr size_t OV_LA = OV_RW + 128 * MiB, OV_DEC = OV_RW + 128 * MiB, OV_ICLR = OV_MG, OV_VG = OV_YB;
constexpr int LKP = 384;
constexpr size_t WS_END = WS_OV + OV_END;
static_assert((size_t)MP * DM * 4 == 130 * MiB && (size_t)MP * DFF * 2 <= 179 * MiB && (size_t)MROWS * NH * 6 * HD * 4 <= 385 * MiB, "d_ws map");
constexpr int CW_TMO = 0, CW_CODE = 1, CW_BAR = 4096;

constexpr int RING_OFF = 0, RING_BYTES = 131072;
constexpr int LDSCTL_OFF = RING_BYTES, MISC_OFF = LDSCTL_OFF + 320;
constexpr int LDS_BYTES = 147456;
static_assert(MISC_OFF + 128 <= LDS_BYTES, "LDS map");

#define GAS __attribute__((address_space(1)))
#define LAS __attribute__((address_space(3)))
typedef unsigned short bf16;
typedef unsigned v4u __attribute__((ext_vector_type(4)));
typedef unsigned v2u __attribute__((ext_vector_type(2)));
typedef float f32x4 __attribute__((ext_vector_type(4)));
typedef float f32x2 __attribute__((ext_vector_type(2)));
typedef GAS unsigned gu32;
#define RLX_AGENT __ATOMIC_RELAXED, __HIP_MEMORY_SCOPE_AGENT
#define LDS_WAIT() asm volatile("s_waitcnt lgkmcnt(0)" ::: "memory")
#define VM_WAIT() asm volatile("s_waitcnt vmcnt(0)" ::: "memory")
__device__ __forceinline__ unsigned f2bf(float f) { unsigned u = __builtin_bit_cast(unsigned, f); return (u + 0x7fffu + ((u >> 16) & 1u)) >> 16; }
__device__ __forceinline__ unsigned pk2(float lo, float hi) { return f2bf(lo) | (f2bf(hi) << 16); }
__device__ __forceinline__ float bf2f(bf16 h) { return __uint_as_float((unsigned)h << 16); }
__device__ __forceinline__ float sigm(float x) { return 1.0f / (1.0f + __expf(-x)); }
#define XB_TMO      128
#define XB_XCNT(j)  (256  + 64 * (j))
#define XB_XSUB(j)  (1280 + 64 * (j))
#define XB_XGEN(j)  (2304 + 64 * (j))
#define XB_TOP      3328
#define XB_TOPGEN   3392
#define XCD_BAR_WORDS 3456
#define XB_SPIN_CAP (1u << 18)

__device__ __forceinline__ unsigned xb_ld(unsigned* p)              { return __hip_atomic_load(p, __ATOMIC_RELAXED, __HIP_MEMORY_SCOPE_AGENT); }
__device__ __forceinline__ unsigned xb_add(unsigned* p, unsigned v) { return __hip_atomic_fetch_add(p, v, __ATOMIC_RELAXED, __HIP_MEMORY_SCOPE_AGENT); }
__device__ __forceinline__ unsigned xb_xcc_id() { return (unsigned)__builtin_amdgcn_s_getreg((3 << 11) | 20) & 0xFu; }
#define XB_SPIN(cond, bar) do { unsigned _sp = 0; while (cond) { __builtin_amdgcn_s_sleep(1); \
    if ((++_sp & 255u) == 0u) { if (xb_ld(&(bar)[XB_TMO])) break; if (_sp > XB_SPIN_CAP) { atomicAdd(&(bar)[XB_TMO], 1u); break; } } } } while (0)

struct XcdBarrier {
    unsigned* bar; unsigned x;
    volatile LAS unsigned* st;
};

__device__ __forceinline__ XcdBarrier xcd_barrier_post(unsigned* bar, volatile LAS unsigned* st) {
    XcdBarrier b; b.bar = bar; b.x = xb_xcc_id(); b.st = st;
    if (threadIdx.x == 0) (void)xb_add(&bar[XB_XCNT(b.x)], 1u);
    return b;
}
__device__ __forceinline__ void xcd_barrier_complete(unsigned* bar, unsigned x, unsigned& nloc, unsigned& nx) {
    const unsigned G = gridDim.x * gridDim.y * gridDim.z;
    unsigned sum, cnt, mine, sp = 0u;
    for (;;) {
        sum = 0u; cnt = 0u; mine = 0u;
#pragma unroll
        for (unsigned j = 0; j < 16; ++j) { const unsigned c = xb_ld(&bar[XB_XCNT(j)]); sum += c; cnt += (c > 0u) ? 1u : 0u; mine = (j == x) ? c : mine; }
        if (sum == G) break;
        __builtin_amdgcn_s_sleep(1);
        if ((++sp & 255u) == 0u) { if (xb_ld(&bar[XB_TMO])) break; if (sp > XB_SPIN_CAP) { atomicAdd(&bar[XB_TMO], 1u); break; } }
    }
    nloc = mine > 0u ? mine : 1u; nx = cnt > 0u ? cnt : 1u;
}

__device__ __forceinline__ void xcd_barrier(const XcdBarrier& b) {
    asm volatile("s_waitcnt vmcnt(0)" ::: "memory");
    __syncthreads();
    if (threadIdx.x == 0) {
        unsigned* bar = b.bar;
        __builtin_amdgcn_s_waitcnt(0);
        unsigned nloc = b.st[0], nx = b.st[1];
        if (nloc == 0u) { xcd_barrier_complete(bar, b.x, nloc, nx); b.st[0] = nloc; b.st[1] = nx; }
        const unsigned old = xb_add(&bar[XB_XSUB(b.x)], 1u);
        const unsigned gen = old / nloc;
        if (old + 1u == (gen + 1u) * nloc) {
            __builtin_amdgcn_fence(__ATOMIC_RELEASE, "agent");
            asm volatile("s_waitcnt vmcnt(0)" ::: "memory");
            const unsigned og = xb_add(&bar[XB_TOP], 1u);
            const unsigned tg = og / nx;
            if (og + 1u == (tg + 1u) * nx) xb_add(&bar[XB_TOPGEN], 1u);
            else XB_SPIN(xb_ld(&bar[XB_TOPGEN]) == tg, bar);
            __builtin_amdgcn_fence(__ATOMIC_ACQUIRE, "agent");
            xb_add(&bar[XB_XGEN(b.x)], 1u);
            asm volatile("s_waitcnt vmcnt(0)" ::: "memory");
        } else {
            XB_SPIN(xb_ld(&bar[XB_XGEN(b.x)]) == gen, bar);
            __builtin_amdgcn_fence(__ATOMIC_ACQUIRE, "agent");
            asm volatile("s_waitcnt vmcnt(0)" ::: "memory");
        }
    }
    __syncthreads();
}
struct Frame {
    LAS unsigned char* lds;
    volatile LAS unsigned* MISC;
    gu32* ctl;
    int tid, lane, wave, vcu, G;
    GAS unsigned char* ws;
};
#define FX16(F) ((GAS bf16*)((F).ws + WS_X))
#define FXB(F)  ((GAS bf16*)((F).ws + WS_XB))
#define FVF(F)  ((GAS bf16*)((F).ws + WS_VF))
#define FSSA(F) ((GAS unsigned long long*)((F).ws + WS_SSP))
#define FSSB(F) ((GAS unsigned long long*)((F).ws + WS_SSP + SS_STRIDE))
#define FSSC(F) ((GAS unsigned long long*)((F).ws + WS_SSP + 2 * SS_STRIDE))
__device__ __forceinline__ const GAS float* inp(const Frame& F, int k) {
    const LAS unsigned* t = (const LAS unsigned*)(F.lds + LDSCTL_OFF) + 2 * k;
    const unsigned lo = __builtin_amdgcn_readfirstlane(t[0]), hi = __builtin_amdgcn_readfirstlane(t[1]);
    return (const GAS float*)(((unsigned long long)hi << 32) | lo);
}
__device__ __forceinline__ float row16_sum(float x) {
    x += __builtin_bit_cast(float, __builtin_amdgcn_update_dpp(0, __builtin_bit_cast(int, x), 0xB1, 0xF, 0xF, false));
    x += __builtin_bit_cast(float, __builtin_amdgcn_update_dpp(0, __builtin_bit_cast(int, x), 0x4E, 0xF, 0xF, false));
    x += __builtin_bit_cast(float, __builtin_amdgcn_update_dpp(0, __builtin_bit_cast(int, x), 0x124, 0xF, 0xF, false));
    x += __builtin_bit_cast(float, __builtin_amdgcn_update_dpp(0, __builtin_bit_cast(int, x), 0x128, 0xF, 0xF, false));
    return x;
}
__device__ __forceinline__ float lane_bcast(float x, int j) { return __builtin_bit_cast(float, __builtin_amdgcn_readlane(__builtin_bit_cast(int, x), j)); }
__device__ __forceinline__ float wave_sum(float v) {
    v = row16_sum(v);
    return (lane_bcast(v, 0) + lane_bcast(v, 16)) + (lane_bcast(v, 32) + lane_bcast(v, 48));
}
__device__ __forceinline__ int seq_row(int b, int s) { return s < NMETA ? MR + s : b * SEQ + (s - NMETA); }
__device__ __forceinline__ int prev_row(int row) { if (row >= MR) return row > MR ? row - 1 : -1; return (row & (SEQ - 1)) ? row - 1 : MR + NMETA - 1; }

__device__ __forceinline__ void px_init(Frame& F) {
    const int gw = F.vcu * NWAVES + F.wave, NGW = F.G * NWAVES;
    const GAS float* xin = inp(F, I_X); const GAS float* meta = inp(F, I_META);
    for (int m = gw; m < MP; m += NGW) {
        const GAS float* src = m < MR ? xin + (size_t)m * DM : (m < MROWS ? meta + (size_t)(m - MR) * DM : nullptr);
        f32x4 v[8]; float s = 0.f;
#pragma unroll
        for (int j = 0; j < 8; ++j) { v[j] = src ? __builtin_nontemporal_load((const GAS f32x4*)src + F.lane + 64 * j) : (f32x4){0.f, 0.f, 0.f, 0.f}; s += (v[j][0] * v[j][0] + v[j][1] * v[j][1]) + (v[j][2] * v[j][2] + v[j][3] * v[j][3]); }
        s = wave_sum(s);
#pragma unroll
        for (int j = 0; j < 8; ++j) {
            v2u w; w.x = pg8::pkh2(v[j][0], v[j][1]); w.y = pg8::pkh2(v[j][2], v[j][3]);
            ((GAS v2u*)(FX16(F) + (size_t)m * DM))[F.lane + 64 * j] = w;
            w.x = pk2(v[j][0], v[j][1]); w.y = pk2(v[j][2], v[j][3]);
            ((GAS v2u*)(FXB(F) + (size_t)m * DM))[F.lane + 64 * j] = w;
        }
        if (F.lane == 0) { unsigned zlo = 0u; asm volatile("" : "+v"(zlo));
            FSSC(F)[m] = (unsigned long long)(long long)(s * pg8::SS_SCALE + 0.5f); FSSA(F)[m] = (unsigned long long)zlo; }
    }
}
__device__ __forceinline__ int tr_drow(int map, int c0) {
    if (map == 1) return (c0 >> 7) * 256 + (c0 & 127);
    if (map == 2) return (c0 >> 7) * 256 + 128 + (c0 & 127);
    if (map == 3) {
        if (c0 < 4096) return c0; if (c0 < 4384) return 8192 + (c0 - 4096); if (c0 < 8480) return 4096 + (c0 - 4384); return 8192 + 288 + (c0 - 8480); }
    return c0;
}
struct TrDesc { const GAS float* W; GAS bf16* WT; const GAS float* gain; int K, N, map, f16; };
__device__ __forceinline__ int tr_items(const TrDesc& d) { return (d.K / 64) * ((d.N + 63) / 64); }
__device__ __forceinline__ void tr_tile_load(const TrDesc& d, int it, int lane, f32x4 (&v)[16]) {
    const int nbn = (d.N + 63) / 64, kb = it / nbn, nb = it - kb * nbn, k0 = 64 * kb, n0 = 64 * nb, rg = lane >> 4, j = lane & 15;
    const bool nok = n0 + 4 * j < d.N;
#pragma unroll
    for (int i = 0; i < 16; ++i) { const int kk = 8 * (i >> 1) + 2 * rg + (i & 1);
        v[i] = nok ? __builtin_nontemporal_load((const GAS f32x4*)(d.W + (size_t)(k0 + kk) * d.N + n0 + 4 * j)) : (f32x4){0.f, 0.f, 0.f, 0.f}; }
}
__device__ __forceinline__ void tr_tile_finish(const TrDesc& d, int it, int lane, const f32x4 (&v)[16], LAS unsigned* scr) {
    const int nbn = (d.N + 63) / 64, kb = it / nbn, nb = it - kb * nbn, k0 = 64 * kb, n0 = 64 * nb, rg = lane >> 4, j = lane & 15;
#pragma unroll
    for (int i = 0; i < 8; ++i) { const int kk = 8 * i + 2 * rg; float g0 = 1.f, g1 = 1.f; if (d.gain) { g0 = d.gain[k0 + kk]; g1 = d.gain[k0 + kk + 1]; }
#pragma unroll
        for (int e = 0; e < 4; ++e) scr[(4 * j + e) * 36 + (kk >> 1)] = d.f16 ? pg8::pkh2(v[2 * i][e] * g0, v[2 * i + 1][e] * g1) : pk2(v[2 * i][e] * g0, v[2 * i + 1][e] * g1); }
    LDS_WAIT(); asm volatile("" ::: "memory");
    const int c = lane & 7;
#pragma unroll
    for (int i = 0; i < 8; ++i) { const int n = (lane >> 3) + 8 * i;
        const v4u o = *(const LAS v4u*)(scr + n * 36 + 4 * c);
        const int col = n0 + n;
        if (col < d.N) *(GAS v4u*)(d.WT + (size_t)(tr_drow(d.map, col & ~31) + (col & 31)) * d.K + k0 + 8 * c) = o; }
    LDS_WAIT(); asm volatile("" ::: "memory");
}
constexpr int TR_NMAT = 11;
__device__ __forceinline__ TrDesc tr_desc(Frame& F, int L, int m) {
    GAS unsigned char* wb = F.ws + WS_W + (size_t)(L & 1) * W_SLOT; const int P = L == 0 ? P_FIRST : P_REST; TrDesc d;
    switch (m) {
    case 0:  d = TrDesc{inp(F, I_F1G) + (size_t)L * DM * DFF, (GAS bf16*)(wb + WO_GU1), inp(F, I_F1N) + (size_t)L * DM, DM, DFF, 1, 0}; break;
    case 1:  d = TrDesc{inp(F, I_F1U) + (size_t)L * DM * DFF, (GAS bf16*)(wb + WO_GU1), inp(F, I_F1N) + (size_t)L * DM, DM, DFF, 2, 0}; break;
    case 2:  d = TrDesc{inp(F, I_F1D) + (size_t)L * DFF * DM, (GAS bf16*)(wb + WO_D1), nullptr, DFF, DM, 0, 0}; break;
    case 3:  d = TrDesc{L == 0 ? inp(F, I_WIN0) : inp(F, I_WINR) + (size_t)(L - 1) * DM * P_REST, (GAS bf16*)(wb + WO_IN), inp(F, I_MIXN) + (size_t)L * DM, DM, P, 3, 0}; break;
    case 4:  d = TrDesc{inp(F, I_WGLU) + (size_t)L * SW * SW, (GAS bf16*)(wb + WO_GLU), nullptr, SW, SW, 0, 0}; break;
    case 5:  d = TrDesc{inp(F, I_WUA) + (size_t)L * SW * DM, (GAS bf16*)(wb + WO_UA), nullptr, SW, DM, 0, 0}; break;
    case 6:  d = TrDesc{inp(F, I_WUB) + (size_t)L * RW_W * DM, (GAS bf16*)(wb + WO_UB), nullptr, RW_W, DM, 0, 0}; break;
    case 7:  d = TrDesc{inp(F, I_WO) + (size_t)L * DM * DM, (GAS bf16*)(wb + WO_O), nullptr, DM, DM, 0, 0}; break;
    case 8:  d = TrDesc{inp(F, I_F2G) + (size_t)L * DM * DFF, (GAS bf16*)(wb + WO_GU2), inp(F, I_F2N) + (size_t)L * DM, DM, DFF, 1, 0}; break;
    case 9:  d = TrDesc{inp(F, I_F2U) + (size_t)L * DM * DFF, (GAS bf16*)(wb + WO_GU2), inp(F, I_F2N) + (size_t)L * DM, DM, DFF, 2, 0}; break;
    default: d = TrDesc{inp(F, I_F2D) + (size_t)L * DFF * DM, (GAS bf16*)(wb + WO_D2), nullptr, DFF, DM, 0, 0}; break;
    }
    return d;
}
__device__ __forceinline__ bool tr_decode(int L, int t, int& m, int& it) {
    const int P = L == 0 ? P_FIRST : P_REST;
    constexpr int n_gu = (DM / 64) * (DFF / 64), n_dn = (DFF / 64) * (DM / 64), n_gl = (SW / 64) * (SW / 64), n_up = (SW / 64) * (DM / 64), n_wo = (DM / 64) * (DM / 64);
    const int n_in = (DM / 64) * ((P + 63) / 64);
    const int cnt[TR_NMAT] = {n_gu, n_gu, n_dn, n_in, n_gl, n_up, n_up, n_wo, n_gu, n_gu, n_dn};
    int r = t;
#pragma unroll
    for (int i = 0; i < TR_NMAT; ++i) { if (r < cnt[i]) { m = i; it = r; return true; } r -= cnt[i]; }
    return false;
}
__device__ __forceinline__ void tr_matrix(Frame& F, const TrDesc& d) {
    LAS unsigned* scr = (LAS unsigned*)(F.lds + RING_OFF + F.wave * 16384);
    const int gw = F.vcu * NWAVES + F.wave, NGW = F.G * NWAVES, nitems = tr_items(d);
    for (int it = gw; it < nitems; it += NGW) { f32x4 v[16]; tr_tile_load(d, it, F.lane, v); tr_tile_finish(d, it, F.lane, v, scr); }
}
__device__ __forceinline__ void pw_zero_rows(Frame& F, int L) {
    GAS unsigned char* wb = F.ws + WS_W + (size_t)(L & 1) * W_SLOT; const int P = L == 0 ? P_FIRST : P_REST;
    const int gw = F.vcu * NWAVES + F.wave, NGW = F.G * NWAVES;
    for (int r = P + gw; r < NIN; r += NGW) { GAS v4u* z = (GAS v4u*)((GAS bf16*)(wb + WO_IN) + (size_t)r * DM);
#pragma unroll
        for (int j = 0; j < 4; ++j) z[F.lane + 64 * j] = (v4u){0u, 0u, 0u, 0u}; }
}
__device__ __forceinline__ void pw_weights(Frame& F, int L) {
    for (int m = 0; m < TR_NMAT; ++m) { const TrDesc d = tr_desc(F, L, m); tr_matrix(F, d); }
}

constexpr size_t S5_KC_BYTES = (size_t)NG * 256 * 384 * 2;
__device__ __forceinline__ float gelu_tanh(float y) { const float t2 = 1.5957691216057308f * (y + 0.044715f * y * y * y); return y * __builtin_amdgcn_rcpf(1.0f + __expf(-t2)); }
__device__ __forceinline__ void abar_pow(float lr, float li, float dt, int p, float& re, float& im) {
    const double ang = (double)p * (double)li * (double)dt;
    const double k = __builtin_rint(ang * 0.15915494309189535);
    const float r = (float)(ang - k * 6.283185307179586);
    const float mag = expf((float)((double)p * (double)lr * (double)dt));
    re = mag * cosf(r); im = mag * sinf(r);
}
__device__ __forceinline__ void s5_build(Frame& F, int L) {
    LAS float* APR = (LAS float*)(F.lds + RING_OFF);
    LAS float* API = APR + 17 * 64;
    LAS float* BBR = API + 17 * 64;
    LAS float* BBI = BBR + 1024;
    LAS float* CR = BBI + 1024;
    LAS float* CI = CR + 1024;
    LAS float* KT = CI + 1024;
    GAS unsigned char* wb = F.ws + WS_W + (size_t)(L & 1) * W_SLOT;
    for (int g = F.vcu; g < NG; g += F.G) {
        const size_t lg = (size_t)L * NG + g;
        const float dt = expf(inp(F, I_LDT)[lg]);
        for (int i = F.tid; i < 17 * 64; i += NWAVES * 64) { const int p = i >> 6, n = i & 63; float pr, pi;
            abar_pow(inp(F, I_LRE)[lg * NS + n], inp(F, I_LIM)[lg * NS + n], dt, p, pr, pi);
            APR[i] = pr; API[i] = pi; }
        for (int i = F.tid; i < 1024; i += NWAVES * 64) { const int n = i >> 4;
            const float lr = inp(F, I_LRE)[lg * NS + n], li = inp(F, I_LIM)[lg * NS + n]; float are, aim;
            abar_pow(lr, li, dt, 1, are, aim);
            const float den = lr * lr + li * li, nr = are - 1.0f, ni = aim;
            const float qre = (nr * lr + ni * li) / den, qim = (ni * lr - nr * li) / den;
            const float br = inp(F, I_BRE)[lg * 1024 + i], bi = inp(F, I_BIM)[lg * 1024 + i];
            BBR[i] = qre * br - qim * bi; BBI[i] = qre * bi + qim * br;
            CR[i] = inp(F, I_CRE)[lg * 1024 + i]; CI[i] = inp(F, I_CIM)[lg * 1024 + i]; }
        __syncthreads();
        for (int i = F.tid; i < 4096; i += NWAVES * 64) { const int tau = i >> 8, c = (i >> 4) & 15, cp = i & 15; float acc = 0.f;
            for (int n = 0; n < 64; ++n) { const float cr = CR[c * 64 + n], ci = CI[c * 64 + n], ar = APR[tau * 64 + n], ai = API[tau * 64 + n], br = BBR[n * 16 + cp], bi = BBI[n * 16 + cp];
                const float mr = cr * ar - ci * ai, mi = cr * ai + ci * ar; acc += mr * br - mi * bi; }
            KT[i] = acc; }
        __syncthreads();
        GAS unsigned* KC = (GAS unsigned*)(wb + WO_S5) + (size_t)g * 256 * 192;
        GAS unsigned* BE = (GAS unsigned*)(wb + WO_S5 + S5_KC_BYTES) + (size_t)g * 128 * 128;
        for (int i = F.tid; i < 256 * 192; i += NWAVES * 64) { const int row = i / 192, cp2 = i - row * 192, t = row >> 4, c = row & 15; float v[2];
#pragma unroll
            for (int e = 0; e < 2; ++e) { const int col = 2 * cp2 + e;
                if (col < 256) { const int j = col >> 4, cq = col & 15; v[e] = j <= t ? KT[((t - j) * 16 + c) * 16 + cq] : 0.f; }
                else { const int n = (col - 256) & 63; const float cr = CR[c * 64 + n], ci = CI[c * 64 + n], ar = APR[(t + 1) * 64 + n], ai = API[(t + 1) * 64 + n];
                    v[e] = col < 320 ? cr * ar - ci * ai : -(cr * ai + ci * ar); } }
            KC[i] = pk2(v[0], v[1]); }
        for (int i = F.tid; i < 128 * 128; i += NWAVES * 64) { const int n2 = i >> 7, cp2 = i & 127, n = n2 & 63; float v[2];
#pragma unroll
            for (int e = 0; e < 2; ++e) { const int col = 2 * cp2 + e, j = col >> 4, cq = col & 15; const float ar = APR[(15 - j) * 64 + n], ai = API[(15 - j) * 64 + n], br = BBR[n * 16 + cq], bi = BBI[n * 16 + cq];
                v[e] = n2 < 64 ? ar * br - ai * bi : ar * bi + ai * br; }
            BE[i] = pk2(v[0], v[1]); }
        __syncthreads();
    }
}
typedef short bfx8 __attribute__((ext_vector_type(8)));
typedef __bf16 bf2v __attribute__((ext_vector_type(2)));
__device__ __forceinline__ unsigned cvt2(float a, float b) { const f32x2 v = {a, b}; const bf2v r = __builtin_convertvector(v, bf2v); return __builtin_bit_cast(unsigned, r); }
__device__ __forceinline__ float bfu(unsigned short u) { return __uint_as_float((unsigned)u << 16); }
__device__ __forceinline__ void wait_vm(int n) {
    switch (n) {
    case 0: asm volatile("s_waitcnt vmcnt(0)" ::: "memory"); break; case 1: asm volatile("s_waitcnt vmcnt(1)" ::: "memory"); break; case 2: asm volatile("s_waitcnt vmcnt(2)" ::: "memory"); break;
    case 3: asm volatile("s_waitcnt vmcnt(3)" ::: "memory"); break; case 4: asm volatile("s_waitcnt vmcnt(4)" ::: "memory"); break; case 5: asm volatile("s_waitcnt vmcnt(5)" ::: "memory"); break;
    case 6: asm volatile("s_waitcnt vmcnt(6)" ::: "memory"); break; case 7: asm volatile("s_waitcnt vmcnt(7)" ::: "memory"); break; case 8: asm volatile("s_waitcnt vmcnt(8)" ::: "memory"); break;
    case 9: asm volatile("s_waitcnt vmcnt(9)" ::: "memory"); break; case 10: asm volatile("s_waitcnt vmcnt(10)" ::: "memory"); break; case 11: asm volatile("s_waitcnt vmcnt(11)" ::: "memory"); break;
    case 12: asm volatile("s_waitcnt vmcnt(12)" ::: "memory"); break; default: asm volatile("s_waitcnt vmcnt(0)" ::: "memory"); break; }
}
__device__ __forceinline__ void s5_unit(Frame& F, int L, int b, int g) {
    const int lane = F.lane, w = F.wave, fr = lane & 15, fq = lane >> 4;
    GAS unsigned char* wb = F.ws + WS_W + (size_t)(L & 1) * W_SLOT;
    const GAS unsigned char* U2b = F.ws + WS_OV + OV_U2 + (size_t)g * U2_CR * 512;
    const GAS bf16* KC = (const GAS bf16*)(wb + WO_S5) + (size_t)g * 256 * 384;
    const GAS bf16* BE = (const GAS bf16*)(wb + WO_S5 + S5_KC_BYTES) + (size_t)g * 128 * 256;
    GAS bf16* YPRE = (GAS bf16*)(F.ws + WS_OV + OV_YPRE);
    constexpr int SLP = 136, UD = 5, UNS = 7;
    LAS bf16* SLh = (LAS bf16*)(F.lds + RING_OFF);
    LAS unsigned char* UR = F.lds + RING_OFF + 256 * SLP * 2;
    static_assert(256 * SLP * 2 + UNS * 8192 <= RING_BYTES, "S5 LDS map");
    const int ur = 2 * w + (lane >> 5), upc = ((lane & 31) ^ ur) * 16;
#define S5_ISSUE(ct_) do { const int c_ = (ct_) * 16 + ur; const int row_ = c_ == 0 ? 1024 : (c_ > 256 ? b * 256 + 255 : b * 256 + c_ - 1); \
        __builtin_amdgcn_global_load_lds((const GAS unsigned*)(U2b + (size_t)row_ * 512 + upc), (LAS unsigned*)(UR + ((ct_) % UNS) * 8192 + w * 1024), 16, 0, 0); } while (0)
#define S5_FRAG(sl_, p_) (*(const LAS bfx8*)((sl_) + ((((p_)) ^ fr) << 4)))
    {
        bfx8 wf[8];
#pragma unroll
        for (int ks = 0; ks < 8; ++ks) wf[ks] = *(const GAS bfx8*)(BE + (size_t)(16 * w + fr) * 256 + ks * 32 + 8 * fq);
        asm volatile("s_waitcnt vmcnt(0)" ::: "memory");
#pragma unroll
        for (int i = 0; i < UD; ++i) S5_ISSUE(i);
#pragma unroll
        for (int ct = 0; ct < 16; ++ct) {
            if (ct + UD < 16) S5_ISSUE(ct + UD);
            wait_vm(15 - ct < UD ? 15 - ct : UD);
            __builtin_amdgcn_s_barrier(); asm volatile("" ::: "memory");
            const LAS unsigned char* sl = UR + (ct % UNS) * 8192 + fr * 512;
            f32x4 acc = {0.f, 0.f, 0.f, 0.f};
#pragma unroll
            for (int ks = 0; ks < 8; ++ks) acc = __builtin_amdgcn_mfma_f32_16x16x32_bf16(wf[ks], S5_FRAG(sl, ks * 4 + fq), acc, 0, 0, 0);
            v2u o; o.x = cvt2(acc[0], acc[1]); o.y = cvt2(acc[2], acc[3]);
            *(LAS v2u*)(SLh + (ct * 16 + fr) * SLP + 16 * w + 4 * fq) = o;
        }
    }
    __syncthreads();
    {
        const int n = lane; const size_t lg = (size_t)L * NG + g;
        const float lr_ = inp(F, I_LRE)[lg * NS + n], li_ = inp(F, I_LIM)[lg * NS + n], dt_ = expf(inp(F, I_LDT)[lg]);
        float a_re, a_im, A_re, A_im; abar_pow(lr_, li_, dt_, 16, a_re, a_im); abar_pow(lr_, li_, dt_, 512, A_re, A_im);
        LAS float* TT = (LAS float*)UR;
        LAS bf16* seg = SLh + (size_t)(32 * w) * SLP;
        float pre[32], pim[32]; float sre = 0.f, sim = 0.f;
#pragma unroll
        for (int j = 0; j < 32; ++j) { const float cre = bfu(seg[j * SLP + n]), cim = bfu(seg[j * SLP + 64 + n]);
            const float nre = a_re * sre - a_im * sim + cre, nim = a_re * sim + a_im * sre + cim; sre = nre; sim = nim; pre[j] = sre; pim[j] = sim; }
        TT[w * 128 + n] = sre; TT[w * 128 + 64 + n] = sim;
        __syncthreads();
        float ire = 0.f, iim = 0.f;
        for (int k = 0; k < w; ++k) { const float tre = TT[k * 128 + n], tim = TT[k * 128 + 64 + n]; const float nre = A_re * ire - A_im * iim + tre, nim = A_re * iim + A_im * ire + tim; ire = nre; iim = nim; }
        float qre = a_re, qim = a_im;
#pragma unroll
        for (int j = 0; j < 32; ++j) { const float ore = pre[j] + qre * ire - qim * iim, oim = pim[j] + qre * iim + qim * ire;
            const unsigned o2 = cvt2(ore, oim); seg[j * SLP + n] = (bf16)o2; seg[j * SLP + 64 + n] = (bf16)(o2 >> 16);
            const float nq = qre * a_re - qim * a_im; qim = qre * a_im + qim * a_re; qre = nq; }
    }
    __syncthreads();
    {
        bfx8 wf[2][12];
#pragma unroll
        for (int tt = 0; tt < 2; ++tt)
#pragma unroll
            for (int ks = 0; ks < 12; ++ks) wf[tt][ks] = *(const GAS bfx8*)(KC + (size_t)(16 * (2 * w + tt) + fr) * 384 + ks * 32 + 8 * fq);
        const f32x4 d4 = *(const GAS f32x4*)(inp(F, I_SD) + (size_t)L * SW + g * SGC + 4 * fq);
        asm volatile("s_waitcnt vmcnt(0)" ::: "memory");
#pragma unroll
        for (int i = 0; i < UD; ++i) S5_ISSUE(i);
#pragma unroll
        for (int ct = 0; ct < 17; ++ct) {
            int nafter = 0;
            if (ct < UD) nafter = (UD - 1 - ct) + 3 * ct;
            else { nafter = 0;
#pragma unroll
                for (int j = ct - UD + 1; j < ct; ++j) nafter += 2 + (j + UD <= 16 ? 1 : 0); }
            wait_vm(nafter);
            __builtin_amdgcn_s_barrier(); asm volatile("" ::: "memory");
            const LAS unsigned char* sl = UR + (ct % UNS) * 8192 + fr * 512;
            const int c = ct * 16 + fr, cc = c <= 256 ? c : 256;
            f32x4 acc[2] = {{0.f, 0.f, 0.f, 0.f}, {0.f, 0.f, 0.f, 0.f}};
#pragma unroll
            for (int ks = 0; ks < 8; ++ks) { const bfx8 af = S5_FRAG(sl, ks * 4 + fq);
                acc[0] = __builtin_amdgcn_mfma_f32_16x16x32_bf16(wf[0][ks], af, acc[0], 0, 0, 0); acc[1] = __builtin_amdgcn_mfma_f32_16x16x32_bf16(wf[1][ks], af, acc[1], 0, 0, 0); }
#pragma unroll
            for (int ks = 0; ks < 4; ++ks) {
                bfx8 sf = {0, 0, 0, 0, 0, 0, 0, 0};
                if (cc >= 1) sf = *(const LAS bfx8*)(SLh + (cc - 1) * SLP + ks * 32 + 8 * fq);
                acc[0] = __builtin_amdgcn_mfma_f32_16x16x32_bf16(wf[0][8 + ks], sf, acc[0], 0, 0, 0); acc[1] = __builtin_amdgcn_mfma_f32_16x16x32_bf16(wf[1][8 + ks], sf, acc[1], 0, 0, 0);
            }
#pragma unroll
            for (int tt = 0; tt < 2; ++tt) { const int t = 2 * w + tt; const int row = cc == 0 ? MR + t : b * SEQ + (cc - 1) * 16 + t;
                const v2u uu = *(const LAS v2u*)(sl + (((2 * t + (fq >> 1)) ^ fr) << 4) + (fq & 1) * 8);
                const float u0 = __uint_as_float(uu.x << 16), u1 = __uint_as_float(uu.x & 0xffff0000u), u2 = __uint_as_float(uu.y << 16), u3 = __uint_as_float(uu.y & 0xffff0000u);
                v2u o; o.x = pk2(gelu_tanh(acc[tt][0] + d4[0] * u0), gelu_tanh(acc[tt][1] + d4[1] * u1)); o.y = pk2(gelu_tanh(acc[tt][2] + d4[2] * u2), gelu_tanh(acc[tt][3] + d4[3] * u3));
                *(GAS v2u*)(YPRE + (size_t)row * SW + g * SGC + 4 * fq) = o; }
            asm volatile("" ::: "memory");
            if (ct + UD < 17) S5_ISSUE(ct + UD);
        }
    }
#undef S5_ISSUE
#undef S5_FRAG
    __syncthreads();
}

constexpr size_t WLF_OFF = (size_t)4096 * LKP * 2;
static_assert(WO_LORA + WLF_OFF + 3 * 16 * 4 * 2 * 64 * 16 <= W_SLOT, "weight slot");
__device__ __forceinline__ void lora_weights(Frame& F, int L) {
    GAS unsigned char* wb = F.ws + WS_W + (size_t)(L & 1) * W_SLOT;
    GAS v4u* WL = (GAS v4u*)(wb + WO_LORA);
    const GAS float* w2 = inp(F, I_W2) + (size_t)L * 64 * RW_W; const GAS float* a2 = inp(F, I_A2) + (size_t)L * 64 * RW_W; const GAS float* g2 = inp(F, I_G2) + (size_t)L * 160 * RW_W;
    const GAS float* v2 = inp(F, I_V2) + (size_t)(L > 0 ? L - 1 : 0) * 32 * RW_W;
    for (int i = (int)(F.vcu * (NWAVES * 64) + F.tid); i < 4096 * (LKP / 8); i += F.G * NWAVES * 64) {
        const int row = i / (LKP / 8), k0 = (i - row * (LKP / 8)) * 8, kind = row >> 10, ch = row & 1023; float v[8];
#pragma unroll
        for (int e = 0; e < 8; ++e) { const int k = k0 + e; float x = 0.f;
            if (kind == 0) { if (k < 64) x = w2[(size_t)k * RW_W + ch]; }
            else if (kind == 1) { if (k >= 64 && k < 128) x = a2[(size_t)(k - 64) * RW_W + ch]; }
            else if (kind == 2) { if (k >= 128 && k < 288) x = g2[(size_t)(k - 128) * RW_W + ch]; }
            else { if (L > 0 && k >= 288 && k < 320) x = v2[(size_t)(k - 288) * RW_W + ch]; }
            v[e] = x; }
        v4u o; o.x = pk2(v[0], v[1]); o.y = pk2(v[2], v[3]); o.z = pk2(v[4], v[5]); o.w = pk2(v[6], v[7]); WL[i] = o;
    }
    GAS v4u* WLF = (GAS v4u*)(wb + WO_LORA + WLF_OFF);
    for (int i = (int)(F.vcu * (NWAVES * 64) + F.tid); i < 3 * 16 * 4 * 2 * 64; i += F.G * NWAVES * 64) {
        const int ln = i & 63, sk = (i >> 6) & 1, tile = (i >> 7) & 3, h = (i >> 9) & 15, kd = i >> 13, c16 = ln & 15, g = ln >> 4, ch = h * HD + 16 * tile + c16, k0 = 32 * sk + 8 * g; float v[8];
#pragma unroll
        for (int e = 0; e < 8; ++e) { const int k = k0 + e; float x = 0.f;
            if (kd == 0) x = w2[(size_t)k * RW_W + ch]; else if (kd == 1) x = a2[(size_t)k * RW_W + ch]; else if (L > 0 && k < 32) x = v2[(size_t)k * RW_W + ch];
            v[e] = x; }
        v4u o; o.x = pk2(v[0], v[1]); o.y = pk2(v[2], v[3]); o.z = pk2(v[4], v[5]); o.w = pk2(v[6], v[7]); WLF[i] = o;
    }
}
__device__ __forceinline__ void lora_inputs(Frame& F, int L) {
    const int gw = F.vcu * NWAVES + F.wave, NGW = F.G * NWAVES, k0 = 8 * F.lane;
    const GAS bf16* LIN = (const GAS bf16*)(F.ws + WS_OV + OV_LIN); GAS bf16* LA = (GAS bf16*)(F.ws + WS_OV + OV_LA);
    if (k0 >= LKP) return;
    f32x4 m0 = {0.f, 0.f, 0.f, 0.f}, m1 = m0;
    if (k0 < 288) { const GAS float* ms = inp(F, I_MUSH) + (size_t)L * 3360 + 3072 + k0; m0 = *(const GAS f32x4*)ms; m1 = *(const GAS f32x4*)(ms + 4); }
    else if (k0 < 320 && L > 0) { const GAS float* mv = inp(F, I_MUVR) + (size_t)(L - 1) * 32 + (k0 - 288); m0 = *(const GAS f32x4*)mv; m1 = *(const GAS f32x4*)(mv + 4); }
    const bool live = k0 < 288 || (k0 < 320 && L > 0);
    for (int row = gw; row < MROWS; row += NGW) {
        v4u o = {0u, 0u, 0u, 0u};
        if (live) { const int prow = prev_row(row);
            f32x4 x0, x1, p0 = {0.f, 0.f, 0.f, 0.f}, p1 = p0;
            pg8::unpack8(*(const GAS v4u*)(LIN + (size_t)row * 512 + k0), x0, x1);
            if (prow >= 0) pg8::unpack8(*(const GAS v4u*)(LIN + (size_t)prow * 512 + k0), p0, p1);
            x0 = x0 + m0 * (p0 - x0); x1 = x1 + m1 * (p1 - x1);
            if (k0 < 64) {
#pragma unroll
                for (int e = 0; e < 4; ++e) { x0[e] = 1.0f - 2.0f * __builtin_amdgcn_rcpf(1.0f + __expf(2.0f * x0[e])); x1[e] = 1.0f - 2.0f * __builtin_amdgcn_rcpf(1.0f + __expf(2.0f * x1[e])); }
            } else if (k0 >= 128 && k0 < 288) {
#pragma unroll
                for (int e = 0; e < 4; ++e) { x0[e] = __builtin_amdgcn_rcpf(1.0f + __expf(-x0[e])); x1[e] = __builtin_amdgcn_rcpf(1.0f + __expf(-x1[e])); }
            }
            o.x = pk2(x0[0], x0[1]); o.y = pk2(x0[2], x0[3]); o.z = pk2(x1[0], x1[1]); o.w = pk2(x1[2], x1[3]); }
        *(GAS v4u*)(LA + (size_t)row * LKP + k0) = o;
    }
}
__device__ __forceinline__ f32x4 ld_bf4(const GAS bf16* p) { const v2u u = *(const GAS v2u*)p; return (f32x4){__uint_as_float(u.x << 16), __uint_as_float(u.x & 0xffff0000u), __uint_as_float(u.y << 16), __uint_as_float(u.y & 0xffff0000u)}; }
constexpr int REC_TB = 32, REC_F = 6 * HD, REC_LF = REC_F + 4, REC_NBLK = (TSEQ + REC_TB - 1) / REC_TB, REC_OBUF = 2 * REC_TB * REC_LF;
__device__ __forceinline__ void rwkv_rec_unit(Frame& F, int L, int b, int h, int q) {
    GAS float* O = (GAS float*)(F.ws + WS_OV + OV_O);
    LAS float* buf = (LAS float*)(F.lds + RING_OFF);
    const bool loader = F.wave >= 4;
    const int lt = F.tid - 256;
    const int rg = F.lane >> 4, j = F.lane & 15, lrow = (F.wave & 3) * 4 + rg, vrow = q * 16 + lrow;
    f32x4 S = {0.f, 0.f, 0.f, 0.f};
    const int ltk = lt >> 4, lj = lt & 15, C = h * HD + 4 * lj;
    const GAS bf16* RKVp = (const GAS bf16*)(F.ws + WS_OV + OV_RKV); const GAS bf16* DECp = (const GAS bf16*)(F.ws + WS_OV + OV_DEC); const GAS bf16* ICLp = (const GAS bf16*)(F.ws + WS_OV + OV_ICLR);
    const GAS bf16* VGp = (const GAS bf16*)(F.ws + WS_OV + OV_VG);
    LAS float* PL = (LAS float*)(F.lds + LDSCTL_OFF + 1024);
    for (int pi = F.wave; pi < 9; pi += NWAVES) {
        const GAS float* src = pi < 3 ? inp(F, I_MUSH) + (size_t)L * 3360 + pi * 1024 : pi == 3 ? inp(F, I_W0) + (size_t)L * RW_W : pi == 4 ? inp(F, I_A0) + (size_t)L * RW_W : pi == 5 ? inp(F, I_V0) + (size_t)(L > 0 ? L - 1 : 0) * RW_W
                             : pi == 6 ? inp(F, I_KK) + (size_t)L * RW_W : pi == 7 ? inp(F, I_KA) + (size_t)L * RW_W : inp(F, I_RK) + (size_t)L * RW_W;
        const float x = src[h * HD + F.lane];
        PL[pi * 64 + F.lane] = (pi == 5 && L == 0) ? 0.f : x; }
    __syncthreads();
    v2u rr[2][2], rk_[2][2], rv[2][2], rvg[2], rvf[2], rdc[2], ric[2];
#define REC_LOAD(blk) do { \
        _Pragma("unroll") for (int p_ = 0; p_ < 2; ++p_) { int s_ = (blk) * REC_TB + ltk + 16 * p_; s_ = s_ > TSEQ - 1 ? TSEQ - 1 : s_; const int sp_ = s_ > 0 ? s_ - 1 : 0; \
            const size_t ro_ = (size_t)seq_row(b, s_) * RW_W + C, rp_ = (size_t)seq_row(b, sp_) * RW_W + C; \
            rr[p_][0] = *(const GAS v2u*)(RKVp + ro_); rr[p_][1] = *(const GAS v2u*)(RKVp + rp_); \
            rk_[p_][0] = *(const GAS v2u*)(RKVp + (size_t)MP * 1024 + ro_); rk_[p_][1] = *(const GAS v2u*)(RKVp + (size_t)MP * 1024 + rp_); \
            rv[p_][0] = *(const GAS v2u*)(RKVp + (size_t)2 * MP * 1024 + ro_); rv[p_][1] = *(const GAS v2u*)(RKVp + (size_t)2 * MP * 1024 + rp_); \
            rdc[p_] = *(const GAS v2u*)(DECp + ro_); ric[p_] = *(const GAS v2u*)(ICLp + ro_); \
            if (L > 0) { rvg[p_] = *(const GAS v2u*)(VGp + ro_); rvf[p_] = *(const GAS v2u*)(FVF(F) + ro_); } } } while (0)
#define UB4(u) ((f32x4){__uint_as_float((u).x << 16), __uint_as_float((u).x & 0xffff0000u), __uint_as_float((u).y << 16), __uint_as_float((u).y & 0xffff0000u)})
#define REC_STORE(bi, blk) do { int lj2_ = lt & 15; asm volatile("" : "+v"(lj2_)); const LAS float* plj = PL + 4 * lj2_;     \
        _Pragma("unroll") for (int p_ = 0; p_ < 2; ++p_) { const int tk_ = ltk + 16 * p_, s_ = (blk) * REC_TB + tk_; const float pm_ = s_ > 0 ? 1.f : 0.f; \
            f32x4 xr_, xk_, xv_, dec_, icl_, vv_; \
            { const f32x4 mu_r = *(const LAS f32x4*)(plj), mu_k = *(const LAS f32x4*)(plj + 64), mu_v = *(const LAS f32x4*)(plj + 128); \
              const f32x4 r1_ = UB4(rr[p_][0]), k1_ = UB4(rk_[p_][0]), v1_ = UB4(rv[p_][0]); \
              xr_ = r1_ + mu_r * (UB4(rr[p_][1]) * pm_ - r1_); xk_ = k1_ + mu_k * (UB4(rk_[p_][1]) * pm_ - k1_); xv_ = v1_ + mu_v * (UB4(rv[p_][1]) * pm_ - v1_); } \
            asm volatile("" ::: "memory"); \
            { const f32x4 wl_ = UB4(rdc[p_]) + *(const LAS f32x4*)(plj + 192), al_ = UB4(ric[p_]) + *(const LAS f32x4*)(plj + 256); vv_ = xv_; \
              if (L > 0) { const f32x4 vf_ = UB4(rvf[p_]), vg_ = UB4(rvg[p_]) + *(const LAS f32x4*)(plj + 320); \
                  _Pragma("unroll") for (int e_ = 0; e_ < 4; ++e_) vv_[e_] = xv_[e_] + (vf_[e_] - xv_[e_]) * __builtin_amdgcn_rcpf(1.0f + __expf(-vg_[e_])); } \
              _Pragma("unroll") for (int e_ = 0; e_ < 4; ++e_) {        \
                  dec_[e_] = __expf(-0.60653066f * __builtin_amdgcn_rcpf(1.0f + __expf(-wl_[e_]))); icl_[e_] = __builtin_amdgcn_rcpf(1.0f + __expf(-al_[e_])); } } \
            asm volatile("" ::: "memory"); \
            const f32x4 kkc = *(const LAS f32x4*)(plj + 384), kac = *(const LAS f32x4*)(plj + 448), rkc = *(const LAS f32x4*)(plj + 512); \
            f32x4 kk_, k2_, bb_, wr_; float skk_ = 0.f, srk_ = 0.f, sbr_ = 0.f, skr_ = 0.f; \
            _Pragma("unroll") for (int e_ = 0; e_ < 4; ++e_) { \
                kk_[e_] = xk_[e_] * kkc[e_]; skk_ += kk_[e_] * kk_[e_]; k2_[e_] = xk_[e_] * (1.0f + (icl_[e_] - 1.0f) * kac[e_]); \
                srk_ += xr_[e_] * k2_[e_] * rkc[e_]; skr_ += k2_[e_] * xr_[e_]; } \
            const float inv_ = rsqrtf(row16_sum(skk_) + 1e-12f); \
            _Pragma("unroll") for (int e_ = 0; e_ < 4; ++e_) { kk_[e_] *= inv_; bb_[e_] = kk_[e_] * icl_[e_]; sbr_ += bb_[e_] * xr_[e_]; wr_[e_] = dec_[e_] * xr_[e_]; } \
            const float br_ = row16_sum(sbr_), kr_ = row16_sum(skr_); \
            LAS float* rec_ = buf + (bi) * (REC_TB * REC_LF) + tk_ * REC_LF + 4 * lj; \
            *(LAS f32x4*)(rec_) = dec_; *(LAS f32x4*)(rec_ + HD) = k2_; *(LAS f32x4*)(rec_ + 2 * HD) = -kk_; *(LAS f32x4*)(rec_ + 3 * HD) = bb_; *(LAS f32x4*)(rec_ + 4 * HD) = wr_; *(LAS f32x4*)(rec_ + 5 * HD) = vv_; \
            if (lj == 0) *(LAS f32x2*)(rec_ + REC_F) = (f32x2){br_, kr_}; \
            if (q == 0 && s_ < TSEQ) { const size_t ro_ = (size_t)seq_row(b, s_) * RW_W + C; const float rks_ = row16_sum(srk_); \
                *(GAS f32x4*)((GAS float*)(F.ws + WS_OV + OV_RW) + ro_) = vv_; if (lj == 0) ((GAS float*)(F.ws + WS_OV + OV_RKS))[(size_t)seq_row(b, s_) * NH + h] = rks_; \
                if (L == 0) { v2u o_; o_.x = pk2(xv_[0], xv_[1]); o_.y = pk2(xv_[2], xv_[3]); *(GAS v2u*)(FVF(F) + ro_) = o_; } } \
            asm volatile("" ::: "memory"); } } while (0)
#define REC_LD(X, tk) do { const LAS float* q_ = rp + (tk) * REC_LF; w##X = *(const LAS f32x4*)(q_); k##X = *(const LAS f32x4*)(q_ + HD); a##X = *(const LAS f32x4*)(q_ + 2 * HD); b##X = *(const LAS f32x4*)(q_ + 3 * HD); r##X = *(const LAS f32x4*)(q_ + 4 * HD); \
        v##X = q_[5 * HD - 4 * j + vrow]; s##X = *(const LAS f32x2*)(q_ + REC_F - 4 * j); } while (0)
#define REC_STEP(X, tk) do { float t0_, t1_, u0_, u1_, q0_, q1_, q2_, q3_, o_; \
        asm("v_mul_f32 %4, %0, %12\n\tv_mul_f32 %5, %0, %16\n\tv_fmac_f32 %4, %1, %13\n\tv_fmac_f32 %5, %1, %17\n\t" \
            "v_mul_f32 %6, %2, %14\n\tv_mul_f32 %7, %2, %18\n\tv_fmac_f32 %6, %3, %15\n\tv_fmac_f32 %7, %3, %19\n\t" \
            "v_add_f32 %4, %4, %6\n\tv_add_f32 %5, %5, %7\n\t" \
            "v_mul_f32 %8, %28, %24\n\t" \
            "v_add_f32_dpp %4, %4, %4 quad_perm:[1,0,3,2] row_mask:0xf bank_mask:0xf bound_ctrl:1\n\tv_add_f32_dpp %5, %5, %5 quad_perm:[1,0,3,2] row_mask:0xf bank_mask:0xf bound_ctrl:1\n\t" \
            "v_mul_f32 %9, %28, %25\n\t" \
            "v_add_f32_dpp %4, %4, %4 quad_perm:[2,3,0,1] row_mask:0xf bank_mask:0xf bound_ctrl:1\n\tv_add_f32_dpp %5, %5, %5 quad_perm:[2,3,0,1] row_mask:0xf bank_mask:0xf bound_ctrl:1\n\t" \
            "v_mul_f32 %10, %28, %26\n\t" \
            "v_add_f32_dpp %4, %4, %4 row_ror:4 row_mask:0xf bank_mask:0xf bound_ctrl:1\n\tv_add_f32_dpp %5, %5, %5 row_ror:4 row_mask:0xf bank_mask:0xf bound_ctrl:1\n\t" \
            "v_mul_f32 %11, %28, %27\n\t" \
            "v_add_f32_dpp %4, %4, %4 row_ror:8 row_mask:0xf bank_mask:0xf bound_ctrl:1\n\tv_add_f32_dpp %5, %5, %5 row_ror:8 row_mask:0xf bank_mask:0xf bound_ctrl:1\n\t" \
            "v_fma_f32 %0, %0, %20, %8\n\tv_fma_f32 %1, %1, %21, %9\n\tv_fma_f32 %2, %2, %22, %10\n\tv_fma_f32 %3, %3, %23, %11" \
            : "+v"(S[0]), "+v"(S[1]), "+v"(S[2]), "+v"(S[3]), "=&v"(t0_), "=&v"(u0_), "=&v"(t1_), "=&v"(u1_), "=&v"(q0_), "=&v"(q1_), "=&v"(q2_), "=&v"(q3_) \
            : "v"(a##X[0]), "v"(a##X[1]), "v"(a##X[2]), "v"(a##X[3]), "v"(r##X[0]), "v"(r##X[1]), "v"(r##X[2]), "v"(r##X[3]), "v"(w##X[0]), "v"(w##X[1]), "v"(w##X[2]), "v"(w##X[3]), \
              "v"(k##X[0]), "v"(k##X[1]), "v"(k##X[2]), "v"(k##X[3]), "v"(v##X)); \
        asm("v_fmac_f32 %0, %5, %7\n\tv_fmac_f32 %1, %5, %8\n\tv_fmac_f32 %2, %5, %9\n\tv_fmac_f32 %3, %5, %10\n\tv_fma_f32 %4, %5, %11, %6\n\tv_fmac_f32 %4, %13, %12" \
            : "+v"(S[0]), "+v"(S[1]), "+v"(S[2]), "+v"(S[3]), "=&v"(o_) \
            : "v"(t0_), "v"(u0_), "v"(b##X[0]), "v"(b##X[1]), "v"(b##X[2]), "v"(b##X[3]), "v"(s##X[0]), "v"(s##X[1]), "v"(v##X)); \
        ob[(tk) * 16 + lrow] = o_; } while (0)
    const bool conv = F.wave >= 5 && L + 1 < DEPTH;
    LAS unsigned* cscr = (LAS unsigned*)(buf + REC_OBUF + 2 * REC_TB * 16) + (F.wave - 5) * (64 * 36);
    int ct = F.vcu * 3 + (F.wave - 5);
    if (loader) { REC_LOAD(0); REC_STORE(0, 0); REC_LOAD(1); }
    __syncthreads();
    for (int blk = 0; blk < REC_NBLK; ++blk) {
        const int s0 = blk * REC_TB, nt = TSEQ - s0 < REC_TB ? TSEQ - s0 : REC_TB;
        LAS float* ob = buf + REC_OBUF + (blk & 1) * (REC_TB * 16);
        if (loader) {
            if (blk + 1 < REC_NBLK) REC_STORE((blk + 1) & 1, blk + 1);
            if (blk > 0) { const LAS float* pb = buf + REC_OBUF + ((blk - 1) & 1) * (REC_TB * 16); const int ps0 = s0 - REC_TB;
#pragma unroll
                for (int i = 0; i < 2; ++i) { const int idx = lt + 256 * i, tk = idx >> 4, r = idx & 15; O[(size_t)seq_row(b, ps0 + tk) * RW_W + h * HD + q * 16 + r] = pb[idx]; } }
            if (conv) { int m_, it_;
                if (tr_decode(L + 1, ct, m_, it_)) { const TrDesc d = tr_desc(F, L + 1, m_); f32x4 cv[16]; tr_tile_load(d, it_, F.lane, cv); tr_tile_finish(d, it_, F.lane, cv, cscr); ct += 3 * F.G; } }
            if (blk + 2 < REC_NBLK) REC_LOAD(blk + 2);
        } else {
            const LAS float* rp = buf + (blk & 1) * (REC_TB * REC_LF) + 4 * j;
            f32x4 wA, kA, aA, bA, rA, wB, kB, aB, bB, rB; float vA, vB; f32x2 sA, sB;
            REC_LD(A, 0);
            if (nt == REC_TB) {
#pragma unroll
                for (int tk = 0; tk < REC_TB; tk += 2) {
                    REC_LD(B, tk + 1);
                    REC_STEP(A, tk);
                    if (tk + 2 < REC_TB) REC_LD(A, tk + 2);
                    REC_STEP(B, tk + 1);
                }
            } else {
                for (int tk = 0; tk < nt; tk += 2) {
                    REC_LD(B, tk + 1);
                    REC_STEP(A, tk);
                    if (tk + 2 < nt) REC_LD(A, tk + 2);
                    REC_STEP(B, tk + 1);
                }
            }
        }
        __syncthreads();
    }
    if (loader) { const int lb = REC_NBLK - 1, ps0 = lb * REC_TB, nt = TSEQ - ps0; const LAS float* pb = buf + REC_OBUF + (lb & 1) * (REC_TB * 16);
        int b2 = b; asm volatile("" : "+s"(b2));
#pragma unroll
        for (int i = 0; i < 2; ++i) { const int idx = lt + 256 * i, tk = idx >> 4, r = idx & 15; if (tk < nt) O[(size_t)seq_row(b2, ps0 + tk) * RW_W + h * HD + q * 16 + r] = pb[idx]; } }
    if (conv) {
        for (;;) { int m_, it_; if (!tr_decode(L + 1, ct, m_, it_)) break;
            const TrDesc d = tr_desc(F, L + 1, m_); f32x4 cv[16]; tr_tile_load(d, it_, F.lane, cv); tr_tile_finish(d, it_, F.lane, cv, cscr); ct += 3 * F.G; }
    }
    __syncthreads();
#undef REC_LOAD
#undef UB4
#undef REC_STORE
#undef REC_LD
#undef REC_STEP
}
constexpr int CH_T = 16, CH_N = TSEQ / CH_T;
constexpr int CR_BYTES = 12288, CR_AT = 0, CR_RT = 2048, CR_BK = 4096, CR_ARK = 8192, CR_VT = 9216, CR_GT = 11264, CR_W15 = 11776;
constexpr size_t OV_CR = OV_RW + 192 * MiB;
static_assert(TSEQ % CH_T == 0, "chunks"); static_assert(OV_CR + (size_t)BATCH * NH * CH_N * CR_BYTES <= OV_O, "chunk records");
typedef short bfx4 __attribute__((ext_vector_type(4)));
__device__ __forceinline__ float sigm_(float x) { return __builtin_amdgcn_rcpf(1.0f + __expf(-x)); }
template <int CTRL, int RMASK> __device__ __forceinline__ float dppf(float x) { return __builtin_bit_cast(float, __builtin_amdgcn_update_dpp(0, __builtin_bit_cast(int, x), CTRL, RMASK, 0xF, false)); }
__device__ __forceinline__ void wave_sum2(float& x, float& y) {
    x += dppf<0xB1, 0xF>(x); y += dppf<0xB1, 0xF>(y); x += dppf<0x4E, 0xF>(x); y += dppf<0x4E, 0xF>(y); x += dppf<0x124, 0xF>(x); y += dppf<0x124, 0xF>(y); x += dppf<0x128, 0xF>(x); y += dppf<0x128, 0xF>(y);
    x += dppf<0x142, 0xA>(x); y += dppf<0x142, 0xA>(y); x += dppf<0x143, 0xC>(x); y += dppf<0x143, 0xC>(y);
    x = lane_bcast(x, 63); y = lane_bcast(y, 63);
}
__device__ __forceinline__ LAS float* rwkv_prep_par(Frame& F, int L, int h) {
    constexpr float LOG2E = 1.4426950408889634f; const int lane = F.lane; const size_t lc = (size_t)L * RW_W + h * HD;
    LAS float* pp = (LAS float*)(F.lds + RING_OFF + 8 * 12288 + F.wave * 2304);
    const GAS float* mu = inp(F, I_MUSH) + (size_t)L * 3360 + h * HD;
    pp[lane] = mu[lane]; pp[64 + lane] = mu[1024 + lane]; pp[128 + lane] = mu[2048 + lane];
    pp[192 + lane] = -LOG2E * (inp(F, I_W0) + lc)[lane]; pp[256 + lane] = -LOG2E * (inp(F, I_A0) + lc)[lane];
    float v0 = 0.f; if (L > 0) v0 = -LOG2E * (inp(F, I_V0) + (lc - RW_W))[lane];
    pp[320 + lane] = v0; pp[384 + lane] = (inp(F, I_KK) + lc)[lane]; pp[448 + lane] = (inp(F, I_KA) + lc)[lane]; pp[512 + lane] = (inp(F, I_RK) + lc)[lane];
    return pp;
}
__device__ __forceinline__ void rwkv_prep_item(Frame& F, int L, int b, int h, int c, const LAS float* pp) {
    const int lane = F.lane, c16 = lane & 15, g = lane >> 4;
    LAS unsigned char* pl = F.lds + RING_OFF + F.wave * 12288;
    LAS bf16* M = (LAS bf16*)pl; LAS float* NT = (LAS float*)(pl + 9216); LAS float* AKT = NT + 256; LAS float* XGT = AKT + 256;
    GAS unsigned char* rec = F.ws + WS_OV + OV_CR + ((size_t)(b * NH + h) * CH_N + c) * CR_BYTES;
    const int rb = c == 0 ? MR : b * SEQ + (c - 1) * CH_T;
    const int rprev = c == 0 ? MR : (c == 1 ? MR + NMETA - 1 : rb - 1); const float pm0 = c == 0 ? 0.f : 1.f;
    constexpr float LOG2E = 1.4426950408889634f;
    const float mu_r = pp[lane], mu_k = pp[64 + lane], mu_v = pp[128 + lane], w0 = pp[192 + lane], a0 = pp[256 + lane], v0 = pp[320 + lane], k_k = pp[384 + lane], k_a = pp[448 + lane], r_k = pp[512 + lane];
    constexpr size_t PL = (size_t)MP * 1024;
    const GAS bf16* Rg = (const GAS bf16*)(F.ws + WS_OV + OV_RKV) + h * HD; GAS bf16* VFg = FVF(F) + h * HD;
    const int wrow = lane >> 3, wpc = lane & 7; v4u wr_[2], wk_[2], wv_[2], wf_[2];
#pragma unroll
    for (int i = 0; i < 2; ++i) { const size_t ro = (size_t)(rb + 8 * i + wrow) * 1024 + wpc * 8;
        wr_[i] = __builtin_nontemporal_load((const GAS v4u*)(Rg + ro)); wk_[i] = __builtin_nontemporal_load((const GAS v4u*)(Rg + PL + ro)); wv_[i] = __builtin_nontemporal_load((const GAS v4u*)(Rg + 2 * PL + ro));
        wf_[i] = (v4u){0u, 0u, 0u, 0u}; if (L > 0) wf_[i] = *(const GAS v4u*)(VFg + ro); }
    unsigned dl[8], il[8], gl[8];
    {
        const GAS bf16* LAg = (const GAS bf16*)(F.ws + WS_OV + OV_LA) + (size_t)(rb + c16) * LKP + 8 * g;
        const GAS bfx8* WLF = (const GAS bfx8*)(F.ws + WS_W + (size_t)(L & 1) * W_SLOT + WO_LORA + WLF_OFF) + lane;
        LAS float* TS = (LAS float*)pl;
#pragma unroll
        for (int kd = 0; kd < 3; ++kd) { const int kind = kd == 2 ? 3 : kd, kb = kd == 0 ? 0 : kd == 1 ? 64 : 288, nks = kd == 2 ? 1 : 2;
            if (kd == 2 && L == 0) break;
            bfx8 lb[2];
#pragma unroll
            for (int sk = 0; sk < nks; ++sk) lb[sk] = *(const GAS bfx8*)(LAg + kb + 32 * sk);
#pragma unroll
            for (int tile = 0; tile < 4; ++tile) { f32x4 acc = {0.f, 0.f, 0.f, 0.f};
#pragma unroll
                for (int sk = 0; sk < nks; ++sk) acc = __builtin_amdgcn_mfma_f32_16x16x32_bf16(WLF[(((kd * 16 + h) * 4 + tile) * 2 + sk) * 64], lb[sk], acc, 0, 0, 0);
#pragma unroll
                for (int e = 0; e < 4; ++e) TS[(16 * tile + 4 * g + e) * 20 + c16] = acc[e]; }
#pragma unroll
            for (int q = 0; q < 4; ++q) { const f32x4 v = *(const LAS f32x4*)(TS + lane * 20 + 4 * q);
#pragma unroll
                for (int e = 0; e < 2; ++e) { const unsigned u2 = cvt2(v[2 * e], v[2 * e + 1]); if (kd == 0) dl[2 * q + e] = u2; else if (kd == 1) il[2 * q + e] = u2; else gl[2 * q + e] = u2; } }
            asm volatile("" ::: "memory");
        }
    }
#pragma unroll
    for (int i = 0; i < 2; ++i) { LAS bf16* wp = M + (8 * i + wrow) * 72 + wpc * 8;
        *(LAS bfx8*)(wp) = __builtin_bit_cast(bfx8, wr_[i]); *(LAS bfx8*)(wp + 1152) = __builtin_bit_cast(bfx8, wk_[i]); *(LAS bfx8*)(wp + 2304) = __builtin_bit_cast(bfx8, wv_[i]); *(LAS bfx8*)(wp + 3456) = __builtin_bit_cast(bfx8, wf_[i]); }
    GAS bf16* Vout = (GAS bf16*)(F.ws + WS_OV + OV_RW) + h * HD; GAS float* RKS = (GAS float*)(F.ws + WS_OV + OV_RKS);
    float pr = bfu((Rg + (size_t)rprev * 1024)[lane]) * pm0, pk = bfu((Rg + PL + (size_t)rprev * 1024)[lane]) * pm0, pv = bfu((Rg + 2 * PL + (size_t)rprev * 1024)[lane]) * pm0;
    float cum = 0.f, wex = 1.f, Ah[16], rksv = 0.f; unsigned Bp[8], Kq[8], Vq[8], bkl = 0u; float vlo = 0.f;
    LAS bf16* VO = (LAS bf16*)NT;
#pragma unroll
    for (int hf = 0; hf < 2; ++hf) {
#pragma unroll
        for (int e = 0; e < 8; ++e) { const int t = 8 * hf + e; const size_t ro = (size_t)(rb + t) * 1024;
            const float r1 = bfu(M[t * 72 + lane]), k1 = bfu(M[1152 + t * 72 + lane]), v1 = bfu(M[2304 + t * 72 + lane]), vf1 = bfu(M[3456 + t * 72 + lane]);
            const float xr = r1 + mu_r * (pr - r1), xk = k1 + mu_k * (pk - k1), xv = v1 + mu_v * (pv - v1); pr = r1; pk = k1; pv = v1;
#define PKF(a_) ((t & 1) ? __uint_as_float((a_)[t >> 1] & 0xffff0000u) : __uint_as_float((a_)[t >> 1] << 16))
            const float sg = __builtin_amdgcn_rcpf(1.0f + __builtin_amdgcn_exp2f(__builtin_fmaf(PKF(dl), -LOG2E, w0))), icl = __builtin_amdgcn_rcpf(1.0f + __builtin_amdgcn_exp2f(__builtin_fmaf(PKF(il), -LOG2E, a0)));
            float vv = xv; if (L > 0) vv = xv + (vf1 - xv) * __builtin_amdgcn_rcpf(1.0f + __builtin_amdgcn_exp2f(__builtin_fmaf(PKF(gl), -LOG2E, v0)));
#undef PKF
            float kk = xk * k_k; const float k2 = xk * (1.0f + (icl - 1.0f) * k_a);
            float skk = kk * kk, rks = xr * k2 * r_k; wave_sum2(skk, rks);
            kk *= __builtin_amdgcn_rsqf(skk + 1e-12f);
            rksv = lane == t ? rks : rksv;
            cum = __builtin_fmaf(sg, -0.60653066f * LOG2E, cum); const float win = __builtin_amdgcn_exp2f(cum), iwin = __builtin_amdgcn_exp2f(-cum);
            const float ah = -kk * wex, rh = xr * win, bh = kk * icl * iwin, kh = k2 * iwin; wex = win; Ah[t] = ah;
            const unsigned ar = cvt2(ah, rh), bk = cvt2(bh, kh);
            M[t * 72 + lane] = (bf16)ar; M[1152 + t * 72 + lane] = (bf16)(ar >> 16); M[2304 + t * 72 + lane] = (bf16)bk; M[3456 + t * 72 + lane] = (bf16)(bk >> 16);
            if (t & 1) { Bp[t >> 1] = (bkl & 0xffffu) | (bk << 16); Kq[t >> 1] = (bkl >> 16) | (bk & 0xffff0000u); Vq[t >> 1] = cvt2(vlo, vv); VO[(t - 1) * 72 + lane] = (bf16)Vq[t >> 1]; VO[t * 72 + lane] = (bf16)(Vq[t >> 1] >> 16); } else { bkl = bk; vlo = vv; } }
    }
    int l2_ = lane; asm volatile("" : "+v"(l2_));
    if (l2_ < 16) RKS[(size_t)(rb + l2_) * NH + h] = rksv; const int wrow2 = l2_ >> 3, wpc2 = l2_ & 7;
#pragma unroll
    for (int i = 0; i < 2; ++i) __builtin_nontemporal_store(__builtin_bit_cast(v4u, *(const LAS bfx8*)(VO + (8 * i + wrow2) * 72 + wpc2 * 8)), (GAS v4u*)(Vout + (size_t)(rb + 8 * i + wrow2) * 1024 + wpc2 * 8));
    if (L == 0) {
#pragma unroll
        for (int i = 0; i < 2; ++i) *(GAS v4u*)(VFg + (size_t)(rb + 8 * i + wrow2) * 1024 + wpc2 * 8) = __builtin_bit_cast(v4u, *(const LAS bfx8*)(VO + (8 * i + wrow2) * 72 + wpc2 * 8)); }
    f32x4 Nm = {0.f, 0.f, 0.f, 0.f}, AK = Nm, RB = Nm, RK = Nm;
#pragma unroll
    for (int s = 0; s < 2; ++s) { const int o = c16 * 72 + 32 * s + 8 * g;
        const bfx8 at = *(const LAS bfx8*)(M + o), rt = *(const LAS bfx8*)(M + 1152 + o), bt = *(const LAS bfx8*)(M + 2304 + o), kt = *(const LAS bfx8*)(M + 3456 + o);
        Nm = __builtin_amdgcn_mfma_f32_16x16x32_bf16(bt, at, Nm, 0, 0, 0); AK = __builtin_amdgcn_mfma_f32_16x16x32_bf16(kt, at, AK, 0, 0, 0);
        RB = __builtin_amdgcn_mfma_f32_16x16x32_bf16(bt, rt, RB, 0, 0, 0); RK = __builtin_amdgcn_mfma_f32_16x16x32_bf16(kt, rt, RK, 0, 0, 0); }
#pragma unroll
    for (int e = 0; e < 4; ++e) { const int s = 4 * g + e; if (!(s < c16)) { Nm[e] = 0.f; AK[e] = 0.f; } if (!(s <= c16)) { RB[e] = 0.f; RK[e] = 0.f; } }
    *(LAS f32x4*)(NT + c16 * 16 + 4 * g) = Nm; *(LAS f32x4*)(AKT + c16 * 16 + 4 * g) = AK;
    { v4u o; o.x = cvt2(RB[0], RB[1]); o.y = cvt2(RB[2], RB[3]); o.z = cvt2(RK[0], RK[1]); o.w = cvt2(RK[2], RK[3]); __builtin_nontemporal_store(o, (GAS v4u*)(rec + CR_ARK + lane * 16)); }
    float X[16], Gx[16];
#pragma unroll
    for (int t = 0; t < 16; ++t) { float xa = Ah[t], xg = AKT[t * 16 + c16];
#pragma unroll
        for (int q = 0; q < (t + 3) / 4; ++q) { const f32x4 n4 = *(const LAS f32x4*)(NT + t * 16 + 4 * q);
#pragma unroll
            for (int e = 0; e < 4; ++e) if (4 * q + e < t) { xa += n4[e] * X[4 * q + e]; xg += n4[e] * Gx[4 * q + e]; } }
        X[t] = xa; Gx[t] = xg; }
#pragma unroll
    for (int t = 0; t < 16; t += 2) { const unsigned x2 = cvt2(X[t], X[t + 1]); M[t * 72 + lane] = (bf16)x2; M[(t + 1) * 72 + lane] = (bf16)(x2 >> 16); }
#pragma unroll
    for (int t = 0; t < 16; ++t) XGT[t * 16 + c16] = Gx[t];
#pragma unroll
    for (int s = 0; s < 2; ++s) { const int o = c16 * 72 + 32 * s + 4 * g;
        const v2u a0_ = __builtin_bit_cast(v2u, *(const LAS bfx4*)(M + o)), a1_ = __builtin_bit_cast(v2u, *(const LAS bfx4*)(M + o + 16)), r0_ = __builtin_bit_cast(v2u, *(const LAS bfx4*)(M + 1152 + o)), r1_ = __builtin_bit_cast(v2u, *(const LAS bfx4*)(M + 1152 + o + 16));
        __builtin_nontemporal_store((v4u){a0_.x, a0_.y, a1_.x, a1_.y}, (GAS v4u*)(rec + CR_AT + s * 1024 + lane * 16)); __builtin_nontemporal_store((v4u){r0_.x, r0_.y, r1_.x, r1_.y}, (GAS v4u*)(rec + CR_RT + s * 1024 + lane * 16)); }
    { const f32x4 xg = *(const LAS f32x4*)(XGT + c16 * 16 + 4 * g); v2u o; o.x = cvt2(xg[0], xg[1]); o.y = cvt2(xg[2], xg[3]); __builtin_nontemporal_store(o, (GAS v2u*)(rec + CR_GT + lane * 8)); }
    *(GAS float*)(rec + CR_W15 + lane * 4) = wex;
#pragma unroll
    for (int q = 0; q < 4; ++q) {
        __builtin_nontemporal_store((v4u){Bp[2 * q], Bp[2 * q + 1], Kq[2 * q], Kq[2 * q + 1]}, (GAS v4u*)(rec + CR_BK + g * 1024 + (c16 + 16 * q) * 16));
        __builtin_nontemporal_store((v2u){Vq[2 * q], Vq[2 * q + 1]}, (GAS v2u*)(rec + CR_VT + g * 512 + (c16 + 16 * q) * 8)); }
}
__device__ __forceinline__ void rwkv_chunk_rec(Frame& F, int L, int b, int h) {
    const int lane = F.lane, c16 = lane & 15, g = lane >> 4, w = F.wave;
    const GAS unsigned char* recs = F.ws + WS_OV + OV_CR + (size_t)(b * NH + h) * CH_N * CR_BYTES;
    LAS unsigned char* ring = F.lds + RING_OFF;
    constexpr int DIST = 6, NSLOT = 8;
    __syncthreads();
    if (w >= 4) {
        const int p0 = (w - 4) * 3;
#define CR_ISSUE(cc) do { const GAS unsigned char* gs_ = recs + (size_t)(cc) * CR_BYTES + p0 * 1024 + lane * 16; LAS unsigned char* ld_ = ring + ((cc) % NSLOT) * CR_BYTES + p0 * 1024; \
        _Pragma("unroll") for (int i_ = 0; i_ < 3; ++i_) __builtin_amdgcn_global_load_lds((const GAS unsigned*)(gs_ + i_ * 1024), (LAS unsigned*)(ld_ + i_ * 1024), 16, 0, 2); } while (0)
        for (int cc = 0; cc < DIST; ++cc) CR_ISSUE(cc);
        for (int c = 0; c < CH_N; ++c) {
            if (c + DIST < CH_N) { CR_ISSUE(c + DIST); asm volatile("s_waitcnt vmcnt(18)" ::: "memory"); } else asm volatile("s_waitcnt vmcnt(0)" ::: "memory");
            __builtin_amdgcn_s_barrier();
        }
#undef CR_ISSUE
    } else {
        f32x4 ST[4];
#pragma unroll
        for (int n = 0; n < 4; ++n) ST[n] = (f32x4){0.f, 0.f, 0.f, 0.f};
        v4u SB0 = {0u, 0u, 0u, 0u}, SB1 = SB0;
        GAS float* O = (GAS float*)(F.ws + WS_OV + OV_O) + h * HD + 16 * w + c16;
        for (int c = 0; c < CH_N; ++c) {
            __builtin_amdgcn_s_barrier(); asm volatile("" ::: "memory");
            const LAS unsigned char* sl = ring + (c % NSLOT) * CR_BYTES;
            const bfx8 AT0 = *(const LAS bfx8*)(sl + CR_AT + lane * 16), AT1 = *(const LAS bfx8*)(sl + CR_AT + 1024 + lane * 16), RT0 = *(const LAS bfx8*)(sl + CR_RT + lane * 16), RT1 = *(const LAS bfx8*)(sl + CR_RT + 1024 + lane * 16);
            const bfx8 ARK = *(const LAS bfx8*)(sl + CR_ARK + lane * 16);
            bfx8 BK[4]; f32x4 W15[4];
#pragma unroll
            for (int n = 0; n < 4; ++n) { BK[n] = *(const LAS bfx8*)(sl + CR_BK + n * 1024 + lane * 16); W15[n] = *(const LAS f32x4*)(sl + CR_W15 + (16 * n + 4 * g) * 4); }
            const v2u VT = *(const LAS v2u*)(sl + CR_VT + w * 512 + lane * 8), GT = *(const LAS v2u*)(sl + CR_GT + lane * 8);
            const bfx8 sb0 = __builtin_bit_cast(bfx8, SB0), sb1 = __builtin_bit_cast(bfx8, SB1);
            f32x4 Z = {0.f, 0.f, 0.f, 0.f}, OT = Z;
            Z = __builtin_amdgcn_mfma_f32_16x16x32_bf16(AT0, sb0, Z, 0, 0, 0); Z = __builtin_amdgcn_mfma_f32_16x16x32_bf16(AT1, sb1, Z, 0, 0, 0);
            Z = __builtin_amdgcn_mfma_f32_16x16x16bf16_1k(__builtin_bit_cast(bfx4, GT), __builtin_bit_cast(bfx4, VT), Z, 0, 0, 0);
            OT = __builtin_amdgcn_mfma_f32_16x16x32_bf16(RT0, sb0, OT, 0, 0, 0); OT = __builtin_amdgcn_mfma_f32_16x16x32_bf16(RT1, sb1, OT, 0, 0, 0);
            v4u zv; zv.x = cvt2(Z[0], Z[1]); zv.y = cvt2(Z[2], Z[3]); zv.z = VT.x; zv.w = VT.y;
            const bfx8 zvb = __builtin_bit_cast(bfx8, zv);
            OT = __builtin_amdgcn_mfma_f32_16x16x32_bf16(ARK, zvb, OT, 0, 0, 0);
#pragma unroll
            for (int n = 0; n < 4; ++n) ST[n] = __builtin_amdgcn_mfma_f32_16x16x32_bf16(BK[n], zvb, ST[n], 0, 0, 0) * W15[n];
            SB0.x = cvt2(ST[0][0], ST[0][1]); SB0.y = cvt2(ST[0][2], ST[0][3]); SB0.z = cvt2(ST[1][0], ST[1][1]); SB0.w = cvt2(ST[1][2], ST[1][3]);
            SB1.x = cvt2(ST[2][0], ST[2][1]); SB1.y = cvt2(ST[2][2], ST[2][3]); SB1.z = cvt2(ST[3][0], ST[3][1]); SB1.w = cvt2(ST[3][2], ST[3][3]);
            const int rb = c == 0 ? MR : b * SEQ + (c - 1) * CH_T;
#pragma unroll
            for (int e = 0; e < 4; ++e) __builtin_nontemporal_store(OT[e], O + (size_t)(rb + 4 * g + e) * RW_W);
        }
    }
    __syncthreads();
}
constexpr int CONV_EARLY = 4096;
__device__ __forceinline__ void conv_share(Frame& F, int L, int wg, int nwg, int lo, int hi) {
    LAS unsigned* cscr = (LAS unsigned*)(F.lds + RING_OFF + F.wave * 16384);
    for (int ct = lo + wg * NWAVES + F.wave; ct < hi; ct += nwg * NWAVES) { int m_, it_; if (!tr_decode(L, ct, m_, it_)) break;
        const TrDesc d = tr_desc(F, L, m_); f32x4 cv[16]; tr_tile_load(d, it_, F.lane, cv); tr_tile_finish(d, it_, F.lane, cv, cscr); }
}
struct PostIn { f32x4 o; v2u v, g; float rk; };
__device__ __forceinline__ PostIn rwkv_post_load(Frame& F, int row, int hq) {
    const int hl = F.lane >> 4, j = F.lane & 15, h = 4 * hq + hl, C = h * HD + 4 * j; const size_t RC = (size_t)row * RW_W + C;
    PostIn p; p.o = __builtin_nontemporal_load((const GAS f32x4*)((const GAS float*)(F.ws + WS_OV + OV_O) + RC));
    p.v = __builtin_nontemporal_load((const GAS v2u*)((const GAS bf16*)(F.ws + WS_OV + OV_RW) + RC));
    p.g = __builtin_nontemporal_load((const GAS v2u*)((const GAS bf16*)(F.ws + WS_OV + OV_GT) + RC));
    p.rk = ((const GAS float*)(F.ws + WS_OV + OV_RKS))[(size_t)row * NH + h];
    return p;
}
__device__ __forceinline__ f32x4 ub4(const v2u u) { return (f32x4){__uint_as_float(u.x << 16), __uint_as_float(u.x & 0xffff0000u), __uint_as_float(u.y << 16), __uint_as_float(u.y & 0xffff0000u)}; }
__device__ __forceinline__ void rwkv_post_finish(Frame& F, const PostIn& p, int row, int hq, const f32x4 lw, const f32x4 lb) {
    const int hl = F.lane >> 4, j = F.lane & 15, h = 4 * hq + hl, C = h * HD + 4 * j; const size_t RC = (size_t)row * RW_W + C;
    const f32x4 o = p.o;
    const float mean = row16_sum((o[0] + o[1]) + (o[2] + o[3])) * (1.0f / HD); const f32x4 d = o - mean;
    const float var = row16_sum((d[0] * d[0] + d[1] * d[1]) + (d[2] * d[2] + d[3] * d[3])) * (1.0f / HD);
    const float rs = rsqrtf(var + HD * 1e-5f);
    const f32x4 y = (d * rs * lw + lb + p.rk * ub4(p.v)) * ub4(p.g);
    v2u w; w.x = pk2(y[0], y[1]); w.y = pk2(y[2], y[3]);
    *(GAS v2u*)((GAS bf16*)(F.ws + WS_OV + OV_YB) + RC) = w;
}
__device__ __forceinline__ void rwkv_post_all(Frame& F, int L, int gw, int NGW) {
    const int hq = gw & 3;
    const int hl = F.lane >> 4, j = F.lane & 15, C = (4 * hq + hl) * HD + 4 * j; const size_t LC = (size_t)L * RW_W + C;
    const f32x4 lw = *(const GAS f32x4*)(inp(F, I_LNW) + LC), lb = *(const GAS f32x4*)(inp(F, I_LNB) + LC);
    constexpr int NT = MROWS * 4;
    for (int t = gw; t < NT; t += 4 * NGW) {
        PostIn p[4];
#pragma unroll
        for (int i = 0; i < 4; ++i) { const int ti = t + i * NGW; p[i] = rwkv_post_load(F, (ti < NT ? ti : t) >> 2, hq); }
#pragma unroll
        for (int i = 0; i < 4; ++i) { const int ti = t + i * NGW; if (ti < NT) rwkv_post_finish(F, p[i], ti >> 2, hq, lw, lb); }
    }
}
__device__ __forceinline__ void final_norm(Frame& F, GAS float* out) {
    const int gw = F.vcu * NWAVES + F.wave, NGW = F.G * NWAVES; const GAS float* gn = inp(F, I_FINN);
    for (int m = gw; m < MR; m += NGW) {
        f32x4 v[8]; float s = 0.f;
#pragma unroll
        for (int j = 0; j < 4; ++j) { pg8::unpackh8(((const GAS v4u*)(FX16(F) + (size_t)m * DM))[F.lane + 64 * j], v[2 * j], v[2 * j + 1]);
            s += ((v[2 * j][0] * v[2 * j][0] + v[2 * j][1] * v[2 * j][1]) + (v[2 * j][2] * v[2 * j][2] + v[2 * j][3] * v[2 * j][3])) + ((v[2 * j + 1][0] * v[2 * j + 1][0] + v[2 * j + 1][1] * v[2 * j + 1][1]) + (v[2 * j + 1][2] * v[2 * j + 1][2] + v[2 * j + 1][3] * v[2 * j + 1][3])); }
        const float inv = rsqrtf(wave_sum(s) * (1.0f / DM) + NORM_EPS);
#pragma unroll
        for (int j = 0; j < 4; ++j) { const int c8 = 8 * (F.lane + 64 * j);
            ((GAS f32x4*)(out + (size_t)m * DM + c8))[0] = v[2 * j] * inv * ((const GAS f32x4*)(gn + c8))[0]; ((GAS f32x4*)(out + (size_t)m * DM + c8))[1] = v[2 * j + 1] * inv * ((const GAS f32x4*)(gn + c8))[1]; }
    }
}
constexpr int INVTAB_OFF = LDSCTL_OFF + 4096;
__device__ __forceinline__ const LAS float* fill_inv_table(Frame& F, const GAS unsigned long long* ss, int G, int c) {
    if (G != 256) return nullptr;
    LAS float* tab = (LAS float*)(F.lds + INVTAB_OFF); const int base = 8 * (c & 7) * 256;
#pragma unroll
    for (int i = 0; i < 4; ++i) { const int r = F.tid + 512 * i; tab[r] = rsqrtf((float)(long long)ss[base + r] * (pg8::SS_INV_SCALE / (float)DM) + 1e-6f); }
    __syncthreads();
    return tab;
}
constexpr int NPH = 14;
struct Args { const float* in[N_IN]; float* out; unsigned char* ws; int l_lo, l_hi, ph_lo, ph_hi; };
__global__ void __launch_bounds__(NWAVES * 64, 2) mk_fwd(Args args) {
    extern __shared__ __attribute__((aligned(16))) unsigned char lds[];
    Frame F;
    F.lds = (LAS unsigned char*)lds;
    F.MISC = (volatile LAS unsigned*)(F.lds + MISC_OFF);
    F.tid = threadIdx.x; F.lane = F.tid & 63; F.wave = __builtin_amdgcn_readfirstlane(F.tid >> 6);
    F.G = gridDim.x; { const int bx = blockIdx.x; F.vcu = (F.G % 8 == 0) ? (bx % 8) * (F.G / 8) + bx / 8 : bx; }
    F.ws = (GAS unsigned char*)args.ws;
    F.ctl = (gu32*)(args.ws + WS_CTL);
    for (int u = F.tid; u < (LDS_BYTES - LDSCTL_OFF) / 4; u += NWAVES * 64) ((LAS unsigned*)(F.lds + LDSCTL_OFF))[u] = 0u;
    __syncthreads();
    if (F.tid < N_IN) ((LAS unsigned long long*)(F.lds + LDSCTL_OFF))[F.tid] = (unsigned long long)args.in[F.tid];
    __syncthreads();
    XcdBarrier bar; bar.bar = (unsigned*)(F.ctl + CW_BAR); bar.x = 0; bar.st = nullptr;
    if (!MK_MULTI) bar = xcd_barrier_post((unsigned*)(F.ctl + CW_BAR), F.MISC + 8);
#define GRID_BAR() do { if (MK_MULTI) { if (F.tid == 0) __hip_atomic_store(F.ctl + CW_TMO, 0xBADBA0u, RLX_AGENT); } else { xcd_barrier(bar); } } while (0)
    const int lo = args.ph_lo, hi = args.ph_hi;
#ifndef PH_MASK
#define PH_MASK 0x3FFF
#endif
#define IN(k) ((((PH_MASK) >> (k)) & 1) && lo <= (k) && (k) < hi)
#define BOTH(k) (IN(k) && IN((k) + 1))
#ifndef REPEAT_MASK
#define REPEAT_MASK 0
#endif
#define PHASE(k) for (int rep_ = (IN(k) ? 1 + (((REPEAT_MASK) >> (k)) & 1) : 0); rep_ > 0; --rep_)
    const int wave0_ = __builtin_amdgcn_readfirstlane((int)threadIdx.x >> 6);
#define PH_ENV() int lane_; asm volatile("v_mbcnt_lo_u32_b32 %0, -1, 0\n\tv_mbcnt_hi_u32_b32 %0, -1, %0" : "=v"(lane_));     \
    unsigned char* wsl_ = args.ws; int bx_ = (int)blockIdx.x, tid_ = (wave0_ << 6) | lane_, G_ = (int)gridDim.x, Lp = L; asm volatile("" : "+s"(wsl_), "+s"(bx_), "+s"(G_), "+s"(Lp), "+v"(tid_)); GAS unsigned char* wsl = (GAS unsigned char*)wsl_; \
    F.ws = wsl; F.tid = tid_; F.lane = tid_ & 63; F.wave = __builtin_amdgcn_readfirstlane(tid_ >> 6); F.G = G_; F.vcu = (G_ % 8 == 0) ? (bx_ % 8) * (G_ / 8) + bx_ / 8 : bx_; \
    GAS unsigned char* ov = wsl + WS_OV; GAS unsigned char* wb = wsl + WS_W + (size_t)(Lp & 1) * W_SLOT; (void)ov; (void)wb; \
    const int gw = F.vcu * NWAVES + F.wave, NGW = F.G * NWAVES; (void)gw; (void)NGW;

    for (int L = args.l_lo; L < args.l_hi; ++L) {
        PHASE(0) { PH_ENV();
            if (Lp == 0 || G_ != 256) {
                if (Lp == 0) px_init(F);
                s5_build(F, Lp); lora_weights(F, Lp); pw_zero_rows(F, Lp);
                if (Lp == 0) { __syncthreads(); conv_share(F, 0, bx_, G_, 0, 1 << 30); }
                if (BOTH(0)) GRID_BAR(); } }
        PHASE(1) { PH_ENV();
            pg8::Gemm g{FXB(F), (const GAS bf16*)(wb + WO_GU1), MR, 2 * DFF, DM}; pg8::StaticOrder S; S.init(MR, 2 * DFF, G_, bx_);
            pg8::EpiSwiglu E{FSSC(F), (GAS bf16*)(ov + OV_ACT), DFF, fill_inv_table(F, FSSC(F), G_, bx_)};
            pg8::gemm_phase<pg8::EpiSwiglu, pg8::StaticOrder, true, true>(F.lds + RING_OFF, g, S, E, tid_); pg8::thin_gemm(F.lds + RING_OFF, g, E, G_, bx_, MR, tid_);
            if (BOTH(1)) GRID_BAR();
        }
        PHASE(2) { PH_ENV();
            pg8::Gemm g{(const GAS bf16*)(ov + OV_ACT), (const GAS bf16*)(wb + WO_D1), MR, DM, DFF}; pg8::StaticOrder S; S.init(MR, DM, G_, bx_);
            pg8::EpiResid E{FX16(F), FXB(F), FSSA(F), ((REPEAT_MASK & 4) && rep_ == 2) ? 0.0f : 0.5f, ((REPEAT_MASK & 4) && rep_ == 2) ? 1 : 0};
            pg8::gemm_phase<pg8::EpiResid, pg8::StaticOrder, true, true>(F.lds + RING_OFF, g, S, E, tid_); pg8::thin_gemm(F.lds + RING_OFF, g, E, G_, bx_, MR, tid_);
            if (BOTH(2)) GRID_BAR();
        }
        PHASE(3) { PH_ENV();
            pg8::Gemm g{FXB(F), (const GAS bf16*)(wb + WO_IN), MR, NIN, DM}; pg8::StaticOrder S; S.init(MR, NIN, G_, bx_);
            typedef pg8::EpiWin<OV_U2, OV_RKV, OV_GA, OV_GB, OV_LIN, MP> EpiW; EpiW E{FSSA(F), ov, fill_inv_table(F, FSSA(F), G_, bx_)};
            pg8::gemm_phase<EpiW, pg8::StaticOrder, true, true>(F.lds + RING_OFF, g, S, E, tid_); pg8::thin_gemm(F.lds + RING_OFF, g, E, G_, bx_, MR, tid_);
            if (Lp + 1 < DEPTH && G_ == 256 && bx_ >= 128) { const int vs = F.vcu, gs = F.G; F.vcu = bx_ - 128; F.G = 128; s5_build(F, Lp + 1); lora_weights(F, Lp + 1); pw_zero_rows(F, Lp + 1); F.vcu = vs; F.G = gs;
                __syncthreads(); conv_share(F, Lp + 1, bx_ - 128, 128, 0, CONV_EARLY); }
            if (BOTH(3)) GRID_BAR();
        }
        PHASE(4) { PH_ENV();
            { unsigned zlo = 0u; asm volatile("" : "+v"(zlo)); const unsigned long long z64 = zlo;
              for (int i = bx_ * (NWAVES * 64) + F.tid; i < MP; i += F.G * NWAVES * 64) { FSSA(F)[i] = z64; FSSB(F)[i] = z64; FSSC(F)[i] = z64; } }
            for (int u = F.vcu; u < BATCH * NG; u += F.G) s5_unit(F, Lp, u >> 6, u & 63);
            lora_inputs(F, Lp);
            if (BOTH(4)) GRID_BAR();
        }
        PHASE(5) { PH_ENV();
            { int KL = LKP; asm volatile("" : "+s"(KL));
              pg8::Gemm g{(const GAS bf16*)(ov + OV_LA), (const GAS bf16*)(wb + WO_LORA) + (size_t)2048 * LKP, MR, 1024, KL}; pg8::StaticOrder S; S.init(MR, 1024, G_, bx_);
              typedef pg8::EpiLora<OV_GT, OV_GT, OV_GT, OV_GT> EpiL; EpiL E{ov};
              pg8::gemm_phase<EpiL, pg8::StaticOrder, true, true>(F.lds + RING_OFF, g, S, E, tid_); pg8::thin_gemm(F.lds + RING_OFF, g, E, G_, bx_, MR, tid_); }
        }
        PHASE(6) { PH_ENV();
            { pg8::Gemm g{(const GAS bf16*)(ov + OV_YPRE), (const GAS bf16*)(wb + WO_GLU), MR, SW, SW}; pg8::StaticOrder S; S.init(MR, SW, G_, bx_);
              pg8::EpiGlu E{(const GAS bf16*)(ov + OV_YPRE), (GAS bf16*)(ov + OV_YA), SW};
              pg8::gemm_phase<pg8::EpiGlu, pg8::StaticOrder, true, true>(F.lds + RING_OFF, g, S, E, tid_); pg8::thin_gemm(F.lds + RING_OFF, g, E, G_, bx_, MR, tid_); }
            __syncthreads();
            { const int bh = gw & 63; const LAS float* pp = rwkv_prep_par(F, Lp, bh & 15);
              for (int it = gw; it < BATCH * NH * CH_N; it += NGW) { int bb = bh >> 4, hh = bh & 15; asm volatile("" : "+s"(bb), "+s"(hh));
                  rwkv_prep_item(F, Lp, bb, hh, it >> 6, pp); } }
            if (IN(6) && IN(7)) GRID_BAR();
        }
        PHASE(7) { PH_ENV();
            const int nrec = G_ > 64 ? 64 : G_;
            for (int u = bx_; u < BATCH * NH; u += nrec) { if (bx_ < nrec) rwkv_chunk_rec(F, Lp, u >> 4, u & 15); else break; }
            if (Lp + 1 < DEPTH) { const int lo = G_ == 256 ? CONV_EARLY : 0; if (G_ > 64) { if (bx_ >= 64) conv_share(F, Lp + 1, bx_ - 64, G_ - 64, lo, 1 << 30); } else conv_share(F, Lp + 1, bx_, G_, lo, 1 << 30); }
            else if (G_ > 64 && bx_ >= 64) {
                pg8::Gemm g{(const GAS bf16*)(ov + OV_YA), (const GAS bf16*)(wb + WO_UA), MR, DM, SW}; pg8::StaticOrder S; S.init(MR, DM, G_ - 64, bx_ - 64);
                pg8::EpiGateMul<false> E{(const GAS bf16*)(ov + OV_GA), (GAS bf16*)(ov + OV_MG)};
                pg8::gemm_phase<pg8::EpiGateMul<false>, pg8::StaticOrder, true, true>(F.lds + RING_OFF, g, S, E, tid_); pg8::thin_gemm(F.lds + RING_OFF, g, E, G_ - 64, bx_ - 64, MR, tid_); }
            if (BOTH(7)) GRID_BAR();
        }
        PHASE(8) { PH_ENV();
            rwkv_post_all(F, Lp, gw, NGW);
            if (!(Lp + 1 == DEPTH && G_ > 64))
            { pg8::Gemm g{(const GAS bf16*)(ov + OV_YA), (const GAS bf16*)(wb + WO_UA), MR, DM, SW}; pg8::StaticOrder S; S.init(MR, DM, G_, bx_);
              pg8::EpiGateMul<false> E{(const GAS bf16*)(ov + OV_GA), (GAS bf16*)(ov + OV_MG)};
              pg8::gemm_phase<pg8::EpiGateMul<false>, pg8::StaticOrder, true, true>(F.lds + RING_OFF, g, S, E, tid_); pg8::thin_gemm(F.lds + RING_OFF, g, E, G_, bx_, MR, tid_); }
            if (BOTH(8)) GRID_BAR();
        }
        PHASE(9) { PH_ENV();
            pg8::Gemm g{(const GAS bf16*)(ov + OV_YB), (const GAS bf16*)(wb + WO_UB), MR, DM, RW_W}; pg8::StaticOrder S; S.init(MR, DM, G_, bx_);
            pg8::EpiGateMul<true> E{(const GAS bf16*)(ov + OV_GB), (GAS bf16*)(ov + OV_MG)};
            pg8::gemm_phase<pg8::EpiGateMul<true>, pg8::StaticOrder, true, true>(F.lds + RING_OFF, g, S, E, tid_); pg8::thin_gemm(F.lds + RING_OFF, g, E, G_, bx_, MR, tid_);
            if (BOTH(9)) GRID_BAR();
        }
        PHASE(10) { PH_ENV();
            pg8::Gemm g{(const GAS bf16*)(ov + OV_MG), (const GAS bf16*)(wb + WO_O), MR, DM, DM}; pg8::StaticOrder S; S.init(MR, DM, G_, bx_);
            pg8::EpiResid E{FX16(F), FXB(F), FSSB(F), 1.0f};
            pg8::gemm_phase<pg8::EpiResid, pg8::StaticOrder, true, true>(F.lds + RING_OFF, g, S, E, tid_); pg8::thin_gemm(F.lds + RING_OFF, g, E, G_, bx_, MR, tid_);
            if (BOTH(10)) GRID_BAR();
        }
        PHASE(11) { PH_ENV();
            pg8::Gemm g{FXB(F), (const GAS bf16*)(wb + WO_GU2), MR, 2 * DFF, DM}; pg8::StaticOrder S; S.init(MR, 2 * DFF, G_, bx_);
            pg8::EpiSwiglu E{FSSB(F), (GAS bf16*)(ov + OV_ACT), DFF, fill_inv_table(F, FSSB(F), G_, bx_)};
            pg8::gemm_phase<pg8::EpiSwiglu, pg8::StaticOrder, true, true>(F.lds + RING_OFF, g, S, E, tid_); pg8::thin_gemm(F.lds + RING_OFF, g, E, G_, bx_, MR, tid_);
            if (BOTH(11)) GRID_BAR();
        }
        PHASE(12) { PH_ENV();
            pg8::Gemm g{(const GAS bf16*)(ov + OV_ACT), (const GAS bf16*)(wb + WO_D2), MR, DM, DFF}; pg8::StaticOrder S; S.init(MR, DM, G_, bx_);
            pg8::EpiResid E{FX16(F), FXB(F), FSSC(F), 0.5f};
            pg8::gemm_phase<pg8::EpiResid, pg8::StaticOrder, true, true>(F.lds + RING_OFF, g, S, E, tid_); pg8::thin_gemm(F.lds + RING_OFF, g, E, G_, bx_, MR, tid_);
            if (IN(13) || L + 1 < args.l_hi) GRID_BAR();
        }
        if (IN(13) && L == DEPTH - 1) { PH_ENV(); final_norm(F, (GAS float*)args.out); }
    }
#undef IN
#undef BOTH
}

extern "C" void kernel_launch(void* const* d_in, const int* in_sizes, int n_in, void* d_out, int out_size, void* d_ws, size_t ws_size, hipStream_t stream) {
    static int grid = 0;
    if (grid == 0) {
        if (n_in != N_IN || in_sizes[0] != MR * DM || out_size != MR * DM || ws_size < WS_END) {
            fprintf(stderr, "kernel_launch: built for %d inputs, x/out of %d floats, >= %zu bytes of workspace; got n_in %d, in0 %d, out %d, ws %zu; nothing launched\n", (int)N_IN, MR * DM, (size_t)WS_END, n_in, n_in > 0 ? in_sizes[0] : -1, out_size, ws_size);
            grid = -1; return; }
        int dev = 0, cus = 0, per_cu = 0;
        if (hipGetDevice(&dev) != hipSuccess || hipDeviceGetAttribute(&cus, hipDeviceAttributeMultiprocessorCount, dev) != hipSuccess) { fprintf(stderr, "kernel_launch: device query failed\n"); grid = -1; return; }
        if (hipFuncSetAttribute((const void*)mk_fwd, hipFuncAttributeMaxDynamicSharedMemorySize, LDS_BYTES) != hipSuccess) { fprintf(stderr, "kernel_launch: hipFuncSetAttribute failed\n"); grid = -1; return; }
        if (hipOccupancyMaxActiveBlocksPerMultiprocessor(&per_cu, (const void*)mk_fwd, NWAVES * 64, LDS_BYTES) != hipSuccess || per_cu < 1)
            fprintf(stderr, "kernel_launch: note: occupancy query reports %d workgroups per CU\n", per_cu);
        (void)hipGetLastError();
        grid = cus;
    }
    if (grid < 0) return;
    if (hipMemsetAsync((char*)d_ws + WS_CTL, 0, CTL_ZERO_BYTES, stream) != hipSuccess) { fprintf(stderr, "kernel_launch: memset failed\n"); return; }
    Args a{};
    for (int i = 0; i < N_IN; ++i) a.in[i] = (const float*)d_in[i];
    a.out = (float*)d_out; a.ws = (unsigned char*)d_ws;
#if MK_MULTI
    for (int L = 0; L < DEPTH; ++L) for (int p = 0; p < NPH; ++p) { if (p == NPH - 1 && L != DEPTH - 1) continue; a.l_lo = L; a.l_hi = L + 1; a.ph_lo = p; a.ph_hi = p + 1;
        hipLaunchKernelGGL(mk_fwd, dim3(grid), dim3(NWAVES * 64), LDS_BYTES, stream, a); }
#else
    a.l_lo = 0; a.l_hi = DEPTH; a.ph_lo = 0; a.ph_hi = NPH;
    hipLaunchKernelGGL(mk_fwd, dim3(grid), dim3(NWAVES * 64), LDS_BYTES, stream, a);
#endif
    const hipError_t le = hipPeekAtLastError();
    if (le != hipSuccess) fprintf(stderr, "kernel_launch: launch failed: %s\n", hipGetErrorName(le));
}
```

```cpp
#include <hip/hip_runtime.h>
#include <cstdio>
#include <cstdint>
namespace pg8 {
#define PG8_LAS __attribute__((address_space(3)))
#define PG8_GAS __attribute__((address_space(1)))
typedef unsigned short bf16_t;
typedef short bf16x8 __attribute__((ext_vector_type(8)));
typedef _Float16 f16x8 __attribute__((ext_vector_type(8)));
typedef float f32x4 __attribute__((ext_vector_type(4)));
typedef unsigned u32x4 __attribute__((ext_vector_type(4)));
constexpr int BM = 256, BK = 64, HALF = 128, HTB = HALF * BK * 2  , STAGE_BYTES = 8 * HTB, NXCD = 8, WGM = 8;

__host__ __device__ __forceinline__ int lds_byte(int r, int c) { const int st = (r >> 4) * 2 + (c >> 5), rr = r & 15, cc = c & 31, ob = rr * 64 + cc * 2; return st * 1024 + (ob ^ (((ob >> 9) & 1) << 5)); }
__host__ __device__ __forceinline__ void stage_rc(int b, int& R, int& C) { const int st = b / 1024, sb = b % 1024, swz = sb ^ (((sb >> 9) & 1) << 5); R = (st >> 1) * 16 + swz / 64; C = (st & 1) * 32 + (swz % 64) / 2; }
__host__ __device__ __forceinline__ int perm32(int rho) { const int n = rho >> 4, i = rho & 15; return 8 * (i >> 2) + 4 * n + (i & 3); }

struct Unit { int pm, pn; };
struct Gemm { const PG8_GAS bf16_t* A; const PG8_GAS bf16_t* Bt; int M, N, K; };

struct StaticOrder {
    int nM, nN, nwg, G, c;
    __host__ __device__ void init(int M, int N, int G_, int c_) { nM = M / BM; nN = N / BM; nwg = nM * nN; G = G_; c = c_; }
    __host__ __device__ bool next(int i, Unit& u) const {
        const long L = (long)i * G + c; if (L >= nwg) return false;
        int wgid = (int)L; { const int q = nwg / NXCD, r = nwg % NXCD, xcd = wgid % NXCD, off = wgid / NXCD; wgid = (xcd < r ? xcd * (q + 1) : r * (q + 1) + (xcd - r) * q) + off; }
        const int nig = WGM * nN, gid = wgid / nig, fm = gid * WGM, gsz = (nM - fm) < WGM ? (nM - fm) : WGM;
        u.pm = fm + ((wgid % nig) % gsz); u.pn = (wgid % nig) / gsz;
#if defined(__HIP_DEVICE_COMPILE__)
        u.pm = __builtin_amdgcn_readfirstlane(u.pm); u.pn = __builtin_amdgcn_readfirstlane(u.pn);
#endif
        return true;
    }
    __device__ __forceinline__ void a_ready(const Unit&) const {}
    __device__ __forceinline__ void done(const Unit&) const {}
};

__device__ __forceinline__ unsigned cvt_pk_bf16(float lo, float hi) { unsigned r; asm volatile("v_cvt_pk_bf16_f32 %0, %1, %2" : "=v"(r) : "v"(lo), "v"(hi)); return r; }
typedef float f32x2 __attribute__((ext_vector_type(2)));
__device__ __forceinline__ f32x2 gelu_pk(f32x2 v) {
    const f32x2 av = __builtin_elementwise_abs(v), d = av * 0.2316418882f + 1.0f;
    f32x2 t; t.x = __builtin_amdgcn_rcpf(d.x); t.y = __builtin_amdgcn_rcpf(d.y);
    f32x2 q = t * 0.5307027145f + (-0.7265760135f); q = q * t + 0.7107068705f; q = q * t + (-0.142248368f); q = q * t + 0.127414796f; q = q * t;
    const f32x2 s = (v * v) * (-0.72134752044f);
    f32x2 e; e.x = __builtin_amdgcn_exp2f(s.x); e.y = __builtin_amdgcn_exp2f(s.y);
    const f32x2 m = v * (q * e), r = v - m;
    f32x2 o; o.x = v.x < 0.f ? m.x : r.x; o.y = v.y < 0.f ? m.y : r.y; return o;
}

template <int ACT  > struct EpiBf16 {
    static constexpr bool PERM = true, AFTER_DRAIN = false; static_assert(ACT == 0 || ACT == 1, "EpiBf16: ACT is 0 (none) or 1 (gelu_pk)");
    bf16_t* O; int ldc; const float* bias; int split_cols; size_t split_stride; float scale0;
    __device__ __forceinline__ void operator()(const f32x4 (&acc)[2][2][4][2], const Unit& u, int wr, int wc, int fr, int fq) const {
        const int row0 = u.pm * BM + wr * 64 + fr; int colt = u.pn * BM; bf16_t* base = O;
        float sc = 1.f; if (split_cols) { const int t = colt / split_cols; base += (size_t)t * split_stride; colt -= t * split_cols; if (t == 0) sc = scale0; }
        const int col0 = colt + wc * 32 + 8 * fq, bcol0 = u.pn * BM + wc * 32 + 8 * fq;
        f32x4 bv[2][2];
#pragma unroll
        for (int bj = 0; bj < 2; ++bj)
#pragma unroll
            for (int n = 0; n < 2; ++n) bv[bj][n] = bias ? *(const f32x4*)(bias + bcol0 + bj * HALF + 4 * n) : (f32x4){0.f, 0.f, 0.f, 0.f};
#pragma unroll
        for (int ai = 0; ai < 2; ++ai)
#pragma unroll
            for (int m = 0; m < 4; ++m) { bf16_t* rowp = base + (size_t)(row0 + ai * HALF + m * 16) * ldc + col0;
#pragma unroll
                for (int bj = 0; bj < 2; ++bj) { f32x4 v0 = acc[ai][bj][m][0] + bv[bj][0], v1 = acc[ai][bj][m][1] + bv[bj][1];
                    if (ACT == 1) { f32x2 a = gelu_pk((f32x2){v0[0], v0[1]}), b = gelu_pk((f32x2){v0[2], v0[3]}), c = gelu_pk((f32x2){v1[0], v1[1]}), d = gelu_pk((f32x2){v1[2], v1[3]});
                        v0 = (f32x4){a.x, a.y, b.x, b.y}; v1 = (f32x4){c.x, c.y, d.x, d.y}; }
                    v0 = v0 * sc; v1 = v1 * sc; u32x4 w; w.x = cvt_pk_bf16(v0[0], v0[1]); w.y = cvt_pk_bf16(v0[2], v0[3]); w.z = cvt_pk_bf16(v1[0], v1[1]); w.w = cvt_pk_bf16(v1[2], v1[3]);
                    *(u32x4*)(rowp + bj * HALF) = w; } }
    }
};


template <class Epi, class Sched, bool ALIGN_EPI = false, bool SP2 = false, bool F16 = false>
__device__ __forceinline__ void gemm_phase(PG8_LAS unsigned char* lds, const Gemm g, const Sched& S, const Epi& E, const int tid) {
    const int wid = __builtin_amdgcn_readfirstlane(tid >> 6), lane = tid & 63, wr = wid >> 2, wc = wid & 3, fr = lane & 15, fq = lane >> 4;
    const int K = g.K, nt = K / BK;
    unsigned voffA[2], voffB[2];
#pragma unroll
    for (int i = 0; i < 2; ++i) { int R, C; stage_rc(tid * 16 + i * 8192, R, C); const int Rb = Epi::PERM ? ((R & ~31) + perm32(R & 31)) : R;
        voffA[i] = (unsigned)(R * K + C) * 2u; voffB[i] = (unsigned)(Rb * K + C) * 2u; }
    const size_t kstep = (size_t)(BK * 2);
    const size_t hstep = (size_t)HALF * K * 2;
    const size_t tstep = 2 * hstep;
    const unsigned ldsw = (unsigned)wid * 1024u;
    const int aoff = lds_byte(wr * 64 + fr, fq * 8), boff = lds_byte(wc * 32 + fr, fq * 8);
#define PG8_SA(b, h) (((b) * 2 + (h)) * HTB)
#define PG8_SB(b, h) ((4 + (b) * 2 + (h)) * HTB)
#define PG8_STAGE(bufoff, gbase, voff) do { _Pragma("unroll") for (int _i = 0; _i < 2; ++_i) \
        __builtin_amdgcn_global_load_lds((const PG8_GAS unsigned*)((const PG8_GAS char*)(gbase) + (voff)[_i]), (PG8_LAS unsigned*)(lds + (bufoff) + ldsw + _i * 8192), 16, 0, 0); } while (0)
#define PG8_LDA(dst, b, h) do { _Pragma("unroll") for (int m = 0; m < 4; ++m) _Pragma("unroll") for (int k = 0; k < 2; ++k) dst[m][k] = *(const PG8_LAS bf16x8*)(lds + PG8_SA(b, h) + aoff + m * 2048 + k * 1024); } while (0)
#define PG8_LDB(dst, b, h) do { _Pragma("unroll") for (int n = 0; n < 2; ++n) _Pragma("unroll") for (int k = 0; k < 2; ++k) dst[n][k] = *(const PG8_LAS bf16x8*)(lds + PG8_SB(b, h) + boff + n * 2048 + k * 1024); } while (0)
#define PG8_MMA(ai, bj, At, Bt) do { __builtin_amdgcn_s_setprio(1); _Pragma("unroll") for (int m = 0; m < 4; ++m) _Pragma("unroll") for (int n = 0; n < 2; ++n) _Pragma("unroll") for (int k = 0; k < 2; ++k) \
        acc[ai][bj][m][n] = F16 ? __builtin_amdgcn_mfma_f32_16x16x32_f16(__builtin_bit_cast(f16x8, Bt[n][k]), __builtin_bit_cast(f16x8, At[m][k]), acc[ai][bj][m][n], 0, 0, 0) \
                                : __builtin_amdgcn_mfma_f32_16x16x32_bf16(Bt[n][k], At[m][k], acc[ai][bj][m][n], 0, 0, 0); __builtin_amdgcn_s_setprio(0); } while (0)
#define PG8_WAIT_V(n) asm volatile("s_waitcnt vmcnt(" #n ")" ::: "memory")
#define PG8_WAIT_L(n) asm volatile("s_waitcnt lgkmcnt(" #n ")" ::: "memory")
#define PG8_BAR __builtin_amdgcn_s_barrier()
#define PG8_SCHED __builtin_amdgcn_sched_barrier(0)
    Unit cur, nxt; int ui = 0;
    if (!S.next(0, cur)) return;
    f32x4 acc[2][2][4][2];
#pragma unroll
    for (int a = 0; a < 2; ++a)
#pragma unroll
        for (int b = 0; b < 2; ++b)
#pragma unroll
            for (int m = 0; m < 4; ++m)
#pragma unroll
                for (int n = 0; n < 2; ++n) acc[a][b][m][n] = (f32x4){0.f, 0.f, 0.f, 0.f};
    bf16x8 At[4][2], B0[2][2], B1[2][2];
    const PG8_GAS char* cA = (const PG8_GAS char*)g.A + (size_t)cur.pm * tstep; const PG8_GAS char* cB = (const PG8_GAS char*)g.Bt + (size_t)cur.pn * tstep;
    S.a_ready(cur);
    if constexpr (SP2) {
        PG8_STAGE(PG8_SB(0, 0), cB, voffB); PG8_STAGE(PG8_SB(0, 1), cB + hstep, voffB); PG8_STAGE(PG8_SA(0, 0), cA, voffA); PG8_STAGE(PG8_SA(0, 1), cA + hstep, voffA);
        if (wr == 1) PG8_BAR;
        PG8_WAIT_V(2); PG8_BAR;
        PG8_STAGE(PG8_SB(1, 0), cB + kstep, voffB); PG8_STAGE(PG8_SA(1, 0), cA + kstep, voffA); PG8_STAGE(PG8_SB(1, 1), cB + hstep + kstep, voffB);
        PG8_WAIT_V(6); PG8_BAR;
    } else {
        PG8_STAGE(PG8_SB(0, 0), cB, voffB); PG8_STAGE(PG8_SA(0, 0), cA, voffA); PG8_STAGE(PG8_SB(0, 1), cB + hstep, voffB); PG8_STAGE(PG8_SA(0, 1), cA + hstep, voffA);
        if (wr == 1) PG8_BAR;
        PG8_WAIT_V(4); PG8_BAR;
        PG8_STAGE(PG8_SB(1, 0), cB + kstep, voffB); PG8_STAGE(PG8_SA(1, 0), cA + kstep, voffA); PG8_STAGE(PG8_SB(1, 1), cB + hstep + kstep, voffB);
        PG8_WAIT_V(6); PG8_BAR;
    }
    for (;;) {
        const bool has_next = S.next(ui + 1, nxt);
        const PG8_GAS char* nA = has_next ? (const PG8_GAS char*)g.A + (size_t)nxt.pm * tstep : cA; const PG8_GAS char* nB = has_next ? (const PG8_GAS char*)g.Bt + (size_t)nxt.pn * tstep : cB;
        for (int t = 0; t < nt; t += 2) {
            const bool last = (t == nt - 2);
            const PG8_GAS char* a1 = cA + (size_t)(t + 1) * kstep;
            const PG8_GAS char* a2 = last ? nA : cA + (size_t)(t + 2) * kstep; const PG8_GAS char* b2 = last ? nB : cB + (size_t)(t + 2) * kstep;
            const PG8_GAS char* a3 = a2 + kstep; const PG8_GAS char* b3 = b2 + kstep;
            if (last && has_next) S.a_ready(nxt);
            if constexpr (SP2) {
            PG8_LDB(B0, 0, 0); PG8_LDB(B1, 0, 1); PG8_SCHED; PG8_LDA(At, 0, 0); PG8_STAGE(PG8_SA(1, 1), a1 + hstep, voffA);
            PG8_WAIT_V(8); PG8_WAIT_L(0); PG8_BAR; PG8_MMA(0, 0, At, B0); PG8_MMA(0, 1, At, B1); PG8_BAR; PG8_SCHED;
            PG8_LDA(At, 0, 1); PG8_STAGE(PG8_SB(0, 0), b2, voffB); PG8_STAGE(PG8_SB(0, 1), b2 + hstep, voffB); PG8_STAGE(PG8_SA(0, 0), a2, voffA);
            PG8_WAIT_V(8); PG8_WAIT_L(0); PG8_BAR; PG8_MMA(1, 0, At, B0); PG8_MMA(1, 1, At, B1); PG8_BAR; PG8_SCHED;
            PG8_LDB(B0, 1, 0); PG8_LDB(B1, 1, 1); PG8_SCHED; PG8_LDA(At, 1, 0); PG8_STAGE(PG8_SA(0, 1), a2 + hstep, voffA);
            PG8_WAIT_V(8); PG8_WAIT_L(0); PG8_BAR; PG8_MMA(0, 0, At, B0); PG8_MMA(0, 1, At, B1); PG8_BAR; PG8_SCHED;
            PG8_LDA(At, 1, 1); PG8_STAGE(PG8_SB(1, 0), b3, voffB); PG8_STAGE(PG8_SB(1, 1), b3 + hstep, voffB); PG8_STAGE(PG8_SA(1, 0), a3, voffA);
            PG8_WAIT_V(8); PG8_WAIT_L(0); PG8_BAR; PG8_MMA(1, 0, At, B0); PG8_MMA(1, 1, At, B1); PG8_BAR; PG8_SCHED;
            } else {
            PG8_LDB(B0, 0, 0); PG8_SCHED; PG8_LDA(At, 0, 0); PG8_STAGE(PG8_SA(1, 1), a1 + hstep, voffA);
            PG8_WAIT_L(8); PG8_BAR; PG8_WAIT_L(0); PG8_MMA(0, 0, At, B0); PG8_BAR; PG8_SCHED;
            PG8_LDB(B1, 0, 1); PG8_STAGE(PG8_SB(0, 0), b2, voffB);
            PG8_BAR; PG8_WAIT_L(0); PG8_MMA(0, 1, At, B1); PG8_BAR;
            PG8_LDA(At, 0, 1); PG8_STAGE(PG8_SA(0, 0), a2, voffA);
            PG8_BAR; PG8_WAIT_L(0); PG8_MMA(1, 0, At, B0); PG8_BAR; PG8_SCHED;
            PG8_STAGE(PG8_SB(0, 1), b2 + hstep, voffB);
            PG8_WAIT_V(6); PG8_BAR; PG8_MMA(1, 1, At, B1); PG8_BAR;
            PG8_LDB(B0, 1, 0); PG8_SCHED; PG8_LDA(At, 1, 0); PG8_STAGE(PG8_SA(0, 1), a2 + hstep, voffA);
            PG8_WAIT_L(8); PG8_BAR; PG8_WAIT_L(0); PG8_MMA(0, 0, At, B0); PG8_BAR; PG8_SCHED;
            PG8_LDB(B1, 1, 1); PG8_STAGE(PG8_SB(1, 0), b3, voffB);
            PG8_BAR; PG8_WAIT_L(0); PG8_MMA(0, 1, At, B1); PG8_BAR;
            PG8_LDA(At, 1, 1); PG8_STAGE(PG8_SA(1, 0), a3, voffA);
            PG8_BAR; PG8_WAIT_L(0); PG8_MMA(1, 0, At, B0); PG8_BAR; PG8_SCHED;
            PG8_STAGE(PG8_SB(1, 1), b3 + hstep, voffB);
            PG8_WAIT_V(6); PG8_BAR; PG8_MMA(1, 1, At, B1); PG8_BAR;
            }
        }
        if constexpr (ALIGN_EPI) { if (wr == 0) PG8_BAR; }
        if constexpr (!Epi::AFTER_DRAIN) { E(acc, cur, wr, wc, fr, fq); S.done(cur); }
        if (!has_next) break;
#pragma unroll
        for (int a = 0; a < 2; ++a)
#pragma unroll
            for (int b = 0; b < 2; ++b)
#pragma unroll
                for (int m = 0; m < 4; ++m)
#pragma unroll
                    for (int n = 0; n < 2; ++n) acc[a][b][m][n] = (f32x4){0.f, 0.f, 0.f, 0.f};
        cur = nxt; cA = nA; cB = nB; ++ui;
        if constexpr (ALIGN_EPI) { if (wr == 1) PG8_BAR; }
    }
    PG8_WAIT_V(0);
    if constexpr (!ALIGN_EPI) { if (wr == 0) PG8_BAR; }
    PG8_BAR;
    if constexpr (Epi::AFTER_DRAIN) { E.fused(acc, cur, wr, wc, fr, fq, lds, wid, lane); S.done(cur); }
#undef PG8_SA
#undef PG8_SB
#undef PG8_STAGE
#undef PG8_LDA
#undef PG8_LDB
#undef PG8_MMA
#undef PG8_WAIT_V
#undef PG8_WAIT_L
#undef PG8_BAR
#undef PG8_SCHED
}
}
namespace pg8 {
constexpr int XD = 2048;
#define EPI_FENCE() asm volatile("" ::: "memory")
__device__ __forceinline__ float add_xor_lane(float s, int lane, int mask) { return s + __builtin_bit_cast(float, __builtin_amdgcn_ds_bpermute((lane ^ mask) << 2, __builtin_bit_cast(int, s))); }
__device__ __forceinline__ float sigmoidf_(float x) { return __builtin_amdgcn_rcpf(1.0f + __expf(-x)); }
__device__ __forceinline__ u32x4 pack8(const f32x4 v0, const f32x4 v1) {
    u32x4 w; w.x = cvt_pk_bf16(v0[0], v0[1]); w.y = cvt_pk_bf16(v0[2], v0[3]); w.z = cvt_pk_bf16(v1[0], v1[1]); w.w = cvt_pk_bf16(v1[2], v1[3]); return w;
}
__device__ __forceinline__ void unpack8(const u32x4 w, f32x4& v0, f32x4& v1) {
    v0[0] = __uint_as_float(w.x << 16); v0[1] = __uint_as_float(w.x & 0xffff0000u); v0[2] = __uint_as_float(w.y << 16); v0[3] = __uint_as_float(w.y & 0xffff0000u);
    v1[0] = __uint_as_float(w.z << 16); v1[1] = __uint_as_float(w.z & 0xffff0000u); v1[2] = __uint_as_float(w.w << 16); v1[3] = __uint_as_float(w.w & 0xffff0000u);
}
constexpr float SS_SCALE = 1048576.0f, SS_INV_SCALE = 1.0f / 1048576.0f;
typedef unsigned long long ss_t;
typedef _Float16 f16x2 __attribute__((ext_vector_type(2)));
__device__ __forceinline__ unsigned pkh2(float lo, float hi) { return __builtin_bit_cast(unsigned, (f16x2){(_Float16)lo, (_Float16)hi}); }
__device__ __forceinline__ u32x4 packh8(const f32x4 v0, const f32x4 v1) { u32x4 w; w.x = pkh2(v0[0], v0[1]); w.y = pkh2(v0[2], v0[3]); w.z = pkh2(v1[0], v1[1]); w.w = pkh2(v1[2], v1[3]); return w; }
__device__ __forceinline__ void unpackh2(unsigned w, float& lo, float& hi) { const f16x2 h = __builtin_bit_cast(f16x2, w); lo = (float)h[0]; hi = (float)h[1]; }
__device__ __forceinline__ void unpackh8(const u32x4 w, f32x4& v0, f32x4& v1) { float a, b, c, d, e, f, g, h; unpackh2(w.x, a, b); unpackh2(w.y, c, d); unpackh2(w.z, e, f); unpackh2(w.w, g, h); v0 = (f32x4){a, b, c, d}; v1 = (f32x4){e, f, g, h}; }
__device__ __forceinline__ void row_invs(const PG8_GAS ss_t* ss, int row0, float (&inv)[2][4]) {
    ss_t raw[2][4];
#pragma unroll
    for (int ai = 0; ai < 2; ++ai)
#pragma unroll
        for (int m = 0; m < 4; ++m) raw[ai][m] = ss[row0 + ai * HALF + m * 16];
#pragma unroll
    for (int ai = 0; ai < 2; ++ai)
#pragma unroll
        for (int m = 0; m < 4; ++m) inv[ai][m] = rsqrtf((float)(long long)raw[ai][m] * (SS_INV_SCALE / (float)XD) + 1e-6f);
}

__device__ __forceinline__ void row_invs_lds(const PG8_LAS float* tab, int pm, int r0, float (&inv)[2][4]) {
#pragma unroll
    for (int ai = 0; ai < 2; ++ai)
#pragma unroll
        for (int m = 0; m < 4; ++m) inv[ai][m] = tab[(pm & 7) * BM + r0 + ai * HALF + m * 16];
}
struct EpiSwiglu {
    static constexpr bool PERM = true, AFTER_DRAIN = false;
    const PG8_GAS ss_t* ss; PG8_GAS bf16_t* act; int ldc; const PG8_LAS float* tab;
    __device__ __forceinline__ void operator()(const f32x4 (&acc)[2][2][4][2], const Unit& u, int wr, int wc, int fr, int fq) const {
        const int row0 = u.pm * BM + wr * 64 + fr, col0 = u.pn * HALF + wc * 32 + 8 * fq;
        float inv[2][4]; if (tab) row_invs_lds(tab, u.pm, wr * 64 + fr, inv); else row_invs(ss, row0, inv);
#pragma unroll
        for (int ai = 0; ai < 2; ++ai)
#pragma unroll
            for (int m = 0; m < 4; ++m) {
                const int row = row0 + ai * HALF + m * 16;
                f32x4 h[2];
#pragma unroll
                for (int n = 0; n < 2; ++n) {
                    const f32x4 g = acc[ai][0][m][n] * inv[ai][m], up = acc[ai][1][m][n] * inv[ai][m];
#pragma unroll
                    for (int j = 0; j < 4; ++j) h[n][j] = g[j] * sigmoidf_(g[j]) * up[j];
                }
                __builtin_nontemporal_store(pack8(h[0], h[1]), (PG8_GAS u32x4*)(act + (size_t)row * ldc + col0));
            }
    }
    static constexpr bool THIN_PAIRED = true;
    __device__ __forceinline__ void thin(int row, int pn, int w, int fq, const f32x4 v0, const f32x4 v1) const {
        typedef unsigned u32x2v __attribute__((ext_vector_type(2)));
        const float inv = rsqrtf((float)(long long)ss[row] * (SS_INV_SCALE / (float)XD) + 1e-6f);
        f32x4 h;
#pragma unroll
        for (int j = 0; j < 4; ++j) { const float g = v0[j] * inv; h[j] = g * sigmoidf_(g) * (v1[j] * inv); }
        u32x2v o; o.x = cvt_pk_bf16(h[0], h[1]); o.y = cvt_pk_bf16(h[2], h[3]);
        *(PG8_GAS u32x2v*)(act + (size_t)row * ldc + pn * HALF + 16 * w + 4 * fq) = o;
    }
};

struct EpiResid {
    static constexpr bool PERM = true, AFTER_DRAIN = false;
    PG8_GAS bf16_t* X16; PG8_GAS bf16_t* XB; PG8_GAS ss_t* ss; float scale; int noss;
    __device__ __forceinline__ void operator()(const f32x4 (&acc)[2][2][4][2], const Unit& u, int wr, int wc, int fr, int fq) const {
        const int row0 = u.pm * BM + wr * 64 + fr, col0 = u.pn * BM + wc * 32 + 8 * fq;
#pragma unroll
        for (int ai = 0; ai < 2; ++ai)
#pragma unroll
            for (int m = 0; m < 4; ++m) {
                const int row = row0 + ai * HALF + m * 16; float s = 0.f;
                u32x4 xo[2];
#pragma unroll
                for (int bj = 0; bj < 2; ++bj) xo[bj] = *(const PG8_GAS u32x4*)(X16 + (size_t)row * XD + col0 + bj * HALF);
#pragma unroll
                for (int bj = 0; bj < 2; ++bj) {
                    f32x4 x0, x1; unpackh8(xo[bj], x0, x1);
                    x0 += acc[ai][bj][m][0] * scale; x1 += acc[ai][bj][m][1] * scale;
                    *(PG8_GAS u32x4*)(X16 + (size_t)row * XD + col0 + bj * HALF) = packh8(x0, x1);
                    *(PG8_GAS u32x4*)(XB + (size_t)row * XD + col0 + bj * HALF) = pack8(x0, x1);
                    s += ((x0[0] * x0[0] + x0[1] * x0[1]) + (x0[2] * x0[2] + x0[3] * x0[3])) + ((x1[0] * x1[0] + x1[1] * x1[1]) + (x1[2] * x1[2] + x1[3] * x1[3]));
                }
                s = add_xor_lane(s, fr + 16 * fq, 16); s = add_xor_lane(s, fr + 16 * fq, 32);
                if (fq == 0 && !noss) __hip_atomic_fetch_add(ss + row, (ss_t)(long long)(s * SS_SCALE + 0.5f), __ATOMIC_RELAXED, __HIP_MEMORY_SCOPE_AGENT);
                if (m & 1) EPI_FENCE();
            }
    }
    static constexpr bool THIN_PAIRED = false;
    __device__ __forceinline__ void thin(int row, int pn, int w, int fq, const f32x4 v0, const f32x4 v1) const {
        typedef unsigned u32x2v __attribute__((ext_vector_type(2)));
        float s = 0.f;
#pragma unroll
        for (int t = 0; t < 2; ++t) { const size_t off = (size_t)row * XD + pn * BM + 32 * w + 16 * t + 4 * fq;
            const u32x2v xo = *(const PG8_GAS u32x2v*)(X16 + off); const f32x4 d = (t ? v1 : v0) * scale;
            float x0, x1, x2, x3; unpackh2(xo.x, x0, x1); unpackh2(xo.y, x2, x3); x0 += d[0]; x1 += d[1]; x2 += d[2]; x3 += d[3];
            u32x2v o; o.x = pkh2(x0, x1); o.y = pkh2(x2, x3); *(PG8_GAS u32x2v*)(X16 + off) = o;
            o.x = cvt_pk_bf16(x0, x1); o.y = cvt_pk_bf16(x2, x3); *(PG8_GAS u32x2v*)(XB + off) = o;
            s += (x0 * x0 + x1 * x1) + (x2 * x2 + x3 * x3); }
        if (!noss) __hip_atomic_fetch_add(ss + row, (ss_t)(long long)(s * SS_SCALE + 0.5f), __ATOMIC_RELAXED, __HIP_MEMORY_SCOPE_AGENT);
    }
};

template <size_t O_U2, size_t O_RKV, size_t O_GA, size_t O_GB, size_t O_LIN, int mp> struct EpiWin {
    static constexpr bool PERM = true, AFTER_DRAIN = false;
    const PG8_GAS ss_t* ss; PG8_GAS unsigned char* ov; const PG8_LAS float* tab;
    __device__ __forceinline__ void operator()(const f32x4 (&acc)[2][2][4][2], const Unit& u, int wr, int wc, int fr, int fq) const {
        PG8_GAS bf16_t* U2 = (PG8_GAS bf16_t*)(ov + O_U2); PG8_GAS bf16_t* RKV = (PG8_GAS bf16_t*)(ov + O_RKV); PG8_GAS bf16_t* GA = (PG8_GAS bf16_t*)(ov + O_GA); PG8_GAS bf16_t* GB = (PG8_GAS bf16_t*)(ov + O_GB); PG8_GAS bf16_t* LIN = (PG8_GAS bf16_t*)(ov + O_LIN);
        const int row0 = u.pm * BM + wr * 64 + fr, cl = wc * 32 + 8 * fq; const int pn = u.pn;
        float inv[2][4]; if (tab) row_invs_lds(tab, u.pm, wr * 64 + fr, inv); else row_invs(ss, row0, inv);
#pragma unroll
        for (int ai = 0; ai < 2; ++ai)
#pragma unroll
            for (int m = 0; m < 4; ++m) {
                const int row = row0 + ai * HALF + m * 16;
#pragma unroll
                for (int bj = 0; bj < 2; ++bj) {
                    f32x4 v0 = acc[ai][bj][m][0] * inv[ai][m], v1 = acc[ai][bj][m][1] * inv[ai][m];
                    const int c = bj * HALF + cl;
                    PG8_GAS bf16_t* dst;
                    if (pn < 4) { const int ch = pn * BM + c, g = ch >> 4; dst = U2 + ((size_t)g * 1040 + (row >> 4)) * 256 + (row & 15) * 16 + (ch & 15); }
                    else if (pn < 16) { const int t = (pn - 4) >> 2; dst = RKV + ((size_t)t * mp + row) * 1024 + ((pn - 4) & 3) * BM + c; }
                    else if (pn < 32) {
#pragma unroll
                        for (int j = 0; j < 4; ++j) { v0[j] = sigmoidf_(v0[j]); v1[j] = sigmoidf_(v1[j]); }
                        dst = (pn < 24 ? GA + (size_t)row * XD + (pn - 16) * BM : GB + (size_t)row * XD + (pn - 24) * BM) + c;
                    } else dst = LIN + (size_t)row * 512 + (pn - 32) * BM + c;
                    __builtin_nontemporal_store(pack8(v0, v1), (PG8_GAS u32x4*)dst);
                }
            }
    }
    static constexpr bool THIN_PAIRED = false;
    __device__ __forceinline__ void thin(int row, int pn, int w, int fq, const f32x4 a0, const f32x4 a1) const {
        typedef unsigned u32x2v __attribute__((ext_vector_type(2)));
        PG8_GAS bf16_t* U2 = (PG8_GAS bf16_t*)(ov + O_U2); PG8_GAS bf16_t* RKV = (PG8_GAS bf16_t*)(ov + O_RKV); PG8_GAS bf16_t* GA = (PG8_GAS bf16_t*)(ov + O_GA); PG8_GAS bf16_t* GB = (PG8_GAS bf16_t*)(ov + O_GB); PG8_GAS bf16_t* LIN = (PG8_GAS bf16_t*)(ov + O_LIN);
        const float inv = rsqrtf((float)(long long)ss[row] * (SS_INV_SCALE / (float)XD) + 1e-6f);
#pragma unroll
        for (int t = 0; t < 2; ++t) { f32x4 v = (t ? a1 : a0) * inv; const int c = 32 * w + 16 * t + 4 * fq;
            PG8_GAS bf16_t* dst;
            if (pn < 4) { const int ch = pn * BM + c, g = ch >> 4; dst = U2 + ((size_t)g * 1040 + (row >> 4)) * 256 + (row & 15) * 16 + (ch & 15); }
            else if (pn < 16) { const int tt = (pn - 4) >> 2; dst = RKV + ((size_t)tt * mp + row) * 1024 + ((pn - 4) & 3) * BM + c; }
            else if (pn < 32) {
#pragma unroll
                for (int j = 0; j < 4; ++j) v[j] = sigmoidf_(v[j]);
                dst = (pn < 24 ? GA + (size_t)row * XD + (pn - 16) * BM : GB + (size_t)row * XD + (pn - 24) * BM) + c;
            } else dst = LIN + (size_t)row * 512 + (pn - 32) * BM + c;
            u32x2v o; o.x = cvt_pk_bf16(v[0], v[1]); o.y = cvt_pk_bf16(v[2], v[3]); *(PG8_GAS u32x2v*)dst = o; }
    }
};

struct EpiGlu {
    static constexpr bool PERM = true, AFTER_DRAIN = false;
    const PG8_GAS bf16_t* aux; PG8_GAS bf16_t* out; int ldc;
    __device__ __forceinline__ void operator()(const f32x4 (&acc)[2][2][4][2], const Unit& u, int wr, int wc, int fr, int fq) const {
        const int row0 = u.pm * BM + wr * 64 + fr, col0 = u.pn * BM + wc * 32 + 8 * fq;
#pragma unroll
        for (int ai = 0; ai < 2; ++ai)
#pragma unroll
            for (int m = 0; m < 4; ++m) {
#pragma unroll
                for (int bj = 0; bj < 2; ++bj) {
                    const size_t off = (size_t)(row0 + ai * HALF + m * 16) * ldc + col0 + bj * HALF;
                    f32x4 a0, a1; unpack8(*(const PG8_GAS u32x4*)(aux + off), a0, a1);
                    f32x4 v0 = acc[ai][bj][m][0], v1 = acc[ai][bj][m][1];
#pragma unroll
                    for (int j = 0; j < 4; ++j) { v0[j] = a0[j] * sigmoidf_(v0[j]); v1[j] = a1[j] * sigmoidf_(v1[j]); }
                    *(PG8_GAS u32x4*)(out + off) = pack8(v0, v1);
                }
                if (m & 1) EPI_FENCE();
            }
    }
    static constexpr bool THIN_PAIRED = false;
    __device__ __forceinline__ void thin(int row, int pn, int w, int fq, const f32x4 a0, const f32x4 a1) const {
        typedef unsigned u32x2v __attribute__((ext_vector_type(2)));
#pragma unroll
        for (int t = 0; t < 2; ++t) { const size_t off = (size_t)row * ldc + pn * BM + 32 * w + 16 * t + 4 * fq; const f32x4 v = t ? a1 : a0;
            const u32x2v x = *(const PG8_GAS u32x2v*)(aux + off);
            const float x0 = __uint_as_float(x.x << 16), x1 = __uint_as_float(x.x & 0xffff0000u), x2 = __uint_as_float(x.y << 16), x3 = __uint_as_float(x.y & 0xffff0000u);
            u32x2v o; o.x = cvt_pk_bf16(x0 * sigmoidf_(v[0]), x1 * sigmoidf_(v[1])); o.y = cvt_pk_bf16(x2 * sigmoidf_(v[2]), x3 * sigmoidf_(v[3])); *(PG8_GAS u32x2v*)(out + off) = o; }
    }
};

template <bool ACCUM> struct EpiGateMul {
    static constexpr bool PERM = true, AFTER_DRAIN = false;
    const PG8_GAS bf16_t* gate; PG8_GAS bf16_t* out;
    __device__ __forceinline__ void operator()(const f32x4 (&acc)[2][2][4][2], const Unit& u, int wr, int wc, int fr, int fq) const {
        const int row0 = u.pm * BM + wr * 64 + fr, col0 = u.pn * BM + wc * 32 + 8 * fq;
#pragma unroll
        for (int ai = 0; ai < 2; ++ai)
#pragma unroll
            for (int m = 0; m < 4; ++m) {
#pragma unroll
                for (int bj = 0; bj < 2; ++bj) {
                    const size_t off = (size_t)(row0 + ai * HALF + m * 16) * XD + col0 + bj * HALF;
                    f32x4 g0, g1; unpack8(__builtin_nontemporal_load((const PG8_GAS u32x4*)(gate + off)), g0, g1);
                    f32x4 v0 = acc[ai][bj][m][0] * g0, v1 = acc[ai][bj][m][1] * g1;
                    if (ACCUM) { f32x4 p0, p1; unpack8(__builtin_nontemporal_load((const PG8_GAS u32x4*)(out + off)), p0, p1); v0 += p0; v1 += p1; }
                    *(PG8_GAS u32x4*)(out + off) = pack8(v0, v1);
                }
                if (m & 1) EPI_FENCE();
            }
    }
    static constexpr bool THIN_PAIRED = false;
    __device__ __forceinline__ void thin(int row, int pn, int w, int fq, const f32x4 a0, const f32x4 a1) const {
        typedef unsigned u32x2v __attribute__((ext_vector_type(2)));
#pragma unroll
        for (int t = 0; t < 2; ++t) { const size_t off = (size_t)row * XD + pn * BM + 32 * w + 16 * t + 4 * fq; const f32x4 v = t ? a1 : a0;
            const u32x2v x = *(const PG8_GAS u32x2v*)(gate + off);
            float r0 = v[0] * __uint_as_float(x.x << 16), r1 = v[1] * __uint_as_float(x.x & 0xffff0000u), r2 = v[2] * __uint_as_float(x.y << 16), r3 = v[3] * __uint_as_float(x.y & 0xffff0000u);
            if (ACCUM) { const u32x2v p = *(const PG8_GAS u32x2v*)(out + off); r0 += __uint_as_float(p.x << 16); r1 += __uint_as_float(p.x & 0xffff0000u); r2 += __uint_as_float(p.y << 16); r3 += __uint_as_float(p.y & 0xffff0000u); }
            u32x2v o; o.x = cvt_pk_bf16(r0, r1); o.y = cvt_pk_bf16(r2, r3); *(PG8_GAS u32x2v*)(out + off) = o; }
    }
};

template <size_t o_a, size_t o_b, size_t o_c, size_t o_d> struct EpiLora {
    static constexpr bool PERM = true, AFTER_DRAIN = false;
    PG8_GAS unsigned char* ov;
    __device__ __forceinline__ void operator()(const f32x4 (&acc)[2][2][4][2], const Unit& u, int wr, int wc, int fr, int fq) const {
        const int row0 = u.pm * BM + wr * 64 + fr, kind = u.pn >> 2, col0 = (u.pn & 3) * BM + wc * 32 + 8 * fq;
        PG8_GAS bf16_t* ob = (PG8_GAS bf16_t*)(ov + (kind == 0 ? o_a : kind == 1 ? o_b : kind == 2 ? o_c : o_d));
#pragma unroll
        for (int ai = 0; ai < 2; ++ai)
#pragma unroll
            for (int m = 0; m < 4; ++m)
#pragma unroll
                for (int bj = 0; bj < 2; ++bj)
                    *(PG8_GAS u32x4*)(ob + (size_t)(row0 + ai * HALF + m * 16) * 1024 + col0 + bj * HALF) = pack8(acc[ai][bj][m][0], acc[ai][bj][m][1]);
    }
    static constexpr bool THIN_PAIRED = false;
    __device__ __forceinline__ void thin(int row, int pn, int w, int fq, const f32x4 a0, const f32x4 a1) const {
        typedef unsigned u32x2v __attribute__((ext_vector_type(2)));
        const int kind = pn >> 2;
        PG8_GAS bf16_t* ob = (PG8_GAS bf16_t*)(ov + (kind == 0 ? o_a : kind == 1 ? o_b : kind == 2 ? o_c : o_d));
#pragma unroll
        for (int t = 0; t < 2; ++t) { const size_t off = (size_t)row * 1024 + (pn & 3) * BM + 32 * w + 16 * t + 4 * fq; const f32x4 v = t ? a1 : a0;
            u32x2v o; o.x = cvt_pk_bf16(v[0], v[1]); o.y = cvt_pk_bf16(v[2], v[3]); *(PG8_GAS u32x2v*)(ob + off) = o; }
    }
};

template <class Epi, bool F16 = false> __device__ __forceinline__ void thin_gemm(PG8_LAS unsigned char* lds, const Gemm g, const Epi& E, int G, int c, int row_base, const int tid) {
    const int w = __builtin_amdgcn_readfirstlane(tid >> 6), lane = tid & 63, fr = lane & 15, fq = lane >> 4, K = g.K, nks = K / 32, nU = g.N / 32;
    PG8_LAS f32x4* P = (PG8_LAS f32x4*)lds;
    for (int u = G - 1 - c; u < nU; u += G) {
        const int pn = u >> 3, wq = u & 7;
        const int r0 = Epi::THIN_PAIRED ? 16 * wq : 32 * wq, r1 = Epi::THIN_PAIRED ? HALF + 16 * wq : 32 * wq + 16;
        const PG8_GAS bf16_t* ap = g.A + (size_t)(row_base + fr) * K + 8 * fq;
        const PG8_GAS bf16_t* b0 = g.Bt + (size_t)(pn * BM + r0 + fr) * K + 8 * fq;
        const PG8_GAS bf16_t* b1 = g.Bt + (size_t)(pn * BM + r1 + fr) * K + 8 * fq;
        f32x4 acc0 = {0.f, 0.f, 0.f, 0.f}, acc1 = {0.f, 0.f, 0.f, 0.f};
        for (int ks = w; ks < nks; ks += 64) {
            bf16x8 av[8], bv0[8], bv1[8];
#pragma unroll
            for (int s = 0; s < 8; ++s) { const int kk = ks + 8 * s; const bool ok = kk < nks; const int ko = ok ? 32 * kk : 0;
                av[s] = *(const PG8_GAS bf16x8*)(ap + ko); bv0[s] = *(const PG8_GAS bf16x8*)(b0 + ko); bv1[s] = *(const PG8_GAS bf16x8*)(b1 + ko);
                if (!ok) av[s] = (bf16x8){0, 0, 0, 0, 0, 0, 0, 0}; }
#pragma unroll
            for (int s = 0; s < 8; ++s) {
                if (F16) { acc0 = __builtin_amdgcn_mfma_f32_16x16x32_f16(__builtin_bit_cast(f16x8, bv0[s]), __builtin_bit_cast(f16x8, av[s]), acc0, 0, 0, 0); acc1 = __builtin_amdgcn_mfma_f32_16x16x32_f16(__builtin_bit_cast(f16x8, bv1[s]), __builtin_bit_cast(f16x8, av[s]), acc1, 0, 0, 0); }
                else { acc0 = __builtin_amdgcn_mfma_f32_16x16x32_bf16(bv0[s], av[s], acc0, 0, 0, 0); acc1 = __builtin_amdgcn_mfma_f32_16x16x32_bf16(bv1[s], av[s], acc1, 0, 0, 0); } }
        }
        P[(w * 2 + 0) * 64 + lane] = acc0; P[(w * 2 + 1) * 64 + lane] = acc1;
        __syncthreads();
        if (w == 0) {
            f32x4 s0 = P[lane], s1 = P[64 + lane];
#pragma unroll
            for (int ww = 1; ww < 8; ++ww) { s0 += P[(ww * 2 + 0) * 64 + lane]; s1 += P[(ww * 2 + 1) * 64 + lane]; }
            E.thin(row_base + fr, pn, wq, fq, s0, s1);
        }
        __syncthreads();
    }
}
}
constexpr int NWAVES = 8;
constexpr int DM = 2048, BATCH = 4, SEQ = 4096, DEPTH = 4, NMETA = 16, DFF = 5632;
constexpr int MR = BATCH * SEQ;
constexpr int MROWS = MR + NMETA;
constexpr int MP = 16640;
constexpr int TSEQ = SEQ + NMETA;
constexpr int SW = 1024, NG = 64, NS = 64, SGC = 16;
constexpr int RW_W = 1024, NH = 16, HD = 64;
constexpr int P_FIRST = 8480, P_REST = 8512, NIN = 8704;
constexpr int U2_CR = 1040;
constexpr float NORM_EPS = 1e-6f;
#ifndef MK_MULTI
#define MK_MULTI 0
#endif
enum In { I_X = 0, I_META, I_F1N, I_F1G, I_F1U, I_F1D, I_MIXN, I_WIN0, I_WINR, I_MUSH, I_MUVR, I_LRE, I_LIM, I_LDT, I_BRE, I_BIM, I_CRE, I_CIM, I_SD, I_WGLU,
          I_W0, I_W2, I_A0, I_A2, I_V0, I_V2, I_G2, I_KK, I_KA, I_RK, I_LNW, I_LNB, I_WUA, I_WUB, I_WO, I_F2N, I_F2G, I_F2U, I_F2D, I_FINN, N_IN };

constexpr size_t MiB = 1u << 20;
constexpr size_t WS_CTL = 0, CTL_ZERO_BYTES = 1 * MiB;
constexpr size_t WS_LPAR = 1 * MiB;
constexpr size_t WS_X = 2 * MiB;
constexpr size_t WS_XB = 132 * MiB;
constexpr size_t WS_SSP = 197 * MiB, SS_STRIDE = 256 * 1024;
constexpr size_t WS_VF = 200 * MiB;
constexpr size_t WS_W = 233 * MiB, W_SLOT = 204 * MiB;
constexpr size_t WO_GU1 = 0, WO_D1 = 44 * MiB, WO_IN = 66 * MiB, WO_GLU = 100 * MiB, WO_UA = 102 * MiB, WO_UB = 106 * MiB, WO_O = 110 * MiB, WO_GU2 = 118 * MiB, WO_D2 = 162 * MiB, WO_S5 = 184 * MiB, WO_LORA = 200 * MiB;
constexpr size_t WS_OV = WS_W + 2 * W_SLOT;
constexpr size_t OV_ACT = 0;
constexpr size_t OV_U2 = 0, OV_RKV = 33 * MiB, OV_LIN = 131 * MiB, OV_GA = 148 * MiB, OV_GB = 213 * MiB, OV_YPRE = 278 * MiB, OV_YA = 311 * MiB, OV_RW = 344 * MiB,
                 OV_O = 729 * MiB, OV_YB = 794 * MiB, OV_GT = 827 * MiB, OV_RKS = 860 * MiB, OV_MG = 862 * MiB, OV_BK = 927 * MiB, OV_END = 930 * MiB;
constexpr size_t OV_LA = OV_RW + 128 * MiB, OV_DEC = OV_RW + 128 * MiB, OV_ICLR = OV_MG, OV_VG = OV_YB;
constexpr int LKP = 384;
constexpr size_t WS_END = WS_OV + OV_END;
static_assert((size_t)MP * DM * 4 == 130 * MiB && (size_t)MP * DFF * 2 <= 179 * MiB && (size_t)MROWS * NH * 6 * HD * 4 <= 385 * MiB, "d_ws map");
constexpr int CW_TMO = 0, CW_CODE = 1, CW_BAR = 4096;

constexpr int RING_OFF = 0, RING_BYTES = 131072;
constexpr int LDSCTL_OFF = RING_BYTES, MISC_OFF = LDSCTL_OFF + 320;
constexpr int LDS_BYTES = 147456;
static_assert(MISC_OFF + 128 <= LDS_BYTES, "LDS map");

#define GAS __attribute__((address_space(1)))
#define LAS __attribute__((address_space(3)))
typedef unsigned short bf16;
typedef unsigned v4u __attribute__((ext_vector_type(4)));
typedef unsigned v2u __attribute__((ext_vector_type(2)));
typedef float f32x4 __attribute__((ext_vector_type(4)));
typedef float f32x2 __attribute__((ext_vector_type(2)));
typedef GAS unsigned gu32;
#define RLX_AGENT __ATOMIC_RELAXED, __HIP_MEMORY_SCOPE_AGENT
#define LDS_WAIT() asm volatile("s_waitcnt lgkmcnt(0)" ::: "memory")
#define VM_WAIT() asm volatile("s_waitcnt vmcnt(0)" ::: "memory")
__device__ __forceinline__ unsigned f2bf(float f) { unsigned u = __builtin_bit_cast(unsigned, f); return (u + 0x7fffu + ((u >> 16) & 1u)) >> 16; }
__device__ __forceinline__ unsigned pk2(float lo, float hi) { return f2bf(lo) | (f2bf(hi) << 16); }
__device__ __forceinline__ float bf2f(bf16 h) { return __uint_as_float((unsigned)h << 16); }
__device__ __forceinline__ float sigm(float x) { return 1.0f / (1.0f + __expf(-x)); }
#define XB_TMO      128
#define XB_XCNT(j)  (256  + 64 * (j))
#define XB_XSUB(j)  (1280 + 64 * (j))
#define XB_XGEN(j)  (2304 + 64 * (j))
#define XB_TOP      3328
#define XB_TOPGEN   3392
#define XCD_BAR_WORDS 3456
#define XB_SPIN_CAP (1u << 18)

__device__ __forceinline__ unsigned xb_ld(unsigned* p)              { return __hip_atomic_load(p, __ATOMIC_RELAXED, __HIP_MEMORY_SCOPE_AGENT); }
__device__ __forceinline__ unsigned xb_add(unsigned* p, unsigned v) { return __hip_atomic_fetch_add(p, v, __ATOMIC_RELAXED, __HIP_MEMORY_SCOPE_AGENT); }
__device__ __forceinline__ unsigned xb_xcc_id() { return (unsigned)__builtin_amdgcn_s_getreg((3 << 11) | 20) & 0xFu; }
#define XB_SPIN(cond, bar) do { unsigned _sp = 0; while (cond) { __builtin_amdgcn_s_sleep(1); \
    if ((++_sp & 255u) == 0u) { if (xb_ld(&(bar)[XB_TMO])) break; if (_sp > XB_SPIN_CAP) { atomicAdd(&(bar)[XB_TMO], 1u); break; } } } } while (0)

struct XcdBarrier {
    unsigned* bar; unsigned x;
    volatile LAS unsigned* st;
};

__device__ __forceinline__ XcdBarrier xcd_barrier_post(unsigned* bar, volatile LAS unsigned* st) {
    XcdBarrier b; b.bar = bar; b.x = xb_xcc_id(); b.st = st;
    if (threadIdx.x == 0) (void)xb_add(&bar[XB_XCNT(b.x)], 1u);
    return b;
}
__device__ __forceinline__ void xcd_barrier_complete(unsigned* bar, unsigned x, unsigned& nloc, unsigned& nx) {
    const unsigned G = gridDim.x * gridDim.y * gridDim.z;
    unsigned sum, cnt, mine, sp = 0u;
    for (;;) {
        sum = 0u; cnt = 0u; mine = 0u;
#pragma unroll
        for (unsigned j = 0; j < 16; ++j) { const unsigned c = xb_ld(&bar[XB_XCNT(j)]); sum += c; cnt += (c > 0u) ? 1u : 0u; mine = (j == x) ? c : mine; }
        if (sum == G) break;
        __builtin_amdgcn_s_sleep(1);
        if ((++sp & 255u) == 0u) { if (xb_ld(&bar[XB_TMO])) break; if (sp > XB_SPIN_CAP) { atomicAdd(&bar[XB_TMO], 1u); break; } }
    }
    nloc = mine > 0u ? mine : 1u; nx = cnt > 0u ? cnt : 1u;
}

__device__ __forceinline__ void xcd_barrier(const XcdBarrier& b) {
    asm volatile("s_waitcnt vmcnt(0)" ::: "memory");
    __syncthreads();
    if (threadIdx.x == 0) {
        unsigned* bar = b.bar;
        __builtin_amdgcn_s_waitcnt(0);
        unsigned nloc = b.st[0], nx = b.st[1];
        if (nloc == 0u) { xcd_barrier_complete(bar, b.x, nloc, nx); b.st[0] = nloc; b.st[1] = nx; }
        const unsigned old = xb_add(&bar[XB_XSUB(b.x)], 1u);
        const unsigned gen = old / nloc;
        if (old + 1u == (gen + 1u) * nloc) {
            __builtin_amdgcn_fence(__ATOMIC_RELEASE, "agent");
            asm volatile("s_waitcnt vmcnt(0)" ::: "memory");
            const unsigned og = xb_add(&bar[XB_TOP], 1u);
            const unsigned tg = og / nx;
            if (og + 1u == (tg + 1u) * nx) xb_add(&bar[XB_TOPGEN], 1u);
            else XB_SPIN(xb_ld(&bar[XB_TOPGEN]) == tg, bar);
            __builtin_amdgcn_fence(__ATOMIC_ACQUIRE, "agent");
            xb_add(&bar[XB_XGEN(b.x)], 1u);
            asm volatile("s_waitcnt vmcnt(0)" ::: "memory");
        } else {
            XB_SPIN(xb_ld(&bar[XB_XGEN(b.x)]) == gen, bar);
            __builtin_amdgcn_fence(__ATOMIC_ACQUIRE, "agent");
            asm volatile("s_waitcnt vmcnt(0)" ::: "memory");
        }
    }
    __syncthreads();
}
struct Frame {
    LAS unsigned char* lds;
    volatile LAS unsigned* MISC;
    gu32* ctl;
    int tid, lane, wave, vcu, G;
    GAS unsigned char* ws;
};
#define FX16(F) ((GAS bf16*)((F).ws + WS_X))
#define FXB(F)  ((GAS bf16*)((F).ws + WS_XB))
#define FVF(F)  ((GAS bf16*)((F).ws + WS_VF))
#define FSSA(F) ((GAS unsigned long long*)((F).ws + WS_SSP))
#define FSSB(F) ((GAS unsigned long long*)((F).ws + WS_SSP + SS_STRIDE))
#define FSSC(F) ((GAS unsigned long long*)((F).ws + WS_SSP + 2 * SS_STRIDE))
__device__ __forceinline__ const GAS float* inp(const Frame& F, int k) {
    const LAS unsigned* t = (const LAS unsigned*)(F.lds + LDSCTL_OFF) + 2 * k;
    const unsigned lo = __builtin_amdgcn_readfirstlane(t[0]), hi = __builtin_amdgcn_readfirstlane(t[1]);
    return (const GAS float*)(((unsigned long long)hi << 32) | lo);
}
__device__ __forceinline__ float row16_sum(float x) {
    x += __builtin_bit_cast(float, __builtin_amdgcn_update_dpp(0, __builtin_bit_cast(int, x), 0xB1, 0xF, 0xF, false));
    x += __builtin_bit_cast(float, __builtin_amdgcn_update_dpp(0, __builtin_bit_cast(int, x), 0x4E, 0xF, 0xF, false));
    x += __builtin_bit_cast(float, __builtin_amdgcn_update_dpp(0, __builtin_bit_cast(int, x), 0x124, 0xF, 0xF, false));
    x += __builtin_bit_cast(float, __builtin_amdgcn_update_dpp(0, __builtin_bit_cast(int, x), 0x128, 0xF, 0xF, false));
    return x;
}
__device__ __forceinline__ float lane_bcast(float x, int j) { return __builtin_bit_cast(float, __builtin_amdgcn_readlane(__builtin_bit_cast(int, x), j)); }
__device__ __forceinline__ float wave_sum(float v) {
    v = row16_sum(v);
    return (lane_bcast(v, 0) + lane_bcast(v, 16)) + (lane_bcast(v, 32) + lane_bcast(v, 48));
}
__device__ __forceinline__ int seq_row(int b, int s) { return s < NMETA ? MR + s : b * SEQ + (s - NMETA); }
__device__ __forceinline__ int prev_row(int row) { if (row >= MR) return row > MR ? row - 1 : -1; return (row & (SEQ - 1)) ? row - 1 : MR + NMETA - 1; }

__device__ __forceinline__ void px_init(Frame& F) {
    const int gw = F.vcu * NWAVES + F.wave, NGW = F.G * NWAVES;
    const GAS float* xin = inp(F, I_X); const GAS float* meta = inp(F, I_META);
    for (int m = gw; m < MP; m += NGW) {
        const GAS float* src = m < MR ? xin + (size_t)m * DM : (m < MROWS ? meta + (size_t)(m - MR) * DM : nullptr);
        f32x4 v[8]; float s = 0.f;
#pragma unroll
        for (int j = 0; j < 8; ++j) { v[j] = src ? __builtin_nontemporal_load((const GAS f32x4*)src + F.lane + 64 * j) : (f32x4){0.f, 0.f, 0.f, 0.f}; s += (v[j][0] * v[j][0] + v[j][1] * v[j][1]) + (v[j][2] * v[j][2] + v[j][3] * v[j][3]); }
        s = wave_sum(s);
#pragma unroll
        for (int j = 0; j < 8; ++j) {
            v2u w; w.x = pg8::pkh2(v[j][0], v[j][1]); w.y = pg8::pkh2(v[j][2], v[j][3]);
            ((GAS v2u*)(FX16(F) + (size_t)m * DM))[F.lane + 64 * j] = w;
            w.x = pk2(v[j][0], v[j][1]); w.y = pk2(v[j][2], v[j][3]);
            ((GAS v2u*)(FXB(F) + (size_t)m * DM))[F.lane + 64 * j] = w;
        }
        if (F.lane == 0) { unsigned zlo = 0u; asm volatile("" : "+v"(zlo));
            FSSC(F)[m] = (unsigned long long)(long long)(s * pg8::SS_SCALE + 0.5f); FSSA(F)[m] = (unsigned long long)zlo; }
    }
}
__device__ __forceinline__ int tr_drow(int map, int c0) {
    if (map == 1) return (c0 >> 7) * 256 + (c0 & 127);
    if (map == 2) return (c0 >> 7) * 256 + 128 + (c0 & 127);
    if (map == 3) {
        if (c0 < 4096) return c0; if (c0 < 4384) return 8192 + (c0 - 4096); if (c0 < 8480) return 4096 + (c0 - 4384); return 8192 + 288 + (c0 - 8480); }
    return c0;
}
struct TrDesc { const GAS float* W; GAS bf16* WT; const GAS float* gain; int K, N, map, f16; };
__device__ __forceinline__ int tr_items(const TrDesc& d) { return (d.K / 64) * ((d.N + 63) / 64); }
__device__ __forceinline__ void tr_tile_load(const TrDesc& d, int it, int lane, f32x4 (&v)[16]) {
    const int nbn = (d.N + 63) / 64, kb = it / nbn, nb = it - kb * nbn, k0 = 64 * kb, n0 = 64 * nb, rg = lane >> 4, j = lane & 15;
    const bool nok = n0 + 4 * j < d.N;
#pragma unroll
    for (int i = 0; i < 16; ++i) { const int kk = 8 * (i >> 1) + 2 * rg + (i & 1);
        v[i] = nok ? __builtin_nontemporal_load((const GAS f32x4*)(d.W + (size_t)(k0 + kk) * d.N + n0 + 4 * j)) : (f32x4){0.f, 0.f, 0.f, 0.f}; }
}
__device__ __forceinline__ void tr_tile_finish(const TrDesc& d, int it, int lane, const f32x4 (&v)[16], LAS unsigned* scr) {
    const int nbn = (d.N + 63) / 64, kb = it / nbn, nb = it - kb * nbn, k0 = 64 * kb, n0 = 64 * nb, rg = lane >> 4, j = lane & 15;
#pragma unroll
    for (int i = 0; i < 8; ++i) { const int kk = 8 * i + 2 * rg; float g0 = 1.f, g1 = 1.f; if (d.gain) { g0 = d.gain[k0 + kk]; g1 = d.gain[k0 + kk + 1]; }
#pragma unroll
        for (int e = 0; e < 4; ++e) scr[(4 * j + e) * 36 + (kk >> 1)] = d.f16 ? pg8::pkh2(v[2 * i][e] * g0, v[2 * i + 1][e] * g1) : pk2(v[2 * i][e] * g0, v[2 * i + 1][e] * g1); }
    LDS_WAIT(); asm volatile("" ::: "memory");
    const int c = lane & 7;
#pragma unroll
    for (int i = 0; i < 8; ++i) { const int n = (lane >> 3) + 8 * i;
        const v4u o = *(const LAS v4u*)(scr + n * 36 + 4 * c);
        const int col = n0 + n;
        if (col < d.N) *(GAS v4u*)(d.WT + (size_t)(tr_drow(d.map, col & ~31) + (col & 31)) * d.K + k0 + 8 * c) = o; }
    LDS_WAIT(); asm volatile("" ::: "memory");
}
constexpr int TR_NMAT = 11;
__device__ __forceinline__ TrDesc tr_desc(Frame& F, int L, int m) {
    GAS unsigned char* wb = F.ws + WS_W + (size_t)(L & 1) * W_SLOT; const int P = L == 0 ? P_FIRST : P_REST; TrDesc d;
    switch (m) {
    case 0:  d = TrDesc{inp(F, I_F1G) + (size_t)L * DM * DFF, (GAS bf16*)(wb + WO_GU1), inp(F, I_F1N) + (size_t)L * DM, DM, DFF, 1, 0}; break;
    case 1:  d = TrDesc{inp(F, I_F1U) + (size_t)L * DM * DFF, (GAS bf16*)(wb + WO_GU1), inp(F, I_F1N) + (size_t)L * DM, DM, DFF, 2, 0}; break;
    case 2:  d = TrDesc{inp(F, I_F1D) + (size_t)L * DFF * DM, (GAS bf16*)(wb + WO_D1), nullptr, DFF, DM, 0, 0}; break;
    case 3:  d = TrDesc{L == 0 ? inp(F, I_WIN0) : inp(F, I_WINR) + (size_t)(L - 1) * DM * P_REST, (GAS bf16*)(wb + WO_IN), inp(F, I_MIXN) + (size_t)L * DM, DM, P, 3, 0}; break;
    case 4:  d = TrDesc{inp(F, I_WGLU) + (size_t)L * SW * SW, (GAS bf16*)(wb + WO_GLU), nullptr, SW, SW, 0, 0}; break;
    case 5:  d = TrDesc{inp(F, I_WUA) + (size_t)L * SW * DM, (GAS bf16*)(wb + WO_UA), nullptr, SW, DM, 0, 0}; break;
    case 6:  d = TrDesc{inp(F, I_WUB) + (size_t)L * RW_W * DM, (GAS bf16*)(wb + WO_UB), nullptr, RW_W, DM, 0, 0}; break;
    case 7:  d = TrDesc{inp(F, I_WO) + (size_t)L * DM * DM, (GAS bf16*)(wb + WO_O), nullptr, DM, DM, 0, 0}; break;
    case 8:  d = TrDesc{inp(F, I_F2G) + (size_t)L * DM * DFF, (GAS bf16*)(wb + WO_GU2), inp(F, I_F2N) + (size_t)L * DM, DM, DFF, 1, 0}; break;
    case 9:  d = TrDesc{inp(F, I_F2U) + (size_t)L * DM * DFF, (GAS bf16*)(wb + WO_GU2), inp(F, I_F2N) + (size_t)L * DM, DM, DFF, 2, 0}; break;
    default: d = TrDesc{inp(F, I_F2D) + (size_t)L * DFF * DM, (GAS bf16*)(wb + WO_D2), nullptr, DFF, DM, 0, 0}; break;
    }
    return d;
}
__device__ __forceinline__ bool tr_decode(int L, int t, int& m, int& it) {
    const int P = L == 0 ? P_FIRST : P_REST;
    constexpr int n_gu = (DM / 64) * (DFF / 64), n_dn = (DFF / 64) * (DM / 64), n_gl = (SW / 64) * (SW / 64), n_up = (SW / 64) * (DM / 64), n_wo = (DM / 64) * (DM / 64);
    const int n_in = (DM / 64) * ((P + 63) / 64);
    const int cnt[TR_NMAT] = {n_gu, n_gu, n_dn, n_in, n_gl, n_up, n_up, n_wo, n_gu, n_gu, n_dn};
    int r = t;
#pragma unroll
    for (int i = 0; i < TR_NMAT; ++i) { if (r < cnt[i]) { m = i; it = r; return true; } r -= cnt[i]; }
    return false;
}
__device__ __forceinline__ void tr_matrix(Frame& F, const TrDesc& d) {
    LAS unsigned* scr = (LAS unsigned*)(F.lds + RING_OFF + F.wave * 16384);
    const int gw = F.vcu * NWAVES + F.wave, NGW = F.G * NWAVES, nitems = tr_items(d);
    for (int it = gw; it < nitems; it += NGW) { f32x4 v[16]; tr_tile_load(d, it, F.lane, v); tr_tile_finish(d, it, F.lane, v, scr); }
}
__device__ __forceinline__ void pw_zero_rows(Frame& F, int L) {
    GAS unsigned char* wb = F.ws + WS_W + (size_t)(L & 1) * W_SLOT; const int P = L == 0 ? P_FIRST : P_REST;
    const int gw = F.vcu * NWAVES + F.wave, NGW = F.G * NWAVES;
    for (int r = P + gw; r < NIN; r += NGW) { GAS v4u* z = (GAS v4u*)((GAS bf16*)(wb + WO_IN) + (size_t)r * DM);
#pragma unroll
        for (int j = 0; j < 4; ++j) z[F.lane + 64 * j] = (v4u){0u, 0u, 0u, 0u}; }
}
__device__ __forceinline__ void pw_weights(Frame& F, int L) {
    for (int m = 0; m < TR_NMAT; ++m) { const TrDesc d = tr_desc(F, L, m); tr_matrix(F, d); }
}

constexpr size_t S5_KC_BYTES = (size_t)NG * 256 * 384 * 2;
__device__ __forceinline__ float gelu_tanh(float y) { const float t2 = 1.5957691216057308f * (y + 0.044715f * y * y * y); return y * __builtin_amdgcn_rcpf(1.0f + __expf(-t2)); }
__device__ __forceinline__ void abar_pow(float lr, float li, float dt, int p, float& re, float& im) {
    const double ang = (double)p * (double)li * (double)dt;
    const double k = __builtin_rint(ang * 0.15915494309189535);
    const float r = (float)(ang - k * 6.283185307179586);
    const float mag = expf((float)((double)p * (double)lr * (double)dt));
    re = mag * cosf(r); im = mag * sinf(r);
}
__device__ __forceinline__ void s5_build(Frame& F, int L) {
    LAS float* APR = (LAS float*)(F.lds + RING_OFF);
    LAS float* API = APR + 17 * 64;
    LAS float* BBR = API + 17 * 64;
    LAS float* BBI = BBR + 1024;
    LAS float* CR = BBI + 1024;
    LAS float* CI = CR + 1024;
    LAS float* KT = CI + 1024;
    GAS unsigned char* wb = F.ws + WS_W + (size_t)(L & 1) * W_SLOT;
    for (int g = F.vcu; g < NG; g += F.G) {
        const size_t lg = (size_t)L * NG + g;
        const float dt = expf(inp(F, I_LDT)[lg]);
        for (int i = F.tid; i < 17 * 64; i += NWAVES * 64) { const int p = i >> 6, n = i & 63; float pr, pi;
            abar_pow(inp(F, I_LRE)[lg * NS + n], inp(F, I_LIM)[lg * NS + n], dt, p, pr, pi);
            APR[i] = pr; API[i] = pi; }
        for (int i = F.tid; i < 1024; i += NWAVES * 64) { const int n = i >> 4;
            const float lr = inp(F, I_LRE)[lg * NS + n], li = inp(F, I_LIM)[lg * NS + n]; float are, aim;
            abar_pow(lr, li, dt, 1, are, aim);
            const float den = lr * lr + li * li, nr = are - 1.0f, ni = aim;
            const float qre = (nr * lr + ni * li) / den, qim = (ni * lr - nr * li) / den;
            const float br = inp(F, I_BRE)[lg * 1024 + i], bi = inp(F, I_BIM)[lg * 1024 + i];
            BBR[i] = qre * br - qim * bi; BBI[i] = qre * bi + qim * br;
            CR[i] = inp(F, I_CRE)[lg * 1024 + i]; CI[i] = inp(F, I_CIM)[lg * 1024 + i]; }
        __syncthreads();
        for (int i = F.tid; i < 4096; i += NWAVES * 64) { const int tau = i >> 8, c = (i >> 4) & 15, cp = i & 15; float acc = 0.f;
            for (int n = 0; n < 64; ++n) { const float cr = CR[c * 64 + n], ci = CI[c * 64 + n], ar = APR[tau * 64 + n], ai = API[tau * 64 + n], br = BBR[n * 16 + cp], bi = BBI[n * 16 + cp];
                const float mr = cr * ar - ci * ai, mi = cr * ai + ci * ar; acc += mr * br - mi * bi; }
            KT[i] = acc; }
        __syncthreads();
        GAS unsigned* KC = (GAS unsigned*)(wb + WO_S5) + (size_t)g * 256 * 192;
        GAS unsigned* BE = (GAS unsigned*)(wb + WO_S5 + S5_KC_BYTES) + (size_t)g * 128 * 128;
        for (int i = F.tid; i < 256 * 192; i += NWAVES * 64) { const int row = i / 192, cp2 = i - row * 192, t = row >> 4, c = row & 15; float v[2];
#pragma unroll
            for (int e = 0; e < 2; ++e) { const int col = 2 * cp2 + e;
                if (col < 256) { const int j = col >> 4, cq = col & 15; v[e] = j <= t ? KT[((t - j) * 16 + c) * 16 + cq] : 0.f; }
                else { const int n = (col - 256) & 63; const float cr = CR[c * 64 + n], ci = CI[c * 64 + n], ar = APR[(t + 1) * 64 + n], ai = API[(t + 1) * 64 + n];
                    v[e] = col < 320 ? cr * ar - ci * ai : -(cr * ai + ci * ar); } }
            KC[i] = pk2(v[0], v[1]); }
        for (int i = F.tid; i < 128 * 128; i += NWAVES * 64) { const int n2 = i >> 7, cp2 = i & 127, n = n2 & 63; float v[2];
#pragma unroll
            for (int e = 0; e < 2; ++e) { const int col = 2 * cp2 + e, j = col >> 4, cq = col & 15; const float ar = APR[(15 - j) * 64 + n], ai = API[(15 - j) * 64 + n], br = BBR[n * 16 + cq], bi = BBI[n * 16 + cq];
                v[e] = n2 < 64 ? ar * br - ai * bi : ar * bi + ai * br; }
            BE[i] = pk2(v[0], v[1]); }
        __syncthreads();
    }
}
typedef short bfx8 __attribute__((ext_vector_type(8)));
typedef __bf16 bf2v __attribute__((ext_vector_type(2)));
__device__ __forceinline__ unsigned cvt2(float a, float b) { const f32x2 v = {a, b}; const bf2v r = __builtin_convertvector(v, bf2v); return __builtin_bit_cast(unsigned, r); }
__device__ __forceinline__ float bfu(unsigned short u) { return __uint_as_float((unsigned)u << 16); }
__device__ __forceinline__ void wait_vm(int n) {
    switch (n) {
    case 0: asm volatile("s_waitcnt vmcnt(0)" ::: "memory"); break; case 1: asm volatile("s_waitcnt vmcnt(1)" ::: "memory"); break; case 2: asm volatile("s_waitcnt vmcnt(2)" ::: "memory"); break;
    case 3: asm volatile("s_waitcnt vmcnt(3)" ::: "memory"); break; case 4: asm volatile("s_waitcnt vmcnt(4)" ::: "memory"); break; case 5: asm volatile("s_waitcnt vmcnt(5)" ::: "memory"); break;
    case 6: asm volatile("s_waitcnt vmcnt(6)" ::: "memory"); break; case 7: asm volatile("s_waitcnt vmcnt(7)" ::: "memory"); break; case 8: asm volatile("s_waitcnt vmcnt(8)" ::: "memory"); break;
    case 9: asm volatile("s_waitcnt vmcnt(9)" ::: "memory"); break; case 10: asm volatile("s_waitcnt vmcnt(10)" ::: "memory"); break; case 11: asm volatile("s_waitcnt vmcnt(11)" ::: "memory"); break;
    case 12: asm volatile("s_waitcnt vmcnt(12)" ::: "memory"); break; default: asm volatile("s_waitcnt vmcnt(0)" ::: "memory"); break; }
}
__device__ __forceinline__ void s5_unit(Frame& F, int L, int b, int g) {
    const int lane = F.lane, w = F.wave, fr = lane & 15, fq = lane >> 4;
    GAS unsigned char* wb = F.ws + WS_W + (size_t)(L & 1) * W_SLOT;
    const GAS unsigned char* U2b = F.ws + WS_OV + OV_U2 + (size_t)g * U2_CR * 512;
    const GAS bf16* KC = (const GAS bf16*)(wb + WO_S5) + (size_t)g * 256 * 384;
    const GAS bf16* BE = (const GAS bf16*)(wb + WO_S5 + S5_KC_BYTES) + (size_t)g * 128 * 256;
    GAS bf16* YPRE = (GAS bf16*)(F.ws + WS_OV + OV_YPRE);
    constexpr int SLP = 136, UD = 5, UNS = 7;
    LAS bf16* SLh = (LAS bf16*)(F.lds + RING_OFF);
    LAS unsigned char* UR = F.lds + RING_OFF + 256 * SLP * 2;
    static_assert(256 * SLP * 2 + UNS * 8192 <= RING_BYTES, "S5 LDS map");
    const int ur = 2 * w + (lane >> 5), upc = ((lane & 31) ^ ur) * 16;
#define S5_ISSUE(ct_) do { const int c_ = (ct_) * 16 + ur; const int row_ = c_ == 0 ? 1024 : (c_ > 256 ? b * 256 + 255 : b * 256 + c_ - 1); \
        __builtin_amdgcn_global_load_lds((const GAS unsigned*)(U2b + (size_t)row_ * 512 + upc), (LAS unsigned*)(UR + ((ct_) % UNS) * 8192 + w * 1024), 16, 0, 0); } while (0)
#define S5_FRAG(sl_, p_) (*(const LAS bfx8*)((sl_) + ((((p_)) ^ fr) << 4)))
    {
        bfx8 wf[8];
#pragma unroll
        for (int ks = 0; ks < 8; ++ks) wf[ks] = *(const GAS bfx8*)(BE + (size_t)(16 * w + fr) * 256 + ks * 32 + 8 * fq);
        asm volatile("s_waitcnt vmcnt(0)" ::: "memory");
#pragma unroll
        for (int i = 0; i < UD; ++i) S5_ISSUE(i);
#pragma unroll
        for (int ct = 0; ct < 16; ++ct) {
            if (ct + UD < 16) S5_ISSUE(ct + UD);
            wait_vm(15 - ct < UD ? 15 - ct : UD);
            __builtin_amdgcn_s_barrier(); asm volatile("" ::: "memory");
            const LAS unsigned char* sl = UR + (ct % UNS) * 8192 + fr * 512;
            f32x4 acc = {0.f, 0.f, 0.f, 0.f};
#pragma unroll
            for (int ks = 0; ks < 8; ++ks) acc = __builtin_amdgcn_mfma_f32_16x16x32_bf16(wf[ks], S5_FRAG(sl, ks * 4 + fq), acc, 0, 0, 0);
            v2u o; o.x = cvt2(acc[0], acc[1]); o.y = cvt2(acc[2], acc[3]);
            *(LAS v2u*)(SLh + (ct * 16 + fr) * SLP + 16 * w + 4 * fq) = o;
        }
    }
    __syncthreads();
    {
        const int n = lane; const size_t lg = (size_t)L * NG + g;
        const float lr_ = inp(F, I_LRE)[lg * NS + n], li_ = inp(F, I_LIM)[lg * NS + n], dt_ = expf(inp(F, I_LDT)[lg]);
        float a_re, a_im, A_re, A_im; abar_pow(lr_, li_, dt_, 16, a_re, a_im); abar_pow(lr_, li_, dt_, 512, A_re, A_im);
        LAS float* TT = (LAS float*)UR;
        LAS bf16* seg = SLh + (size_t)(32 * w) * SLP;
        float pre[32], pim[32]; float sre = 0.f, sim = 0.f;
#pragma unroll
        for (int j = 0; j < 32; ++j) { const float cre = bfu(seg[j * SLP + n]), cim = bfu(seg[j * SLP + 64 + n]);
            const float nre = a_re * sre - a_im * sim + cre, nim = a_re * sim + a_im * sre + cim; sre = nre; sim = nim; pre[j] = sre; pim[j] = sim; }
        TT[w * 128 + n] = sre; TT[w * 128 + 64 + n] = sim;
        __syncthreads();
        float ire = 0.f, iim = 0.f;
        for (int k = 0; k < w; ++k) { const float tre = TT[k * 128 + n], tim = TT[k * 128 + 64 + n]; const float nre = A_re * ire - A_im * iim + tre, nim = A_re * iim + A_im * ire + tim; ire = nre; iim = nim; }
        float qre = a_re, qim = a_im;
#pragma unroll
        for (int j = 0; j < 32; ++j) { const float ore = pre[j] + qre * ire - qim * iim, oim = pim[j] + qre * iim + qim * ire;
            const unsigned o2 = cvt2(ore, oim); seg[j * SLP + n] = (bf16)o2; seg[j * SLP + 64 + n] = (bf16)(o2 >> 16);
            const float nq = qre * a_re - qim * a_im; qim = qre * a_im + qim * a_re; qre = nq; }
    }
    __syncthreads();
    {
        bfx8 wf[2][12];
#pragma unroll
        for (int tt = 0; tt < 2; ++tt)
#pragma unroll
            for (int ks = 0; ks < 12; ++ks) wf[tt][ks] = *(const GAS bfx8*)(KC + (size_t)(16 * (2 * w + tt) + fr) * 384 + ks * 32 + 8 * fq);
        const f32x4 d4 = *(const GAS f32x4*)(inp(F, I_SD) + (size_t)L * SW + g * SGC + 4 * fq);
        asm volatile("s_waitcnt vmcnt(0)" ::: "memory");
#pragma unroll
        for (int i = 0; i < UD; ++i) S5_ISSUE(i);
#pragma unroll
        for (int ct = 0; ct < 17; ++ct) {
            int nafter = 0;
            if (ct < UD) nafter = (UD - 1 - ct) + 3 * ct;
            else { nafter = 0;
#pragma unroll
                for (int j = ct - UD + 1; j < ct; ++j) nafter += 2 + (j + UD <= 16 ? 1 : 0); }
            wait_vm(nafter);
            __builtin_amdgcn_s_barrier(); asm volatile("" ::: "memory");
            const LAS unsigned char* sl = UR + (ct % UNS) * 8192 + fr * 512;
            const int c = ct * 16 + fr, cc = c <= 256 ? c : 256;
            f32x4 acc[2] = {{0.f, 0.f, 0.f, 0.f}, {0.f, 0.f, 0.f, 0.f}};
#pragma unroll
            for (int ks = 0; ks < 8; ++ks) { const bfx8 af = S5_FRAG(sl, ks * 4 + fq);
                acc[0] = __builtin_amdgcn_mfma_f32_16x16x32_bf16(wf[0][ks], af, acc[0], 0, 0, 0); acc[1] = __builtin_amdgcn_mfma_f32_16x16x32_bf16(wf[1][ks], af, acc[1], 0, 0, 0); }
#pragma unroll
            for (int ks = 0; ks < 4; ++ks) {
                bfx8 sf = {0, 0, 0, 0, 0, 0, 0, 0};
                if (cc >= 1) sf = *(const LAS bfx8*)(SLh + (cc - 1) * SLP + ks * 32 + 8 * fq);
                acc[0] = __builtin_amdgcn_mfma_f32_16x16x32_bf16(wf[0][8 + ks], sf, acc[0], 0, 0, 0); acc[1] = __builtin_amdgcn_mfma_f32_16x16x32_bf16(wf[1][8 + ks], sf, acc[1], 0, 0, 0);
            }
#pragma unroll
            for (int tt = 0; tt < 2; ++tt) { const int t = 2 * w + tt; const int row = cc == 0 ? MR + t : b * SEQ + (cc - 1) * 16 + t;
                const v2u uu = *(const LAS v2u*)(sl + (((2 * t + (fq >> 1)) ^ fr) << 4) + (fq & 1) * 8);
                const float u0 = __uint_as_float(uu.x << 16), u1 = __uint_as_float(uu.x & 0xffff0000u), u2 = __uint_as_float(uu.y << 16), u3 = __uint_as_float(uu.y & 0xffff0000u);
                v2u o; o.x = pk2(gelu_tanh(acc[tt][0] + d4[0] * u0), gelu_tanh(acc[tt][1] + d4[1] * u1)); o.y = pk2(gelu_tanh(acc[tt][2] + d4[2] * u2), gelu_tanh(acc[tt][3] + d4[3] * u3));
                *(GAS v2u*)(YPRE + (size_t)row * SW + g * SGC + 4 * fq) = o; }
            asm volatile("" ::: "memory");
            if (ct + UD < 17) S5_ISSUE(ct + UD);
        }
    }
#undef S5_ISSUE
#undef S5_FRAG
    __syncthreads();
}

constexpr size_t WLF_OFF = (size_t)4096 * LKP * 2;
static_assert(WO_LORA + WLF_OFF + 3 * 16 * 4 * 2 * 64 * 16 <= W_SLOT, "weight slot");
__device__ __forceinline__ void lora_weights(Frame& F, int L) {
    GAS unsigned char* wb = F.ws + WS_W + (size_t)(L & 1) * W_SLOT;
    GAS v4u* WL = (GAS v4u*)(wb + WO_LORA);
    const GAS float* w2 = inp(F, I_W2) + (size_t)L * 64 * RW_W; const GAS float* a2 = inp(F, I_A2) + (size_t)L * 64 * RW_W; const GAS float* g2 = inp(F, I_G2) + (size_t)L * 160 * RW_W;
    const GAS float* v2 = inp(F, I_V2) + (size_t)(L > 0 ? L - 1 : 0) * 32 * RW_W;
    for (int i = (int)(F.vcu * (NWAVES * 64) + F.tid); i < 4096 * (LKP / 8); i += F.G * NWAVES * 64) {
        const int row = i / (LKP / 8), k0 = (i - row * (LKP / 8)) * 8, kind = row >> 10, ch = row & 1023; float v[8];
#pragma unroll
        for (int e = 0; e < 8; ++e) { const int k = k0 + e; float x = 0.f;
            if (kind == 0) { if (k < 64) x = w2[(size_t)k * RW_W + ch]; }
            else if (kind == 1) { if (k >= 64 && k < 128) x = a2[(size_t)(k - 64) * RW_W + ch]; }
            else if (kind == 2) { if (k >= 128 && k < 288) x = g2[(size_t)(k - 128) * RW_W + ch]; }
            else { if (L > 0 && k >= 288 && k < 320) x = v2[(size_t)(k - 288) * RW_W + ch]; }
            v[e] = x; }
        v4u o; o.x = pk2(v[0], v[1]); o.y = pk2(v[2], v[3]); o.z = pk2(v[4], v[5]); o.w = pk2(v[6], v[7]); WL[i] = o;
    }
    GAS v4u* WLF = (GAS v4u*)(wb + WO_LORA + WLF_OFF);
    for (int i = (int)(F.vcu * (NWAVES * 64) + F.tid); i < 3 * 16 * 4 * 2 * 64; i += F.G * NWAVES * 64) {
        const int ln = i & 63, sk = (i >> 6) & 1, tile = (i >> 7) & 3, h = (i >> 9) & 15, kd = i >> 13, c16 = ln & 15, g = ln >> 4, ch = h * HD + 16 * tile + c16, k0 = 32 * sk + 8 * g; float v[8];
#pragma unroll
        for (int e = 0; e < 8; ++e) { const int k = k0 + e; float x = 0.f;
            if (kd == 0) x = w2[(size_t)k * RW_W + ch]; else if (kd == 1) x = a2[(size_t)k * RW_W + ch]; else if (L > 0 && k < 32) x = v2[(size_t)k * RW_W + ch];
            v[e] = x; }
        v4u o; o.x = pk2(v[0], v[1]); o.y = pk2(v[2], v[3]); o.z = pk2(v[4], v[5]); o.w = pk2(v[6], v[7]); WLF[i] = o;
    }
}
__device__ __forceinline__ void lora_inputs(Frame& F, int L) {
    const int gw = F.vcu * NWAVES + F.wave, NGW = F.G * NWAVES, k0 = 8 * F.lane;
    const GAS bf16* LIN = (const GAS bf16*)(F.ws + WS_OV + OV_LIN); GAS bf16* LA = (GAS bf16*)(F.ws + WS_OV + OV_LA);
    if (k0 >= LKP) return;
    f32x4 m0 = {0.f, 0.f, 0.f, 0.f}, m1 = m0;
    if (k0 < 288) { const GAS float* ms = inp(F, I_MUSH) + (size_t)L * 3360 + 3072 + k0; m0 = *(const GAS f32x4*)ms; m1 = *(const GAS f32x4*)(ms + 4); }
    else if (k0 < 320 && L > 0) { const GAS float* mv = inp(F, I_MUVR) + (size_t)(L - 1) * 32 + (k0 - 288); m0 = *(const GAS f32x4*)mv; m1 = *(const GAS f32x4*)(mv + 4); }
    const bool live = k0 < 288 || (k0 < 320 && L > 0);
    for (int row = gw; row < MROWS; row += NGW) {
        v4u o = {0u, 0u, 0u, 0u};
        if (live) { const int prow = prev_row(row);
            f32x4 x0, x1, p0 = {0.f, 0.f, 0.f, 0.f}, p1 = p0;
            pg8::unpack8(*(const GAS v4u*)(LIN + (size_t)row * 512 + k0), x0, x1);
            if (prow >= 0) pg8::unpack8(*(const GAS v4u*)(LIN + (size_t)prow * 512 + k0), p0, p1);
            x0 = x0 + m0 * (p0 - x0); x1 = x1 + m1 * (p1 - x1);
            if (k0 < 64) {
#pragma unroll
                for (int e = 0; e < 4; ++e) { x0[e] = 1.0f - 2.0f * __builtin_amdgcn_rcpf(1.0f + __expf(2.0f * x0[e])); x1[e] = 1.0f - 2.0f * __builtin_amdgcn_rcpf(1.0f + __expf(2.0f * x1[e])); }
            } else if (k0 >= 128 && k0 < 288) {
#pragma unroll
                for (int e = 0; e < 4; ++e) { x0[e] = __builtin_amdgcn_rcpf(1.0f + __expf(-x0[e])); x1[e] = __builtin_amdgcn_rcpf(1.0f + __expf(-x1[e])); }
            }
            o.x = pk2(x0[0], x0[1]); o.y = pk2(x0[2], x0[3]); o.z = pk2(x1[0], x1[1]); o.w = pk2(x1[2], x1[3]); }
        *(GAS v4u*)(LA + (size_t)row * LKP + k0) = o;
    }
}
__device__ __forceinline__ f32x4 ld_bf4(const GAS bf16* p) { const v2u u = *(const GAS v2u*)p; return (f32x4){__uint_as_float(u.x << 16), __uint_as_float(u.x & 0xffff0000u), __uint_as_float(u.y << 16), __uint_as_float(u.y & 0xffff0000u)}; }
constexpr int REC_TB = 32, REC_F = 6 * HD, REC_LF = REC_F + 4, REC_NBLK = (TSEQ + REC_TB - 1) / REC_TB, REC_OBUF = 2 * REC_TB * REC_LF;
__device__ __forceinline__ void rwkv_rec_unit(Frame& F, int L, int b, int h, int q) {
    GAS float* O = (GAS float*)(F.ws + WS_OV + OV_O);
    LAS float* buf = (LAS float*)(F.lds + RING_OFF);
    const bool loader = F.wave >= 4;
    const int lt = F.tid - 256;
    const int rg = F.lane >> 4, j = F.lane & 15, lrow = (F.wave & 3) * 4 + rg, vrow = q * 16 + lrow;
    f32x4 S = {0.f, 0.f, 0.f, 0.f};
    const int ltk = lt >> 4, lj = lt & 15, C = h * HD + 4 * lj;
    const GAS bf16* RKVp = (const GAS bf16*)(F.ws + WS_OV + OV_RKV); const GAS bf16* DECp = (const GAS bf16*)(F.ws + WS_OV + OV_DEC); const GAS bf16* ICLp = (const GAS bf16*)(F.ws + WS_OV + OV_ICLR);
    const GAS bf16* VGp = (const GAS bf16*)(F.ws + WS_OV + OV_VG);
    LAS float* PL = (LAS float*)(F.lds + LDSCTL_OFF + 1024);
    for (int pi = F.wave; pi < 9; pi += NWAVES) {
        const GAS float* src = pi < 3 ? inp(F, I_MUSH) + (size_t)L * 3360 + pi * 1024 : pi == 3 ? inp(F, I_W0) + (size_t)L * RW_W : pi == 4 ? inp(F, I_A0) + (size_t)L * RW_W : pi == 5 ? inp(F, I_V0) + (size_t)(L > 0 ? L - 1 : 0) * RW_W
                             : pi == 6 ? inp(F, I_KK) + (size_t)L * RW_W : pi == 7 ? inp(F, I_KA) + (size_t)L * RW_W : inp(F, I_RK) + (size_t)L * RW_W;
        const float x = src[h * HD + F.lane];
        PL[pi * 64 + F.lane] = (pi == 5 && L == 0) ? 0.f : x; }
    __syncthreads();
    v2u rr[2][2], rk_[2][2], rv[2][2], rvg[2], rvf[2], rdc[2], ric[2];
#define REC_LOAD(blk) do { \
        _Pragma("unroll") for (int p_ = 0; p_ < 2; ++p_) { int s_ = (blk) * REC_TB + ltk + 16 * p_; s_ = s_ > TSEQ - 1 ? TSEQ - 1 : s_; const int sp_ = s_ > 0 ? s_ - 1 : 0; \
            const size_t ro_ = (size_t)seq_row(b, s_) * RW_W + C, rp_ = (size_t)seq_row(b, sp_) * RW_W + C; \
            rr[p_][0] = *(const GAS v2u*)(RKVp + ro_); rr[p_][1] = *(const GAS v2u*)(RKVp + rp_); \
            rk_[p_][0] = *(const GAS v2u*)(RKVp + (size_t)MP * 1024 + ro_); rk_[p_][1] = *(const GAS v2u*)(RKVp + (size_t)MP * 1024 + rp_); \
            rv[p_][0] = *(const GAS v2u*)(RKVp + (size_t)2 * MP * 1024 + ro_); rv[p_][1] = *(const GAS v2u*)(RKVp + (size_t)2 * MP * 1024 + rp_); \
            rdc[p_] = *(const GAS v2u*)(DECp + ro_); ric[p_] = *(const GAS v2u*)(ICLp + ro_); \
            if (L > 0) { rvg[p_] = *(const GAS v2u*)(VGp + ro_); rvf[p_] = *(const GAS v2u*)(FVF(F) + ro_); } } } while (0)
#define UB4(u) ((f32x4){__uint_as_float((u).x << 16), __uint_as_float((u).x & 0xffff0000u), __uint_as_float((u).y << 16), __uint_as_float((u).y & 0xffff0000u)})
#define REC_STORE(bi, blk) do { int lj2_ = lt & 15; asm volatile("" : "+v"(lj2_)); const LAS float* plj = PL + 4 * lj2_;     \
        _Pragma("unroll") for (int p_ = 0; p_ < 2; ++p_) { const int tk_ = ltk + 16 * p_, s_ = (blk) * REC_TB + tk_; const float pm_ = s_ > 0 ? 1.f : 0.f; \
            f32x4 xr_, xk_, xv_, dec_, icl_, vv_; \
            { const f32x4 mu_r = *(const LAS f32x4*)(plj), mu_k = *(const LAS f32x4*)(plj + 64), mu_v = *(const LAS f32x4*)(plj + 128); \
              const f32x4 r1_ = UB4(rr[p_][0]), k1_ = UB4(rk_[p_][0]), v1_ = UB4(rv[p_][0]); \
              xr_ = r1_ + mu_r * (UB4(rr[p_][1]) * pm_ - r1_); xk_ = k1_ + mu_k * (UB4(rk_[p_][1]) * pm_ - k1_); xv_ = v1_ + mu_v * (UB4(rv[p_][1]) * pm_ - v1_); } \
            asm volatile("" ::: "memory"); \
            { const f32x4 wl_ = UB4(rdc[p_]) + *(const LAS f32x4*)(plj + 192), al_ = UB4(ric[p_]) + *(const LAS f32x4*)(plj + 256); vv_ = xv_; \
              if (L > 0) { const f32x4 vf_ = UB4(rvf[p_]), vg_ = UB4(rvg[p_]) + *(const LAS f32x4*)(plj + 320); \
                  _Pragma("unroll") for (int e_ = 0; e_ < 4; ++e_) vv_[e_] = xv_[e_] + (vf_[e_] - xv_[e_]) * __builtin_amdgcn_rcpf(1.0f + __expf(-vg_[e_])); } \
              _Pragma("unroll") for (int e_ = 0; e_ < 4; ++e_) {        \
                  dec_[e_] = __expf(-0.60653066f * __builtin_amdgcn_rcpf(1.0f + __expf(-wl_[e_]))); icl_[e_] = __builtin_amdgcn_rcpf(1.0f + __expf(-al_[e_])); } } \
            asm volatile("" ::: "memory"); \
            const f32x4 kkc = *(const LAS f32x4*)(plj + 384), kac = *(const LAS f32x4*)(plj + 448), rkc = *(const LAS f32x4*)(plj + 512); \
            f32x4 kk_, k2_, bb_, wr_; float skk_ = 0.f, srk_ = 0.f, sbr_ = 0.f, skr_ = 0.f; \
            _Pragma("unroll") for (int e_ = 0; e_ < 4; ++e_) { \
                kk_[e_] = xk_[e_] * kkc[e_]; skk_ += kk_[e_] * kk_[e_]; k2_[e_] = xk_[e_] * (1.0f + (icl_[e_] - 1.0f) * kac[e_]); \
                srk_ += xr_[e_] * k2_[e_] * rkc[e_]; skr_ += k2_[e_] * xr_[e_]; } \
            const float inv_ = rsqrtf(row16_sum(skk_) + 1e-12f); \
            _Pragma("unroll") for (int e_ = 0; e_ < 4; ++e_) { kk_[e_] *= inv_; bb_[e_] = kk_[e_] * icl_[e_]; sbr_ += bb_[e_] * xr_[e_]; wr_[e_] = dec_[e_] * xr_[e_]; } \
            const float br_ = row16_sum(sbr_), kr_ = row16_sum(skr_); \
            LAS float* rec_ = buf + (bi) * (REC_TB * REC_LF) + tk_ * REC_LF + 4 * lj; \
            *(LAS f32x4*)(rec_) = dec_; *(LAS f32x4*)(rec_ + HD) = k2_; *(LAS f32x4*)(rec_ + 2 * HD) = -kk_; *(LAS f32x4*)(rec_ + 3 * HD) = bb_; *(LAS f32x4*)(rec_ + 4 * HD) = wr_; *(LAS f32x4*)(rec_ + 5 * HD) = vv_; \
            if (lj == 0) *(LAS f32x2*)(rec_ + REC_F) = (f32x2){br_, kr_}; \
            if (q == 0 && s_ < TSEQ) { const size_t ro_ = (size_t)seq_row(b, s_) * RW_W + C; const float rks_ = row16_sum(srk_); \
                *(GAS f32x4*)((GAS float*)(F.ws + WS_OV + OV_RW) + ro_) = vv_; if (lj == 0) ((GAS float*)(F.ws + WS_OV + OV_RKS))[(size_t)seq_row(b, s_) * NH + h] = rks_; \
                if (L == 0) { v2u o_; o_.x = pk2(xv_[0], xv_[1]); o_.y = pk2(xv_[2], xv_[3]); *(GAS v2u*)(FVF(F) + ro_) = o_; } } \
            asm volatile("" ::: "memory"); } } while (0)
#define REC_LD(X, tk) do { const LAS float* q_ = rp + (tk) * REC_LF; w##X = *(const LAS f32x4*)(q_); k##X = *(const LAS f32x4*)(q_ + HD); a##X = *(const LAS f32x4*)(q_ + 2 * HD); b##X = *(const LAS f32x4*)(q_ + 3 * HD); r##X = *(const LAS f32x4*)(q_ + 4 * HD); \
        v##X = q_[5 * HD - 4 * j + vrow]; s##X = *(const LAS f32x2*)(q_ + REC_F - 4 * j); } while (0)
#define REC_STEP(X, tk) do { float t0_, t1_, u0_, u1_, q0_, q1_, q2_, q3_, o_; \
        asm("v_mul_f32 %4, %0, %12\n\tv_mul_f32 %5, %0, %16\n\tv_fmac_f32 %4, %1, %13\n\tv_fmac_f32 %5, %1, %17\n\t" \
            "v_mul_f32 %6, %2, %14\n\tv_mul_f32 %7, %2, %18\n\tv_fmac_f32 %6, %3, %15\n\tv_fmac_f32 %7, %3, %19\n\t" \
            "v_add_f32 %4, %4, %6\n\tv_add_f32 %5, %5, %7\n\t" \
            "v_mul_f32 %8, %28, %24\n\t" \
            "v_add_f32_dpp %4, %4, %4 quad_perm:[1,0,3,2] row_mask:0xf bank_mask:0xf bound_ctrl:1\n\tv_add_f32_dpp %5, %5, %5 quad_perm:[1,0,3,2] row_mask:0xf bank_mask:0xf bound_ctrl:1\n\t" \
            "v_mul_f32 %9, %28, %25\n\t" \
            "v_add_f32_dpp %4, %4, %4 quad_perm:[2,3,0,1] row_mask:0xf bank_mask:0xf bound_ctrl:1\n\tv_add_f32_dpp %5, %5, %5 quad_perm:[2,3,0,1] row_mask:0xf bank_mask:0xf bound_ctrl:1\n\t" \
            "v_mul_f32 %10, %28, %26\n\t" \
            "v_add_f32_dpp %4, %4, %4 row_ror:4 row_mask:0xf bank_mask:0xf bound_ctrl:1\n\tv_add_f32_dpp %5, %5, %5 row_ror:4 row_mask:0xf bank_mask:0xf bound_ctrl:1\n\t" \
            "v_mul_f32 %11, %28, %27\n\t" \
            "v_add_f32_dpp %4, %4, %4 row_ror:8 row_mask:0xf bank_mask:0xf bound_ctrl:1\n\tv_add_f32_dpp %5, %5, %5 row_ror:8 row_mask:0xf bank_mask:0xf bound_ctrl:1\n\t" \
            "v_fma_f32 %0, %0, %20, %8\n\tv_fma_f32 %1, %1, %21, %9\n\tv_fma_f32 %2, %2, %22, %10\n\tv_fma_f32 %3, %3, %23, %11" \
            : "+v"(S[0]), "+v"(S[1]), "+v"(S[2]), "+v"(S[3]), "=&v"(t0_), "=&v"(u0_), "=&v"(t1_), "=&v"(u1_), "=&v"(q0_), "=&v"(q1_), "=&v"(q2_), "=&v"(q3_) \
            : "v"(a##X[0]), "v"(a##X[1]), "v"(a##X[2]), "v"(a##X[3]), "v"(r##X[0]), "v"(r##X[1]), "v"(r##X[2]), "v"(r##X[3]), "v"(w##X[0]), "v"(w##X[1]), "v"(w##X[2]), "v"(w##X[3]), \
              "v"(k##X[0]), "v"(k##X[1]), "v"(k##X[2]), "v"(k##X[3]), "v"(v##X)); \
        asm("v_fmac_f32 %0, %5, %7\n\tv_fmac_f32 %1, %5, %8\n\tv_fmac_f32 %2, %5, %9\n\tv_fmac_f32 %3, %5, %10\n\tv_fma_f32 %4, %5, %11, %6\n\tv_fmac_f32 %4, %13, %12" \
            : "+v"(S[0]), "+v"(S[1]), "+v"(S[2]), "+v"(S[3]), "=&v"(o_) \
            : "v"(t0_), "v"(u0_), "v"(b##X[0]), "v"(b##X[1]), "v"(b##X[2]), "v"(b##X[3]), "v"(s##X[0]), "v"(s##X[1]), "v"(v##X)); \
        ob[(tk) * 16 + lrow] = o_; } while (0)
    const bool conv = F.wave >= 5 && L + 1 < DEPTH;
    LAS unsigned* cscr = (LAS unsigned*)(buf + REC_OBUF + 2 * REC_TB * 16) + (F.wave - 5) * (64 * 36);
    int ct = F.vcu * 3 + (F.wave - 5);
    if (loader) { REC_LOAD(0); REC_STORE(0, 0); REC_LOAD(1); }
    __syncthreads();
    for (int blk = 0; blk < REC_NBLK; ++blk) {
        const int s0 = blk * REC_TB, nt = TSEQ - s0 < REC_TB ? TSEQ - s0 : REC_TB;
        LAS float* ob = buf + REC_OBUF + (blk & 1) * (REC_TB * 16);
        if (loader) {
            if (blk + 1 < REC_NBLK) REC_STORE((blk + 1) & 1, blk + 1);
            if (blk > 0) { const LAS float* pb = buf + REC_OBUF + ((blk - 1) & 1) * (REC_TB * 16); const int ps0 = s0 - REC_TB;
#pragma unroll
                for (int i = 0; i < 2; ++i) { const int idx = lt + 256 * i, tk = idx >> 4, r = idx & 15; O[(size_t)seq_row(b, ps0 + tk) * RW_W + h * HD + q * 16 + r] = pb[idx]; } }
            if (conv) { int m_, it_;
                if (tr_decode(L + 1, ct, m_, it_)) { const TrDesc d = tr_desc(F, L + 1, m_); f32x4 cv[16]; tr_tile_load(d, it_, F.lane, cv); tr_tile_finish(d, it_, F.lane, cv, cscr); ct += 3 * F.G; } }
            if (blk + 2 < REC_NBLK) REC_LOAD(blk + 2);
        } else {
            const LAS float* rp = buf + (blk & 1) * (REC_TB * REC_LF) + 4 * j;
            f32x4 wA, kA, aA, bA, rA, wB, kB, aB, bB, rB; float vA, vB; f32x2 sA, sB;
            REC_LD(A, 0);
            if (nt == REC_TB) {
#pragma unroll
                for (int tk = 0; tk < REC_TB; tk += 2) {
                    REC_LD(B, tk + 1);
                    REC_STEP(A, tk);
                    if (tk + 2 < REC_TB) REC_LD(A, tk + 2);
                    REC_STEP(B, tk + 1);
                }
            } else {
                for (int tk = 0; tk < nt; tk += 2) {
                    REC_LD(B, tk + 1);
                    REC_STEP(A, tk);
                    if (tk + 2 < nt) REC_LD(A, tk + 2);
                    REC_STEP(B, tk + 1);
                }
            }
        }
        __syncthreads();
    }
    if (loader) { const int lb = REC_NBLK - 1, ps0 = lb * REC_TB, nt = TSEQ - ps0; const LAS float* pb = buf + REC_OBUF + (lb & 1) * (REC_TB * 16);
        int b2 = b; asm volatile("" : "+s"(b2));
#pragma unroll
        for (int i = 0; i < 2; ++i) { const int idx = lt + 256 * i, tk = idx >> 4, r = idx & 15; if (tk < nt) O[(size_t)seq_row(b2, ps0 + tk) * RW_W + h * HD + q * 16 + r] = pb[idx]; } }
    if (conv) {
        for (;;) { int m_, it_; if (!tr_decode(L + 1, ct, m_, it_)) break;
            const TrDesc d = tr_desc(F, L + 1, m_); f32x4 cv[16]; tr_tile_load(d, it_, F.lane, cv); tr_tile_finish(d, it_, F.lane, cv, cscr); ct += 3 * F.G; }
    }
    __syncthreads();
#undef REC_LOAD
#undef UB4
#undef REC_STORE
#undef REC_LD
#undef REC_STEP
}
constexpr int CH_T = 16, CH_N = TSEQ / CH_T;
constexpr int CR_BYTES = 12288, CR_AT = 0, CR_RT = 2048, CR_BK = 4096, CR_ARK = 8192, CR_VT = 9216, CR_GT = 11264, CR_W15 = 11776;
constexpr size_t OV_CR = OV_RW + 192 * MiB;
static_assert(TSEQ % CH_T == 0, "chunks"); static_assert(OV_CR + (size_t)BATCH * NH * CH_N * CR_BYTES <= OV_O, "chunk records");
typedef short bfx4 __attribute__((ext_vector_type(4)));
__device__ __forceinline__ float sigm_(float x) { return __builtin_amdgcn_rcpf(1.0f + __expf(-x)); }
template <int CTRL, int RMASK> __device__ __forceinline__ float dppf(float x) { return __builtin_bit_cast(float, __builtin_amdgcn_update_dpp(0, __builtin_bit_cast(int, x), CTRL, RMASK, 0xF, false)); }
__device__ __forceinline__ void wave_sum2(float& x, float& y) {
    x += dppf<0xB1, 0xF>(x); y += dppf<0xB1, 0xF>(y); x += dppf<0x4E, 0xF>(x); y += dppf<0x4E, 0xF>(y); x += dppf<0x124, 0xF>(x); y += dppf<0x124, 0xF>(y); x += dppf<0x128, 0xF>(x); y += dppf<0x128, 0xF>(y);
    x += dppf<0x142, 0xA>(x); y += dppf<0x142, 0xA>(y); x += dppf<0x143, 0xC>(x); y += dppf<0x143, 0xC>(y);
    x = lane_bcast(x, 63); y = lane_bcast(y, 63);
}
__device__ __forceinline__ LAS float* rwkv_prep_par(Frame& F, int L, int h) {
    constexpr float LOG2E = 1.4426950408889634f; const int lane = F.lane; const size_t lc = (size_t)L * RW_W + h * HD;
    LAS float* pp = (LAS float*)(F.lds + RING_OFF + 8 * 12288 + F.wave * 2304);
    const GAS float* mu = inp(F, I_MUSH) + (size_t)L * 3360 + h * HD;
    pp[lane] = mu[lane]; pp[64 + lane] = mu[1024 + lane]; pp[128 + lane] = mu[2048 + lane];
    pp[192 + lane] = -LOG2E * (inp(F, I_W0) + lc)[lane]; pp[256 + lane] = -LOG2E * (inp(F, I_A0) + lc)[lane];
    float v0 = 0.f; if (L > 0) v0 = -LOG2E * (inp(F, I_V0) + (lc - RW_W))[lane];
    pp[320 + lane] = v0; pp[384 + lane] = (inp(F, I_KK) + lc)[lane]; pp[448 + lane] = (inp(F, I_KA) + lc)[lane]; pp[512 + lane] = (inp(F, I_RK) + lc)[lane];
    return pp;
}
__device__ __forceinline__ void rwkv_prep_item(Frame& F, int L, int b, int h, int c, const LAS float* pp) {
    const int lane = F.lane, c16 = lane & 15, g = lane >> 4;
    LAS unsigned char* pl = F.lds + RING_OFF + F.wave * 12288;
    LAS bf16* M = (LAS bf16*)pl; LAS float* NT = (LAS float*)(pl + 9216); LAS float* AKT = NT + 256; LAS float* XGT = AKT + 256;
    GAS unsigned char* rec = F.ws + WS_OV + OV_CR + ((size_t)(b * NH + h) * CH_N + c) * CR_BYTES;
    const int rb = c == 0 ? MR : b * SEQ + (c - 1) * CH_T;
    const int rprev = c == 0 ? MR : (c == 1 ? MR + NMETA - 1 : rb - 1); const float pm0 = c == 0 ? 0.f : 1.f;
    constexpr float LOG2E = 1.4426950408889634f;
    const float mu_r = pp[lane], mu_k = pp[64 + lane], mu_v = pp[128 + lane], w0 = pp[192 + lane], a0 = pp[256 + lane], v0 = pp[320 + lane], k_k = pp[384 + lane], k_a = pp[448 + lane], r_k = pp[512 + lane];
    constexpr size_t PL = (size_t)MP * 1024;
    const GAS bf16* Rg = (const GAS bf16*)(F.ws + WS_OV + OV_RKV) + h * HD; GAS bf16* VFg = FVF(F) + h * HD;
    const int wrow = lane >> 3, wpc = lane & 7; v4u wr_[2], wk_[2], wv_[2], wf_[2];
#pragma unroll
    for (int i = 0; i < 2; ++i) { const size_t ro = (size_t)(rb + 8 * i + wrow) * 1024 + wpc * 8;
        wr_[i] = __builtin_nontemporal_load((const GAS v4u*)(Rg + ro)); wk_[i] = __builtin_nontemporal_load((const GAS v4u*)(Rg + PL + ro)); wv_[i] = __builtin_nontemporal_load((const GAS v4u*)(Rg + 2 * PL + ro));
        wf_[i] = (v4u){0u, 0u, 0u, 0u}; if (L > 0) wf_[i] = *(const GAS v4u*)(VFg + ro); }
    unsigned dl[8], il[8], gl[8];
    {
        const GAS bf16* LAg = (const GAS bf16*)(F.ws + WS_OV + OV_LA) + (size_t)(rb + c16) * LKP + 8 * g;
        const GAS bfx8* WLF = (const GAS bfx8*)(F.ws + WS_W + (size_t)(L & 1) * W_SLOT + WO_LORA + WLF_OFF) + lane;
        LAS float* TS = (LAS float*)pl;
#pragma unroll
        for (int kd = 0; kd < 3; ++kd) { const int kind = kd == 2 ? 3 : kd, kb = kd == 0 ? 0 : kd == 1 ? 64 : 288, nks = kd == 2 ? 1 : 2;
            if (kd == 2 && L == 0) break;
            bfx8 lb[2];
#pragma unroll
            for (int sk = 0; sk < nks; ++sk) lb[sk] = *(const GAS bfx8*)(LAg + kb + 32 * sk);
#pragma unroll
            for (int tile = 0; tile < 4; ++tile) { f32x4 acc = {0.f, 0.f, 0.f, 0.f};
#pragma unroll
                for (int sk = 0; sk < nks; ++sk) acc = __builtin_amdgcn_mfma_f32_16x16x32_bf16(WLF[(((kd * 16 + h) * 4 + tile) * 2 + sk) * 64], lb[sk], acc, 0, 0, 0);
#pragma unroll
                for (int e = 0; e < 4; ++e) TS[(16 * tile + 4 * g + e) * 20 + c16] = acc[e]; }
#pragma unroll
            for (int q = 0; q < 4; ++q) { const f32x4 v = *(const LAS f32x4*)(TS + lane * 20 + 4 * q);
#pragma unroll
                for (int e = 0; e < 2; ++e) { const unsigned u2 = cvt2(v[2 * e], v[2 * e + 1]); if (kd == 0) dl[2 * q + e] = u2; else if (kd == 1) il[2 * q + e] = u2; else gl[2 * q + e] = u2; } }
            asm volatile("" ::: "memory");
        }
    }
#pragma unroll
    for (int i = 0; i < 2; ++i) { LAS bf16* wp = M + (8 * i + wrow) * 72 + wpc * 8;
        *(LAS bfx8*)(wp) = __builtin_bit_cast(bfx8, wr_[i]); *(LAS bfx8*)(wp + 1152) = __builtin_bit_cast(bfx8, wk_[i]); *(LAS bfx8*)(wp + 2304) = __builtin_bit_cast(bfx8, wv_[i]); *(LAS bfx8*)(wp + 3456) = __builtin_bit_cast(bfx8, wf_[i]); }
    GAS bf16* Vout = (GAS bf16*)(F.ws + WS_OV + OV_RW) + h * HD; GAS float* RKS = (GAS float*)(F.ws + WS_OV + OV_RKS);
    float pr = bfu((Rg + (size_t)rprev * 1024)[lane]) * pm0, pk = bfu((Rg + PL + (size_t)rprev * 1024)[lane]) * pm0, pv = bfu((Rg + 2 * PL + (size_t)rprev * 1024)[lane]) * pm0;
    float cum = 0.f, wex = 1.f, Ah[16], rksv = 0.f; unsigned Bp[8], Kq[8], Vq[8], bkl = 0u; float vlo = 0.f;
    LAS bf16* VO = (LAS bf16*)NT;
#pragma unroll
    for (int hf = 0; hf < 2; ++hf) {
#pragma unroll
        for (int e = 0; e < 8; ++e) { const int t = 8 * hf + e; const size_t ro = (size_t)(rb + t) * 1024;
            const float r1 = bfu(M[t * 72 + lane]), k1 = bfu(M[1152 + t * 72 + lane]), v1 = bfu(M[2304 + t * 72 + lane]), vf1 = bfu(M[3456 + t * 72 + lane]);
            const float xr = r1 + mu_r * (pr - r1), xk = k1 + mu_k * (pk - k1), xv = v1 + mu_v * (pv - v1); pr = r1; pk = k1; pv = v1;
#define PKF(a_) ((t & 1) ? __uint_as_float((a_)[t >> 1] & 0xffff0000u) : __uint_as_float((a_)[t >> 1] << 16))
            const float sg = __builtin_amdgcn_rcpf(1.0f + __builtin_amdgcn_exp2f(__builtin_fmaf(PKF(dl), -LOG2E, w0))), icl = __builtin_amdgcn_rcpf(1.0f + __builtin_amdgcn_exp2f(__builtin_fmaf(PKF(il), -LOG2E, a0)));
            float vv = xv; if (L > 0) vv = xv + (vf1 - xv) * __builtin_amdgcn_rcpf(1.0f + __builtin_amdgcn_exp2f(__builtin_fmaf(PKF(gl), -LOG2E, v0)));
#undef PKF
            float kk = xk * k_k; const float k2 = xk * (1.0f + (icl - 1.0f) * k_a);
            float skk = kk * kk, rks = xr * k2 * r_k; wave_sum2(skk, rks);
            kk *= __builtin_amdgcn_rsqf(skk + 1e-12f);
            rksv = lane == t ? rks : rksv;
            cum = __builtin_fmaf(sg, -0.60653066f * LOG2E, cum); const float win = __builtin_amdgcn_exp2f(cum), iwin = __builtin_amdgcn_exp2f(-cum);
            const float ah = -kk * wex, rh = xr * win, bh = kk * icl * iwin, kh = k2 * iwin; wex = win; Ah[t] = ah;
            const unsigned ar = cvt2(ah, rh), bk = cvt2(bh, kh);
            M[t * 72 + lane] = (bf16)ar; M[1152 + t * 72 + lane] = (bf16)(ar >> 16); M[2304 + t * 72 + lane] = (bf16)bk; M[3456 + t * 72 + lane] = (bf16)(bk >> 16);
            if (t & 1) { Bp[t >> 1] = (bkl & 0xffffu) | (bk << 16); Kq[t >> 1] = (bkl >> 16) | (bk & 0xffff0000u); Vq[t >> 1] = cvt2(vlo, vv); VO[(t - 1) * 72 + lane] = (bf16)Vq[t >> 1]; VO[t * 72 + lane] = (bf16)(Vq[t >> 1] >> 16); } else { bkl = bk; vlo = vv; } }
    }
    int l2_ = lane; asm volatile("" : "+v"(l2_));
    if (l2_ < 16) RKS[(size_t)(rb + l2_) * NH + h] = rksv; const int wrow2 = l2_ >> 3, wpc2 = l2_ & 7;
#pragma unroll
    for (int i = 0; i < 2; ++i) __builtin_nontemporal_store(__builtin_bit_cast(v4u, *(const LAS bfx8*)(VO + (8 * i + wrow2) * 72 + wpc2 * 8)), (GAS v4u*)(Vout + (size_t)(rb + 8 * i + wrow2) * 1024 + wpc2 * 8));
    if (L == 0) {
#pragma unroll
        for (int i = 0; i < 2; ++i) *(GAS v4u*)(VFg + (size_t)(rb + 8 * i + wrow2) * 1024 + wpc2 * 8) = __builtin_bit_cast(v4u, *(const LAS bfx8*)(VO + (8 * i + wrow2) * 72 + wpc2 * 8)); }
    f32x4 Nm = {0.f, 0.f, 0.f, 0.f}, AK = Nm, RB = Nm, RK = Nm;
#pragma unroll
    for (int s = 0; s < 2; ++s) { const int o = c16 * 72 + 32 * s + 8 * g;
        const bfx8 at = *(const LAS bfx8*)(M + o), rt = *(const LAS bfx8*)(M + 1152 + o), bt = *(const LAS bfx8*)(M + 2304 + o), kt = *(const LAS bfx8*)(M + 3456 + o);
        Nm = __builtin_amdgcn_mfma_f32_16x16x32_bf16(bt, at, Nm, 0, 0, 0); AK = __builtin_amdgcn_mfma_f32_16x16x32_bf16(kt, at, AK, 0, 0, 0);
        RB = __builtin_amdgcn_mfma_f32_16x16x32_bf16(bt, rt, RB, 0, 0, 0); RK = __builtin_amdgcn_mfma_f32_16x16x32_bf16(kt, rt, RK, 0, 0, 0); }
#pragma unroll
    for (int e = 0; e < 4; ++e) { const int s = 4 * g + e; if (!(s < c16)) { Nm[e] = 0.f; AK[e] = 0.f; } if (!(s <= c16)) { RB[e] = 0.f; RK[e] = 0.f; } }
    *(LAS f32x4*)(NT + c16 * 16 + 4 * g) = Nm; *(LAS f32x4*)(AKT + c16 * 16 + 4 * g) = AK;
    { v4u o; o.x = cvt2(RB[0], RB[1]); o.y = cvt2(RB[2], RB[3]); o.z = cvt2(RK[0], RK[1]); o.w = cvt2(RK[2], RK[3]); __builtin_nontemporal_store(o, (GAS v4u*)(rec + CR_ARK + lane * 16)); }
    float X[16], Gx[16];
#pragma unroll
    for (int t = 0; t < 16; ++t) { float xa = Ah[t], xg = AKT[t * 16 + c16];
#pragma unroll
        for (int q = 0; q < (t + 3) / 4; ++q) { const f32x4 n4 = *(const LAS f32x4*)(NT + t * 16 + 4 * q);
#pragma unroll
            for (int e = 0; e < 4; ++e) if (4 * q + e < t) { xa += n4[e] * X[4 * q + e]; xg += n4[e] * Gx[4 * q + e]; } }
        X[t] = xa; Gx[t] = xg; }
#pragma unroll
    for (int t = 0; t < 16; t += 2) { const unsigned x2 = cvt2(X[t], X[t + 1]); M[t * 72 + lane] = (bf16)x2; M[(t + 1) * 72 + lane] = (bf16)(x2 >> 16); }
#pragma unroll
    for (int t = 0; t < 16; ++t) XGT[t * 16 + c16] = Gx[t];
#pragma unroll
    for (int s = 0; s < 2; ++s) { const int o = c16 * 72 + 32 * s + 4 * g;
        const v2u a0_ = __builtin_bit_cast(v2u, *(const LAS bfx4*)(M + o)), a1_ = __builtin_bit_cast(v2u, *(const LAS bfx4*)(M + o + 16)), r0_ = __builtin_bit_cast(v2u, *(const LAS bfx4*)(M + 1152 + o)), r1_ = __builtin_bit_cast(v2u, *(const LAS bfx4*)(M + 1152 + o + 16));
        __builtin_nontemporal_store((v4u){a0_.x, a0_.y, a1_.x, a1_.y}, (GAS v4u*)(rec + CR_AT + s * 1024 + lane * 16)); __builtin_nontemporal_store((v4u){r0_.x, r0_.y, r1_.x, r1_.y}, (GAS v4u*)(rec + CR_RT + s * 1024 + lane * 16)); }
    { const f32x4 xg = *(const LAS f32x4*)(XGT + c16 * 16 + 4 * g); v2u o; o.x = cvt2(xg[0], xg[1]); o.y = cvt2(xg[2], xg[3]); __builtin_nontemporal_store(o, (GAS v2u*)(rec + CR_GT + lane * 8)); }
    *(GAS float*)(rec + CR_W15 + lane * 4) = wex;
#pragma unroll
    for (int q = 0; q < 4; ++q) {
        __builtin_nontemporal_store((v4u){Bp[2 * q], Bp[2 * q + 1], Kq[2 * q], Kq[2 * q + 1]}, (GAS v4u*)(rec + CR_BK + g * 1024 + (c16 + 16 * q) * 16));
        __builtin_nontemporal_store((v2u){Vq[2 * q], Vq[2 * q + 1]}, (GAS v2u*)(rec + CR_VT + g * 512 + (c16 + 16 * q) * 8)); }
}
__device__ __forceinline__ void rwkv_chunk_rec(Frame& F, int L, int b, int h) {
    const int lane = F.lane, c16 = lane & 15, g = lane >> 4, w = F.wave;
    const GAS unsigned char* recs = F.ws + WS_OV + OV_CR + (size_t)(b * NH + h) * CH_N * CR_BYTES;
    LAS unsigned char* ring = F.lds + RING_OFF;
    constexpr int DIST = 6, NSLOT = 8;
    __syncthreads();
    if (w >= 4) {
        const int p0 = (w - 4) * 3;
#define CR_ISSUE(cc) do { const GAS unsigned char* gs_ = recs + (size_t)(cc) * CR_BYTES + p0 * 1024 + lane * 16; LAS unsigned char* ld_ = ring + ((cc) % NSLOT) * CR_BYTES + p0 * 1024; \
        _Pragma("unroll") for (int i_ = 0; i_ < 3; ++i_) __builtin_amdgcn_global_load_lds((const GAS unsigned*)(gs_ + i_ * 1024), (LAS unsigned*)(ld_ + i_ * 1024), 16, 0, 2); } while (0)
        for (int cc = 0; cc < DIST; ++cc) CR_ISSUE(cc);
        for (int c = 0; c < CH_N; ++c) {
            if (c + DIST < CH_N) { CR_ISSUE(c + DIST); asm volatile("s_waitcnt vmcnt(18)" ::: "memory"); } else asm volatile("s_waitcnt vmcnt(0)" ::: "memory");
            __builtin_amdgcn_s_barrier();
        }
#undef CR_ISSUE
    } else {
        f32x4 ST[4];
#pragma unroll
        for (int n = 0; n < 4; ++n) ST[n] = (f32x4){0.f, 0.f, 0.f, 0.f};
        v4u SB0 = {0u, 0u, 0u, 0u}, SB1 = SB0;
        GAS float* O = (GAS float*)(F.ws + WS_OV + OV_O) + h * HD + 16 * w + c16;
        for (int c = 0; c < CH_N; ++c) {
            __builtin_amdgcn_s_barrier(); asm volatile("" ::: "memory");
            const LAS unsigned char* sl = ring + (c % NSLOT) * CR_BYTES;
            const bfx8 AT0 = *(const LAS bfx8*)(sl + CR_AT + lane * 16), AT1 = *(const LAS bfx8*)(sl + CR_AT + 1024 + lane * 16), RT0 = *(const LAS bfx8*)(sl + CR_RT + lane * 16), RT1 = *(const LAS bfx8*)(sl + CR_RT + 1024 + lane * 16);
            const bfx8 ARK = *(const LAS bfx8*)(sl + CR_ARK + lane * 16);
            bfx8 BK[4]; f32x4 W15[4];
#pragma unroll
            for (int n = 0; n < 4; ++n) { BK[n] = *(const LAS bfx8*)(sl + CR_BK + n * 1024 + lane * 16); W15[n] = *(const LAS f32x4*)(sl + CR_W15 + (16 * n + 4 * g) * 4); }
            const v2u VT = *(const LAS v2u*)(sl + CR_VT + w * 512 + lane * 8), GT = *(const LAS v2u*)(sl + CR_GT + lane * 8);
            const bfx8 sb0 = __builtin_bit_cast(bfx8, SB0), sb1 = __builtin_bit_cast(bfx8, SB1);
            f32x4 Z = {0.f, 0.f, 0.f, 0.f}, OT = Z;
            Z = __builtin_amdgcn_mfma_f32_16x16x32_bf16(AT0, sb0, Z, 0, 0, 0); Z = __builtin_amdgcn_mfma_f32_16x16x32_bf16(AT1, sb1, Z, 0, 0, 0);
            Z = __builtin_amdgcn_mfma_f32_16x16x16bf16_1k(__builtin_bit_cast(bfx4, GT), __builtin_bit_cast(bfx4, VT), Z, 0, 0, 0);
            OT = __builtin_amdgcn_mfma_f32_16x16x32_bf16(RT0, sb0, OT, 0, 0, 0); OT = __builtin_amdgcn_mfma_f32_16x16x32_bf16(RT1, sb1, OT, 0, 0, 0);
            v4u zv; zv.x = cvt2(Z[0], Z[1]); zv.y = cvt2(Z[2], Z[3]); zv.z = VT.x; zv.w = VT.y;
            const bfx8 zvb = __builtin_bit_cast(bfx8, zv);
            OT = __builtin_amdgcn_mfma_f32_16x16x32_bf16(ARK, zvb, OT, 0, 0, 0);
#pragma unroll
            for (int n = 0; n < 4; ++n) ST[n] = __builtin_amdgcn_mfma_f32_16x16x32_bf16(BK[n], zvb, ST[n], 0, 0, 0) * W15[n];
            SB0.x = cvt2(ST[0][0], ST[0][1]); SB0.y = cvt2(ST[0][2], ST[0][3]); SB0.z = cvt2(ST[1][0], ST[1][1]); SB0.w = cvt2(ST[1][2], ST[1][3]);
            SB1.x = cvt2(ST[2][0], ST[2][1]); SB1.y = cvt2(ST[2][2], ST[2][3]); SB1.z = cvt2(ST[3][0], ST[3][1]); SB1.w = cvt2(ST[3][2], ST[3][3]);
            const int rb = c == 0 ? MR : b * SEQ + (c - 1) * CH_T;
#pragma unroll
            for (int e = 0; e < 4; ++e) __builtin_nontemporal_store(OT[e], O + (size_t)(rb + 4 * g + e) * RW_W);
        }
    }
    __syncthreads();
}
constexpr int CONV_EARLY = 4096;
__device__ __forceinline__ void conv_share(Frame& F, int L, int wg, int nwg, int lo, int hi) {
    LAS unsigned* cscr = (LAS unsigned*)(F.lds + RING_OFF + F.wave * 16384);
    for (int ct = lo + wg * NWAVES + F.wave; ct < hi; ct += nwg * NWAVES) { int m_, it_; if (!tr_decode(L, ct, m_, it_)) break;
        const TrDesc d = tr_desc(F, L, m_); f32x4 cv[16]; tr_tile_load(d, it_, F.lane, cv); tr_tile_finish(d, it_, F.lane, cv, cscr); }
}
struct PostIn { f32x4 o; v2u v, g; float rk; };
__device__ __forceinline__ PostIn rwkv_post_load(Frame& F, int row, int hq) {
    const int hl = F.lane >> 4, j = F.lane & 15, h = 4 * hq + hl, C = h * HD + 4 * j; const size_t RC = (size_t)row * RW_W + C;
    PostIn p; p.o = __builtin_nontemporal_load((const GAS f32x4*)((const GAS float*)(F.ws + WS_OV + OV_O) + RC));
    p.v = __builtin_nontemporal_load((const GAS v2u*)((const GAS bf16*)(F.ws + WS_OV + OV_RW) + RC));
    p.g = __builtin_nontemporal_load((const GAS v2u*)((const GAS bf16*)(F.ws + WS_OV + OV_GT) + RC));
    p.rk = ((const GAS float*)(F.ws + WS_OV + OV_RKS))[(size_t)row * NH + h];
    return p;
}
__device__ __forceinline__ f32x4 ub4(const v2u u) { return (f32x4){__uint_as_float(u.x << 16), __uint_as_float(u.x & 0xffff0000u), __uint_as_float(u.y << 16), __uint_as_float(u.y & 0xffff0000u)}; }
__device__ __forceinline__ void rwkv_post_finish(Frame& F, const PostIn& p, int row, int hq, const f32x4 lw, const f32x4 lb) {
    const int hl = F.lane >> 4, j = F.lane & 15, h = 4 * hq + hl, C = h * HD + 4 * j; const size_t RC = (size_t)row * RW_W + C;
    const f32x4 o = p.o;
    const float mean = row16_sum((o[0] + o[1]) + (o[2] + o[3])) * (1.0f / HD); const f32x4 d = o - mean;
    const float var = row16_sum((d[0] * d[0] + d[1] * d[1]) + (d[2] * d[2] + d[3] * d[3])) * (1.0f / HD);
    const float rs = rsqrtf(var + HD * 1e-5f);
    const f32x4 y = (d * rs * lw + lb + p.rk * ub4(p.v)) * ub4(p.g);
    v2u w; w.x = pk2(y[0], y[1]); w.y = pk2(y[2], y[3]);
    *(GAS v2u*)((GAS bf16*)(F.ws + WS_OV + OV_YB) + RC) = w;
}
__device__ __forceinline__ void rwkv_post_all(Frame& F, int L, int gw, int NGW) {
    const int hq = gw & 3;
    const int hl = F.lane >> 4, j = F.lane & 15, C = (4 * hq + hl) * HD + 4 * j; const size_t LC = (size_t)L * RW_W + C;
    const f32x4 lw = *(const GAS f32x4*)(inp(F, I_LNW) + LC), lb = *(const GAS f32x4*)(inp(F, I_LNB) + LC);
    constexpr int NT = MROWS * 4;
    for (int t = gw; t < NT; t += 4 * NGW) {
        PostIn p[4];
#pragma unroll
        for (int i = 0; i < 4; ++i) { const int ti = t + i * NGW; p[i] = rwkv_post_load(F, (ti < NT ? ti : t) >> 2, hq); }
#pragma unroll
        for (int i = 0; i < 4; ++i) { const int ti = t + i * NGW; if (ti < NT) rwkv_post_finish(F, p[i], ti >> 2, hq, lw, lb); }
    }
}
__device__ __forceinline__ void final_norm(Frame& F, GAS float* out) {
    const int gw = F.vcu * NWAVES + F.wave, NGW = F.G * NWAVES; const GAS float* gn = inp(F, I_FINN);
    for (int m = gw; m < MR; m += NGW) {
        f32x4 v[8]; float s = 0.f;
#pragma unroll
        for (int j = 0; j < 4; ++j) { pg8::unpackh8(((const GAS v4u*)(FX16(F) + (size_t)m * DM))[F.lane + 64 * j], v[2 * j], v[2 * j + 1]);
            s += ((v[2 * j][0] * v[2 * j][0] + v[2 * j][1] * v[2 * j][1]) + (v[2 * j][2] * v[2 * j][2] + v[2 * j][3] * v[2 * j][3])) + ((v[2 * j + 1][0] * v[2 * j + 1][0] + v[2 * j + 1][1] * v[2 * j + 1][1]) + (v[2 * j + 1][2] * v[2 * j + 1][2] + v[2 * j + 1][3] * v[2 * j + 1][3])); }
        const float inv = rsqrtf(wave_sum(s) * (1.0f / DM) + NORM_EPS);
#pragma unroll
        for (int j = 0; j < 4; ++j) { const int c8 = 8 * (F.lane + 64 * j);
            ((GAS f32x4*)(out + (size_t)m * DM + c8))[0] = v[2 * j] * inv * ((const GAS f32x4*)(gn + c8))[0]; ((GAS f32x4*)(out + (size_t)m * DM + c8))[1] = v[2 * j + 1] * inv * ((const GAS f32x4*)(gn + c8))[1]; }
    }
}
constexpr int INVTAB_OFF = LDSCTL_OFF + 4096;
__device__ __forceinline__ const LAS float* fill_inv_table(Frame& F, const GAS unsigned long long* ss, int G, int c) {
    if (G != 256) return nullptr;
    LAS float* tab = (LAS float*)(F.lds + INVTAB_OFF); const int base = 8 * (c & 7) * 256;
#pragma unroll
    for (int i = 0; i < 4; ++i) { const int r = F.tid + 512 * i; tab[r] = rsqrtf((float)(long long)ss[base + r] * (pg8::SS_INV_SCALE / (float)DM) + 1e-6f); }
    __syncthreads();
    return tab;
}
constexpr int NPH = 14;
struct Args { const float* in[N_IN]; float* out; unsigned char* ws; int l_lo, l_hi, ph_lo, ph_hi; };
__global__ void __launch_bounds__(NWAVES * 64, 2) mk_fwd(Args args) {
    extern __shared__ __attribute__((aligned(16))) unsigned char lds[];
    Frame F;
    F.lds = (LAS unsigned char*)lds;
    F.MISC = (volatile LAS unsigned*)(F.lds + MISC_OFF);
    F.tid = threadIdx.x; F.lane = F.tid & 63; F.wave = __builtin_amdgcn_readfirstlane(F.tid >> 6);
    F.G = gridDim.x; { const int bx = blockIdx.x; F.vcu = (F.G % 8 == 0) ? (bx % 8) * (F.G / 8) + bx / 8 : bx; }
    F.ws = (GAS unsigned char*)args.ws;
    F.ctl = (gu32*)(args.ws + WS_CTL);
    for (int u = F.tid; u < (LDS_BYTES - LDSCTL_OFF) / 4; u += NWAVES * 64) ((LAS unsigned*)(F.lds + LDSCTL_OFF))[u] = 0u;
    __syncthreads();
    if (F.tid < N_IN) ((LAS unsigned long long*)(F.lds + LDSCTL_OFF))[F.tid] = (unsigned long long)args.in[F.tid];
    __syncthreads();
    XcdBarrier bar; bar.bar = (unsigned*)(F.ctl + CW_BAR); bar.x = 0; bar.st = nullptr;
    if (!MK_MULTI) bar = xcd_barrier_post((unsigned*)(F.ctl + CW_BAR), F.MISC + 8);
#define GRID_BAR() do { if (MK_MULTI) { if (F.tid == 0) __hip_atomic_store(F.ctl + CW_TMO, 0xBADBA0u, RLX_AGENT); } else { xcd_barrier(bar); } } while (0)
    const int lo = args.ph_lo, hi = args.ph_hi;
#ifndef PH_MASK
#define PH_MASK 0x3FFF
#endif
#define IN(k) ((((PH_MASK) >> (k)) & 1) && lo <= (k) && (k) < hi)
#define BOTH(k) (IN(k) && IN((k) + 1))
#ifndef REPEAT_MASK
#define REPEAT_MASK 0
#endif
#define PHASE(k) for (int rep_ = (IN(k) ? 1 + (((REPEAT_MASK) >> (k)) & 1) : 0); rep_ > 0; --rep_)
    const int wave0_ = __builtin_amdgcn_readfirstlane((int)threadIdx.x >> 6);
#define PH_ENV() int lane_; asm volatile("v_mbcnt_lo_u32_b32 %0, -1, 0\n\tv_mbcnt_hi_u32_b32 %0, -1, %0" : "=v"(lane_));     \
    unsigned char* wsl_ = args.ws; int bx_ = (int)blockIdx.x, tid_ = (wave0_ << 6) | lane_, G_ = (int)gridDim.x, Lp = L; asm volatile("" : "+s"(wsl_), "+s"(bx_), "+s"(G_), "+s"(Lp), "+v"(tid_)); GAS unsigned char* wsl = (GAS unsigned char*)wsl_; \
    F.ws = wsl; F.tid = tid_; F.lane = tid_ & 63; F.wave = __builtin_amdgcn_readfirstlane(tid_ >> 6); F.G = G_; F.vcu = (G_ % 8 == 0) ? (bx_ % 8) * (G_ / 8) + bx_ / 8 : bx_; \
    GAS unsigned char* ov = wsl + WS_OV; GAS unsigned char* wb = wsl + WS_W + (size_t)(Lp & 1) * W_SLOT; (void)ov; (void)wb; \
    const int gw = F.vcu * NWAVES + F.wave, NGW = F.G * NWAVES; (void)gw; (void)NGW;

    for (int L = args.l_lo; L < args.l_hi; ++L) {
        PHASE(0) { PH_ENV();
            if (Lp == 0 || G_ != 256) {
                if (Lp == 0) px_init(F);
                s5_build(F, Lp); lora_weights(F, Lp); pw_zero_rows(F, Lp);
                if (Lp == 0) { __syncthreads(); conv_share(F, 0, bx_, G_, 0, 1 << 30); }
                if (BOTH(0)) GRID_BAR(); } }
        PHASE(1) { PH_ENV();
            pg8::Gemm g{FXB(F), (const GAS bf16*)(wb + WO_GU1), MR, 2 * DFF, DM}; pg8::StaticOrder S; S.init(MR, 2 * DFF, G_, bx_);
            pg8::EpiSwiglu E{FSSC(F), (GAS bf16*)(ov + OV_ACT), DFF, fill_inv_table(F, FSSC(F), G_, bx_)};
            pg8::gemm_phase<pg8::EpiSwiglu, pg8::StaticOrder, true, true>(F.lds + RING_OFF, g, S, E, tid_); pg8::thin_gemm(F.lds + RING_OFF, g, E, G_, bx_, MR, tid_);
            if (BOTH(1)) GRID_BAR();
        }
        PHASE(2) { PH_ENV();
            pg8::Gemm g{(const GAS bf16*)(ov + OV_ACT), (const GAS bf16*)(wb + WO_D1), MR, DM, DFF}; pg8::StaticOrder S; S.init(MR, DM, G_, bx_);
            pg8::EpiResid E{FX16(F), FXB(F), FSSA(F), ((REPEAT_MASK & 4) && rep_ == 2) ? 0.0f : 0.5f, ((REPEAT_MASK & 4) && rep_ == 2) ? 1 : 0};
            pg8::gemm_phase<pg8::EpiResid, pg8::StaticOrder, true, true>(F.lds + RING_OFF, g, S, E, tid_); pg8::thin_gemm(F.lds + RING_OFF, g, E, G_, bx_, MR, tid_);
            if (BOTH(2)) GRID_BAR();
        }
        PHASE(3) { PH_ENV();
            pg8::Gemm g{FXB(F), (const GAS bf16*)(wb + WO_IN), MR, NIN, DM}; pg8::StaticOrder S; S.init(MR, NIN, G_, bx_);
            typedef pg8::EpiWin<OV_U2, OV_RKV, OV_GA, OV_GB, OV_LIN, MP> EpiW; EpiW E{FSSA(F), ov, fill_inv_table(F, FSSA(F), G_, bx_)};
            pg8::gemm_phase<EpiW, pg8::StaticOrder, true, true>(F.lds + RING_OFF, g, S, E, tid_); pg8::thin_gemm(F.lds + RING_OFF, g, E, G_, bx_, MR, tid_);
            if (Lp + 1 < DEPTH && G_ == 256 && bx_ >= 128) { const int vs = F.vcu, gs = F.G; F.vcu = bx_ - 128; F.G = 128; s5_build(F, Lp + 1); lora_weights(F, Lp + 1); pw_zero_rows(F, Lp + 1); F.vcu = vs; F.G = gs;
                __syncthreads(); conv_share(F, Lp + 1, bx_ - 128, 128, 0, CONV_EARLY); }
            if (BOTH(3)) GRID_BAR();
        }
        PHASE(4) { PH_ENV();
            { unsigned zlo = 0u; asm volatile("" : "+v"(zlo)); const unsigned long long z64 = zlo;
              for (int i = bx_ * (NWAVES * 64) + F.tid; i < MP; i += F.G * NWAVES * 64) { FSSA(F)[i] = z64; FSSB(F)[i] = z64; FSSC(F)[i] = z64; } }
            for (int u = F.vcu; u < BATCH * NG; u += F.G) s5_unit(F, Lp, u >> 6, u & 63);
            lora_inputs(F, Lp);
            if (BOTH(4)) GRID_BAR();
        }
        PHASE(5) { PH_ENV();
            { int KL = LKP; asm volatile("" : "+s"(KL));
              pg8::Gemm g{(const GAS bf16*)(ov + OV_LA), (const GAS bf16*)(wb + WO_LORA) + (size_t)2048 * LKP, MR, 1024, KL}; pg8::StaticOrder S; S.init(MR, 1024, G_, bx_);
              typedef pg8::EpiLora<OV_GT, OV_GT, OV_GT, OV_GT> EpiL; EpiL E{ov};
              pg8::gemm_phase<EpiL, pg8::StaticOrder, true, true>(F.lds + RING_OFF, g, S, E, tid_); pg8::thin_gemm(F.lds + RING_OFF, g, E, G_, bx_, MR, tid_); }
        }
        PHASE(6) { PH_ENV();
            { pg8::Gemm g{(const GAS bf16*)(ov + OV_YPRE), (const GAS bf16*)(wb + WO_GLU), MR, SW, SW}; pg8::StaticOrder S; S.init(MR, SW, G_, bx_);
              pg8::EpiGlu E{(const GAS bf16*)(ov + OV_YPRE), (GAS bf16*)(ov + OV_YA), SW};
              pg8::gemm_phase<pg8::EpiGlu, pg8::StaticOrder, true, true>(F.lds + RING_OFF, g, S, E, tid_); pg8::thin_gemm(F.lds + RING_OFF, g, E, G_, bx_, MR, tid_); }
            __syncthreads();
            { const int bh = gw & 63; const LAS float* pp = rwkv_prep_par(F, Lp, bh & 15);
              for (int it = gw; it < BATCH * NH * CH_N; it += NGW) { int bb = bh >> 4, hh = bh & 15; asm volatile("" : "+s"(bb), "+s"(hh));
                  rwkv_prep_item(F, Lp, bb, hh, it >> 6, pp); } }
            if (IN(6) && IN(7)) GRID_BAR();
        }
        PHASE(7) { PH_ENV();
            const int nrec = G_ > 64 ? 64 : G_;
            for (int u = bx_; u < BATCH * NH; u += nrec) { if (bx_ < nrec) rwkv_chunk_rec(F, Lp, u >> 4, u & 15); else break; }
            if (Lp + 1 < DEPTH) { const int lo = G_ == 256 ? CONV_EARLY : 0; if (G_ > 64) { if (bx_ >= 64) conv_share(F, Lp + 1, bx_ - 64, G_ - 64, lo, 1 << 30); } else conv_share(F, Lp + 1, bx_, G_, lo, 1 << 30); }
            else if (G_ > 64 && bx_ >= 64) {
                pg8::Gemm g{(const GAS bf16*)(ov + OV_YA), (const GAS bf16*)(wb + WO_UA), MR, DM, SW}; pg8::StaticOrder S; S.init(MR, DM, G_ - 64, bx_ - 64);
                pg8::EpiGateMul<false> E{(const GAS bf16*)(ov + OV_GA), (GAS bf16*)(ov + OV_MG)};
                pg8::gemm_phase<pg8::EpiGateMul<false>, pg8::StaticOrder, true, true>(F.lds + RING_OFF, g, S, E, tid_); pg8::thin_gemm(F.lds + RING_OFF, g, E, G_ - 64, bx_ - 64, MR, tid_); }
            if (BOTH(7)) GRID_BAR();
        }
        PHASE(8) { PH_ENV();
            rwkv_post_all(F, Lp, gw, NGW);
            if (!(Lp + 1 == DEPTH && G_ > 64))
            { pg8::Gemm g{(const GAS bf16*)(ov + OV_YA), (const GAS bf16*)(wb + WO_UA), MR, DM, SW}; pg8::StaticOrder S; S.init(MR, DM, G_, bx_);
              pg8::EpiGateMul<false> E{(const GAS bf16*)(ov + OV_GA), (GAS bf16*)(ov + OV_MG)};
              pg8::gemm_phase<pg8::EpiGateMul<false>, pg8::StaticOrder, true, true>(F.lds + RING_OFF, g, S, E, tid_); pg8::thin_gemm(F.lds + RING_OFF, g, E, G_, bx_, MR, tid_); }
            if (BOTH(8)) GRID_BAR();
        }
        PHASE(9) { PH_ENV();
            pg8::Gemm g{(const GAS bf16*)(ov + OV_YB), (const GAS bf16*)(wb + WO_UB), MR, DM, RW_W}; pg8::StaticOrder S; S.init(MR, DM, G_, bx_);
            pg8::EpiGateMul<true> E{(const GAS bf16*)(ov + OV_GB), (GAS bf16*)(ov + OV_MG)};
            pg8::gemm_phase<pg8::EpiGateMul<true>, pg8::StaticOrder, true, true>(F.lds + RING_OFF, g, S, E, tid_); pg8::thin_gemm(F.lds + RING_OFF, g, E, G_, bx_, MR, tid_);
            if (BOTH(9)) GRID_BAR();
        }
        PHASE(10) { PH_ENV();
            pg8::Gemm g{(const GAS bf16*)(ov + OV_MG), (const GAS bf16*)(wb + WO_O), MR, DM, DM}; pg8::StaticOrder S; S.init(MR, DM, G_, bx_);
            pg8::EpiResid E{FX16(F), FXB(F), FSSB(F), 1.0f};
            pg8::gemm_phase<pg8::EpiResid, pg8::StaticOrder, true, true>(F.lds + RING_OFF, g, S, E, tid_); pg8::thin_gemm(F.lds + RING_OFF, g, E, G_, bx_, MR, tid_);
            if (BOTH(10)) GRID_BAR();
        }
        PHASE(11) { PH_ENV();
            pg8::Gemm g{FXB(F), (const GAS bf16*)(wb + WO_GU2), MR, 2 * DFF, DM}; pg8::StaticOrder S; S.init(MR, 2 * DFF, G_, bx_);
            pg8::EpiSwiglu E{FSSB(F), (GAS bf16*)(ov + OV_ACT), DFF, fill_inv_table(F, FSSB(F), G_, bx_)};
            pg8::gemm_phase<pg8::EpiSwiglu, pg8::StaticOrder, true, true>(F.lds + RING_OFF, g, S, E, tid_); pg8::thin_gemm(F.lds + RING_OFF, g, E, G_, bx_, MR, tid_);
            if (BOTH(11)) GRID_BAR();
        }
        PHASE(12) { PH_ENV();
            pg8::Gemm g{(const GAS bf16*)(ov + OV_ACT), (const GAS bf16*)(wb + WO_D2), MR, DM, DFF}; pg8::StaticOrder S; S.init(MR, DM, G_, bx_);
            pg8::EpiResid E{FX16(F), FXB(F), FSSC(F), 0.5f};
            pg8::gemm_phase<pg8::EpiResid, pg8::StaticOrder, true, true>(F.lds + RING_OFF, g, S, E, tid_); pg8::thin_gemm(F.lds + RING_OFF, g, E, G_, bx_, MR, tid_);
            if (IN(13) || L + 1 < args.l_hi) GRID_BAR();
        }
        if (IN(13) && L == DEPTH - 1) { PH_ENV(); final_norm(F, (GAS float*)args.out); }
    }
#undef IN
#undef BOTH
}

extern "C" void kernel_launch(void* const* d_in, const int* in_sizes, int n_in, void* d_out, int out_size, void* d_ws, size_t ws_size, hipStream_t stream) {
    static int grid = 0;
    if (grid == 0) {
        if (n_in != N_IN || in_sizes[0] != MR * DM || out_size != MR * DM || ws_size < WS_END) {
            fprintf(stderr, "kernel_launch: built for %d inputs, x/out of %d floats, >= %zu bytes of workspace; got n_in %d, in0 %d, out %d, ws %zu; nothing launched\n", (int)N_IN, MR * DM, (size_t)WS_END, n_in, n_in > 0 ? in_sizes[0] : -1, out_size, ws_size);
            grid = -1; return; }
        int dev = 0, cus = 0, per_cu = 0;
        if (hipGetDevice(&dev) != hipSuccess || hipDeviceGetAttribute(&cus, hipDeviceAttributeMultiprocessorCount, dev) != hipSuccess) { fprintf(stderr, "kernel_launch: device query failed\n"); grid = -1; return; }
        if (hipFuncSetAttribute((const void*)mk_fwd, hipFuncAttributeMaxDynamicSharedMemorySize, LDS_BYTES) != hipSuccess) { fprintf(stderr, "kernel_launch: hipFuncSetAttribute failed\n"); grid = -1; return; }
        if (hipOccupancyMaxActiveBlocksPerMultiprocessor(&per_cu, (const void*)mk_fwd, NWAVES * 64, LDS_BYTES) != hipSuccess || per_cu < 1)
            fprintf(stderr, "kernel_launch: note: occupancy query reports %d workgroups per CU\n", per_cu);
        (void)hipGetLastError();
        grid = cus;
    }
    if (grid < 0) return;
    if (hipMemsetAsync((char*)d_ws + WS_CTL, 0, CTL_ZERO_BYTES, stream) != hipSuccess) { fprintf(stderr, "kernel_launch: memset failed\n"); return; }
    Args a{};
    for (int i = 0; i < N_IN; ++i) a.in[i] = (const float*)d_in[i];
    a.out = (float*)d_out; a.ws = (unsigned char*)d_ws;
#if MK_MULTI
    for (int L = 0; L < DEPTH; ++L) for (int p = 0; p < NPH; ++p) { if (p == NPH - 1 && L != DEPTH - 1) continue; a.l_lo = L; a.l_hi = L + 1; a.ph_lo = p; a.ph_hi = p + 1;
        hipLaunchKernelGGL(mk_fwd, dim3(grid), dim3(NWAVES * 64), LDS_BYTES, stream, a); }
#else
    a.l_lo = 0; a.l_hi = DEPTH; a.ph_lo = 0; a.ph_hi = NPH;
    hipLaunchKernelGGL(mk_fwd, dim3(grid), dim3(NWAVES * 64), LDS_BYTES, stream, a);
#endif
    const hipError_t le = hipPeekAtLastError();
    if (le != hipSuccess) fprintf(stderr, "kernel_launch: launch failed: %s\n", hipGetErrorName(le));
}
```
